# Optimizing an MI355X kernel written in HIP

```python
import jax, jax.numpy as jnp
from jax import lax
import numpy as np

D_MODEL = 2048
BATCH = 4
SEQ = 4096
DEPTH = 2

D_MIX = D_MODEL
ATTN_WIDTH = D_MIX // 2
HGRN_WIDTH = D_MIX - ATTN_WIDTH
HEAD_DIM = 64
N_Q_HEADS = ATTN_WIDTH // HEAD_DIM
N_KV_HEADS = 4
Q_PER_KV = N_Q_HEADS // N_KV_HEADS
WINDOW = 128
ATTN_BLOCK = WINDOW
ROPE_THETA = 10000.0
MASK_VALUE = -1e30
HGRN_EXPAND = 128
HGRN_HEADS = HGRN_WIDTH // HGRN_EXPAND
HGRN_VDIM = HGRN_WIDTH // HGRN_HEADS
HGRN_CHUNK = 64
D_FF = ((8 * D_MODEL // 3 + 255) // 256) * 256
D_PLE = 256
RMS_EPS = 1e-6
KV_WIDTH = N_KV_HEADS * HEAD_DIM
IN_SIZES = (ATTN_WIDTH, KV_WIDTH, KV_WIDTH, HGRN_WIDTH, HGRN_WIDTH, HGRN_WIDTH, HGRN_WIDTH)
SPLIT_POINTS = tuple(int(v) for v in np.cumsum(IN_SIZES)[:-1])
D_IN = sum(IN_SIZES)

kernel_name = "hymba_swa_sink_hgrn2_sandwich_ple"


def rms_norm(x, gain):
    xf = x.astype(jnp.float32)
    y = xf * lax.rsqrt(jnp.mean(xf * xf, axis=-1, keepdims=True) + RMS_EPS)
    return (y * gain.astype(jnp.float32)).astype(x.dtype)


def rope(x, positions):
    half = HEAD_DIM // 2
    inv_freq = ROPE_THETA ** (-jnp.arange(half, dtype=jnp.float32) / half)
    ang = positions.astype(jnp.float32)[..., None] * inv_freq
    cos = jnp.cos(ang)[:, :, None, :]
    sin = jnp.sin(ang)[:, :, None, :]
    xf = x.astype(jnp.float32)
    x1, x2 = xf[..., :half], xf[..., half:]
    out = jnp.concatenate([x1 * cos - x2 * sin, x2 * cos + x1 * sin], axis=-1)
    return out.astype(x.dtype)


def sliding_window_attention(q, k, v, sinks):
    B, S = q.shape[0], q.shape[1]
    nb = S // ATTN_BLOCK
    L = ATTN_BLOCK
    qb = q.reshape(B, nb, L, N_KV_HEADS, Q_PER_KV, HEAD_DIM)
    kb = k.reshape(B, nb, L, N_KV_HEADS, HEAD_DIM)
    vb = v.reshape(B, nb, L, N_KV_HEADS, HEAD_DIM)
    prev = lambda t: jnp.concatenate([jnp.zeros_like(t[:, :1]), t[:, :-1]], axis=1)
    kk = jnp.concatenate([prev(kb), kb], axis=2)
    vv = jnp.concatenate([prev(vb), vb], axis=2)
    scores = jnp.einsum('bnqhgd,bnkhd->bnhgqk', qb, kk,
                        preferred_element_type=jnp.float32) * (HEAD_DIM ** -0.5)
    qi = jnp.arange(L)[:, None] + L
    ki = jnp.arange(2 * L)[None, :]
    rel = qi - ki
    band = (rel >= 0) & (rel < WINDOW)
    valid = band[None] & ((jnp.arange(nb)[:, None, None] > 0) | (ki >= L)[None])
    scores = jnp.where(valid[None, :, None, None], scores, MASK_VALUE)
    sink = sinks.astype(jnp.float32).reshape(N_KV_HEADS, Q_PER_KV)[None, None, :, :, None, None]
    m = jnp.maximum(jnp.max(scores, axis=-1, keepdims=True), sink)
    e = jnp.exp(scores - m)
    probs = e / (jnp.sum(e, axis=-1, keepdims=True) + jnp.exp(sink - m))
    out = jnp.einsum('bnhgqk,bnkhd->bnqhgd', probs.astype(vv.dtype), vv)
    return out.reshape(B, S, N_Q_HEADS * HEAD_DIM)


def hgrn2_chunkwise(q, k, v, log_f):
    B, S = q.shape[0], q.shape[1]
    nc = S // HGRN_CHUNK
    C = HGRN_CHUNK

    def to_chunks(t):
        return t.astype(jnp.float32).reshape(B, nc, C, HGRN_HEADS, t.shape[-1]).transpose(1, 0, 3, 2, 4)

    qc, kc, vc, gc = to_chunks(q), to_chunks(k), to_chunks(v), to_chunks(log_f)
    causal = jnp.tril(jnp.ones((C, C), dtype=bool))

    def step(state, inp):
        q_, k_, v_, g_ = inp
        b = jnp.cumsum(g_, axis=2)
        diff = b[:, :, :, None, :] - b[:, :, None, :, :]
        decay = jnp.exp(jnp.where(causal[None, None, :, :, None], diff, MASK_VALUE))
        a = jnp.einsum('bhtk,bhsk,bhtsk->bhts', q_, k_, decay)
        o = jnp.einsum('bhts,bhsv->bhtv', a, v_) + \
            jnp.einsum('bhtk,bhkv->bhtv', q_ * jnp.exp(b), state)
        b_last = b[:, :, -1:, :]
        new_state = state * jnp.exp(b_last)[:, :, 0, :, None] + \
            jnp.einsum('bhsk,bhsv->bhkv', k_ * jnp.exp(b_last - b), v_)
        return new_state, o

    s0 = jnp.zeros((B, HGRN_HEADS, HGRN_EXPAND, HGRN_VDIM), jnp.float32)
    _, o = lax.scan(step, s0, (qc, kc, vc, gc))
    return o.transpose(1, 0, 3, 2, 4).reshape(B, S, HGRN_HEADS, HGRN_VDIM)


def hybrid_mixer(h, positions, w_in, sinks, lb, attn_gain, hgrn_gain, w_out):
    B, S = h.shape[0], h.shape[1]
    proj = h @ w_in
    q, k, v, hq, hf, hi, hg = jnp.split(proj, SPLIT_POINTS, axis=-1)
    q = rope(q.reshape(B, S, N_Q_HEADS, HEAD_DIM), positions)
    k = rope(k.reshape(B, S, N_KV_HEADS, HEAD_DIM), positions)
    v = v.reshape(B, S, N_KV_HEADS, HEAD_DIM)
    attn = rms_norm(sliding_window_attention(q, k, v, sinks), attn_gain)
    z = hf.astype(jnp.float32)
    lbf = lb.astype(jnp.float32)
    f = lbf + (1.0 - lbf) * jax.nn.sigmoid(z)
    log_f = jnp.log(f)
    k_in = (1.0 - lbf) * jax.nn.sigmoid(-z)
    hq_ = jax.nn.silu(hq.astype(jnp.float32))
    shp = (B, S, HGRN_HEADS, HGRN_EXPAND)
    o = hgrn2_chunkwise(hq_.reshape(shp), k_in.reshape(shp),
                        hi.reshape(B, S, HGRN_HEADS, HGRN_VDIM), log_f.reshape(shp))
    o = rms_norm(o, hgrn_gain.reshape(HGRN_HEADS, HGRN_VDIM)).reshape(B, S, HGRN_WIDTH)
    hgrn = (o * jax.nn.silu(hg.astype(jnp.float32))).astype(h.dtype)
    return jnp.concatenate([attn, hgrn], axis=-1) @ w_out


def setup_inputs(seed: int = 0) -> dict:
    key = jax.random.key(seed)
    ks = jax.random.split(key, 24)
    f32 = jnp.float32
    nrm = lambda k, shape, scale: jax.random.normal(k, shape, f32) * scale
    gain = lambda k, shape: 1.0 + 0.05 * jax.random.normal(k, shape, f32)
    offsets = jax.random.randint(ks[2], (BATCH, 1), 0, 1024, dtype=jnp.int32)
    positions = offsets + jnp.arange(SEQ, dtype=jnp.int32)[None, :]
    return {
        "x": nrm(ks[0], (BATCH, SEQ, D_MODEL), 1.0),
        "p": nrm(ks[1], (DEPTH, BATCH, SEQ, D_PLE), 1.0),
        "positions": positions,
        "w_in": nrm(ks[3], (DEPTH, D_MODEL, D_IN), D_MODEL ** -0.5),
        "attn_sinks": nrm(ks[4], (DEPTH, N_Q_HEADS), 1.0),
        "hgrn_lb_logits": nrm(ks[5], (DEPTH, HGRN_WIDTH), 0.5),
        "attn_out_gain": gain(ks[6], (DEPTH, ATTN_WIDTH)),
        "hgrn_out_gain": gain(ks[7], (DEPTH, HGRN_WIDTH)),
        "w_out": nrm(ks[8], (DEPTH, D_MIX, D_MODEL), D_MIX ** -0.5),
        "pre_mix_gain": gain(ks[9], (DEPTH, D_MODEL)),
        "post_mix_gain": gain(ks[10], (DEPTH, D_MODEL)),
        "pre_ffn_gain": gain(ks[11], (DEPTH, D_MODEL)),
        "post_ffn_gain": gain(ks[12], (DEPTH, D_MODEL)),
        "w_ffn_gate": nrm(ks[13], (DEPTH, D_MODEL, D_FF), D_MODEL ** -0.5),
        "w_ffn_up": nrm(ks[14], (DEPTH, D_MODEL, D_FF), D_MODEL ** -0.5),
        "w_ffn_down": nrm(ks[15], (DEPTH, D_FF, D_MODEL), D_FF ** -0.5),
        "ple_gain": gain(ks[16], (DEPTH, D_MODEL)),
        "w_ple_gate": nrm(ks[17], (DEPTH, D_MODEL, D_MODEL), D_MODEL ** -0.5),
        "w_ple_proj": nrm(ks[18], (DEPTH, D_PLE, D_MODEL), 0.5 * D_PLE ** -0.5),
    }


def reference(x, p, positions, w_in, attn_sinks, hgrn_lb_logits, attn_out_gain, hgrn_out_gain,
              w_out, pre_mix_gain, post_mix_gain, pre_ffn_gain, post_ffn_gain,
              w_ffn_gate, w_ffn_up, w_ffn_down, ple_gain, w_ple_gate, w_ple_proj):
    lb_soft = jax.nn.softmax(hgrn_lb_logits.astype(jnp.float32), axis=0)
    lower_bounds = jnp.cumsum(lb_soft, axis=0) - lb_soft[0:1]
    for i in range(DEPTH):
        h = rms_norm(x, pre_mix_gain[i])
        m = hybrid_mixer(h, positions, w_in[i], attn_sinks[i], lower_bounds[i],
                         attn_out_gain[i], hgrn_out_gain[i], w_out[i])
        x = x + rms_norm(m, post_mix_gain[i])
        h = rms_norm(x, pre_ffn_gain[i])
        f = (jax.nn.silu(h @ w_ffn_gate[i]) * (h @ w_ffn_up[i])) @ w_ffn_down[i]
        x = x + rms_norm(f, post_ffn_gain[i])
        gate = jax.nn.sigmoid(rms_norm(x, ple_gain[i]) @ w_ple_gate[i])
        x = x + (p[i] @ w_ple_proj[i]) * gate
    return x
```

```cpp
#include <hip/hip_runtime.h>
#include <hip/hip_cooperative_groups.h>
#include <cstdio>
#include <cstdint>
namespace cg = cooperative_groups;

#ifndef PH
#define PH 63
#endif
#ifndef NAIVE_MIX
#define NAIVE_MIX 1
#endif

namespace pg8 {
#define PG8_LAS __attribute__((address_space(3)))
typedef unsigned short bf16_t;
typedef short bf16x8 __attribute__((ext_vector_type(8)));
typedef float f32x4 __attribute__((ext_vector_type(4)));
typedef unsigned u32x4 __attribute__((ext_vector_type(4)));
constexpr int BM = 256, BK = 64, HALF = 128, HTB = HALF * BK * 2, STAGE_BYTES = 8 * HTB, NXCD = 8, WGM = 8;

__host__ __device__ __forceinline__ int lds_byte(int r, int c) { const int st = (r >> 4) * 2 + (c >> 5), rr = r & 15, cc = c & 31, ob = rr * 64 + cc * 2; return st * 1024 + (ob ^ (((ob >> 9) & 1) << 5)); }
__host__ __device__ __forceinline__ void stage_rc(int b, int& R, int& C) { const int st = b / 1024, sb = b % 1024, swz = sb ^ (((sb >> 9) & 1) << 5); R = (st >> 1) * 16 + swz / 64; C = (st & 1) * 32 + (swz % 64) / 2; }
__host__ __device__ __forceinline__ int perm32(int rho) { const int n = rho >> 4, i = rho & 15; return 8 * (i >> 2) + 4 * n + (i & 3); }

struct Unit { int pm, pn; };
struct Gemm { const bf16_t* A; const bf16_t* Bt; int M, N, K; };

struct StaticOrder {
    int nM, nN, nwg, G, c;
    __host__ __device__ void init(int M, int N, int G_, int c_) { nM = M / BM; nN = N / BM; nwg = nM * nN; G = G_; c = c_; }
    __host__ __device__ bool next(int i, Unit& u) const {
        const long L = (long)i * G + c; if (L >= nwg) return false;
        int wgid = (int)L; { const int q = nwg / NXCD, r = nwg % NXCD, xcd = wgid % NXCD, off = wgid / NXCD; wgid = (xcd < r ? xcd * (q + 1) : r * (q + 1) + (xcd - r) * q) + off; }
        const int nig = WGM * nN, gid = wgid / nig, fm = gid * WGM, gsz = (nM - fm) < WGM ? (nM - fm) : WGM;
        u.pm = fm + ((wgid % nig) % gsz); u.pn = (wgid % nig) / gsz; return true;
    }
    __device__ __forceinline__ void a_ready(const Unit&) const {}
    __device__ __forceinline__ void done(const Unit&) const {}
};

__device__ __forceinline__ unsigned cvt_pk_bf16(float lo, float hi) { unsigned r; asm volatile("v_cvt_pk_bf16_f32 %0, %1, %2" : "=v"(r) : "v"(lo), "v"(hi)); return r; }

template <class Epi, class Sched, bool ALIGN_EPI = false, bool SP2 = false>
__device__ __forceinline__ void gemm_phase(PG8_LAS unsigned char* lds, const Gemm g, const Sched& S, const Epi& E, int tid_in) {
    int tid_ = tid_in; asm volatile("" : "+v"(tid_));
    const int tid = tid_, wid = __builtin_amdgcn_readfirstlane(tid >> 6), lane = tid & 63, wr = wid >> 2, wc = wid & 3, fr = lane & 15, fq = lane >> 4;
    const int K = g.K, nt = K / BK;
    unsigned voffA[2], voffB[2];
#pragma unroll
    for (int i = 0; i < 2; ++i) { int R, C; stage_rc(tid * 16 + i * 8192, R, C); const int Rb = Epi::PERM ? ((R & ~31) + perm32(R & 31)) : R;
        voffA[i] = (unsigned)(R * K + C) * 2u; voffB[i] = (unsigned)(Rb * K + C) * 2u; }
    const size_t kstep = (size_t)(BK * 2);
    const size_t hstep = (size_t)HALF * K * 2;
    const size_t tstep = 2 * hstep;
    const unsigned ldsw = (unsigned)wid * 1024u;
    const int aoff = lds_byte(wr * 64 + fr, fq * 8), boff = lds_byte(wc * 32 + fr, fq * 8);
#define PG8_SA(b, h) (((b) * 2 + (h)) * HTB)
#define PG8_SB(b, h) ((4 + (b) * 2 + (h)) * HTB)
#define PG8_STAGE(bufoff, gbase, voff) do { _Pragma("unroll") for (int _i = 0; _i < 2; ++_i) \
        __builtin_amdgcn_global_load_lds((const unsigned*)((const char*)(gbase) + (voff)[_i]), (PG8_LAS unsigned*)(lds + (bufoff) + ldsw + _i * 8192), 16, 0, 0); } while (0)
#define PG8_LDA(dst, b, h) do { _Pragma("unroll") for (int m = 0; m < 4; ++m) _Pragma("unroll") for (int k = 0; k < 2; ++k) dst[m][k] = *(const PG8_LAS bf16x8*)(lds + PG8_SA(b, h) + aoff + m * 2048 + k * 1024); } while (0)
#define PG8_LDB(dst, b, h) do { _Pragma("unroll") for (int n = 0; n < 2; ++n) _Pragma("unroll") for (int k = 0; k < 2; ++k) dst[n][k] = *(const PG8_LAS bf16x8*)(lds + PG8_SB(b, h) + boff + n * 2048 + k * 1024); } while (0)
#define PG8_MMA(ai, bj, At, Bt) do { __builtin_amdgcn_s_setprio(1); _Pragma("unroll") for (int m = 0; m < 4; ++m) _Pragma("unroll") for (int n = 0; n < 2; ++n) _Pragma("unroll") for (int k = 0; k < 2; ++k) \
        acc[ai][bj][m][n] = __builtin_amdgcn_mfma_f32_16x16x32_bf16(Bt[n][k], At[m][k], acc[ai][bj][m][n], 0, 0, 0); __builtin_amdgcn_s_setprio(0); } while (0)
#define PG8_WAIT_V(n) asm volatile("s_waitcnt vmcnt(" #n ")" ::: "memory")
#define PG8_WAIT_L(n) asm volatile("s_waitcnt lgkmcnt(" #n ")" ::: "memory")
#define PG8_BAR __builtin_amdgcn_s_barrier()
#define PG8_SCHED __builtin_amdgcn_sched_barrier(0)
    Unit cur, nxt; int ui = 0;
    if (!S.next(0, cur)) return;
    f32x4 acc[2][2][4][2];
#pragma unroll
    for (int a = 0; a < 2; ++a)
#pragma unroll
        for (int b = 0; b < 2; ++b)
#pragma unroll
            for (int m = 0; m < 4; ++m)
#pragma unroll
                for (int n = 0; n < 2; ++n) acc[a][b][m][n] = (f32x4){0.f, 0.f, 0.f, 0.f};
    bf16x8 At[4][2], B0[2][2], B1[2][2];
    const char* cA = (const char*)g.A + (size_t)cur.pm * tstep; const char* cB = (const char*)g.Bt + (size_t)cur.pn * tstep;
    S.a_ready(cur);
    if constexpr (SP2) {
        PG8_STAGE(PG8_SB(0, 0), cB, voffB); PG8_STAGE(PG8_SB(0, 1), cB + hstep, voffB); PG8_STAGE(PG8_SA(0, 0), cA, voffA); PG8_STAGE(PG8_SA(0, 1), cA + hstep, voffA);
        if (wr == 1) PG8_BAR;
        PG8_WAIT_V(2); PG8_BAR;
        PG8_STAGE(PG8_SB(1, 0), cB + kstep, voffB); PG8_STAGE(PG8_SA(1, 0), cA + kstep, voffA); PG8_STAGE(PG8_SB(1, 1), cB + hstep + kstep, voffB);
        PG8_WAIT_V(6); PG8_BAR;
    } else {
        PG8_STAGE(PG8_SB(0, 0), cB, voffB); PG8_STAGE(PG8_SA(0, 0), cA, voffA); PG8_STAGE(PG8_SB(0, 1), cB + hstep, voffB); PG8_STAGE(PG8_SA(0, 1), cA + hstep, voffA);
        if (wr == 1) PG8_BAR;
        PG8_WAIT_V(4); PG8_BAR;
        PG8_STAGE(PG8_SB(1, 0), cB + kstep, voffB); PG8_STAGE(PG8_SA(1, 0), cA + kstep, voffA); PG8_STAGE(PG8_SB(1, 1), cB + hstep + kstep, voffB);
        PG8_WAIT_V(6); PG8_BAR;
    }
    for (;;) {
        const bool has_next = S.next(ui + 1, nxt);
        const char* nA = has_next ? (const char*)g.A + (size_t)nxt.pm * tstep : cA; const char* nB = has_next ? (const char*)g.Bt + (size_t)nxt.pn * tstep : cB;
        for (int t = 0; t < nt; t += 2) {
            const bool last = (t == nt - 2);
            const char* a1 = cA + (size_t)(t + 1) * kstep;
            const char* a2 = last ? nA : cA + (size_t)(t + 2) * kstep; const char* b2 = last ? nB : cB + (size_t)(t + 2) * kstep;
            const char* a3 = a2 + kstep; const char* b3 = b2 + kstep;
            if (last && has_next) S.a_ready(nxt);
            if constexpr (Epi::MID) { if (t == E.kmid) { int l2 = lane; asm volatile("" : "+v"(l2)); E.mid(acc, cur, wr, wc, l2 & 15, l2 >> 4); } }
            if constexpr (SP2) {
            PG8_LDB(B0, 0, 0); PG8_LDB(B1, 0, 1); PG8_SCHED; PG8_LDA(At, 0, 0); PG8_STAGE(PG8_SA(1, 1), a1 + hstep, voffA);
            PG8_WAIT_V(8); PG8_WAIT_L(0); PG8_BAR; PG8_MMA(0, 0, At, B0); PG8_MMA(0, 1, At, B1); PG8_BAR; PG8_SCHED;
            PG8_LDA(At, 0, 1); PG8_STAGE(PG8_SB(0, 0), b2, voffB); PG8_STAGE(PG8_SB(0, 1), b2 + hstep, voffB); PG8_STAGE(PG8_SA(0, 0), a2, voffA);
            PG8_WAIT_V(8); PG8_WAIT_L(0); PG8_BAR; PG8_MMA(1, 0, At, B0); PG8_MMA(1, 1, At, B1); PG8_BAR; PG8_SCHED;
            PG8_LDB(B0, 1, 0); PG8_LDB(B1, 1, 1); PG8_SCHED; PG8_LDA(At, 1, 0); PG8_STAGE(PG8_SA(0, 1), a2 + hstep, voffA);
            PG8_WAIT_V(8); PG8_WAIT_L(0); PG8_BAR; PG8_MMA(0, 0, At, B0); PG8_MMA(0, 1, At, B1); PG8_BAR; PG8_SCHED;
            PG8_LDA(At, 1, 1); PG8_STAGE(PG8_SB(1, 0), b3, voffB); PG8_STAGE(PG8_SB(1, 1), b3 + hstep, voffB); PG8_STAGE(PG8_SA(1, 0), a3, voffA);
            PG8_WAIT_V(8); PG8_WAIT_L(0); PG8_BAR; PG8_MMA(1, 0, At, B0); PG8_MMA(1, 1, At, B1); PG8_BAR; PG8_SCHED;
            } else {
            PG8_LDB(B0, 0, 0); PG8_SCHED; PG8_LDA(At, 0, 0); PG8_STAGE(PG8_SA(1, 1), a1 + hstep, voffA);
            PG8_WAIT_L(8); PG8_BAR; PG8_WAIT_L(0); PG8_MMA(0, 0, At, B0); PG8_BAR; PG8_SCHED;
            PG8_LDB(B1, 0, 1); PG8_STAGE(PG8_SB(0, 0), b2, voffB);
            PG8_BAR; PG8_WAIT_L(0); PG8_MMA(0, 1, At, B1); PG8_BAR;
            PG8_LDA(At, 0, 1); PG8_STAGE(PG8_SA(0, 0), a2, voffA);
            PG8_BAR; PG8_WAIT_L(0); PG8_MMA(1, 0, At, B0); PG8_BAR; PG8_SCHED;
            PG8_STAGE(PG8_SB(0, 1), b2 + hstep, voffB);
            PG8_WAIT_V(6); PG8_BAR; PG8_MMA(1, 1, At, B1); PG8_BAR;
            PG8_LDB(B0, 1, 0); PG8_SCHED; PG8_LDA(At, 1, 0); PG8_STAGE(PG8_SA(0, 1), a2 + hstep, voffA);
            PG8_WAIT_L(8); PG8_BAR; PG8_WAIT_L(0); PG8_MMA(0, 0, At, B0); PG8_BAR; PG8_SCHED;
            PG8_LDB(B1, 1, 1); PG8_STAGE(PG8_SB(1, 0), b3, voffB);
            PG8_BAR; PG8_WAIT_L(0); PG8_MMA(0, 1, At, B1); PG8_BAR;
            PG8_LDA(At, 1, 1); PG8_STAGE(PG8_SA(1, 0), a3, voffA);
            PG8_BAR; PG8_WAIT_L(0); PG8_MMA(1, 0, At, B0); PG8_BAR; PG8_SCHED;
            PG8_STAGE(PG8_SB(1, 1), b3 + hstep, voffB);
            PG8_WAIT_V(6); PG8_BAR; PG8_MMA(1, 1, At, B1); PG8_BAR;
            }
        }
        if constexpr (ALIGN_EPI) { if (wr == 0) PG8_BAR; }
        { int l2 = lane; asm volatile("" : "+v"(l2)); E(acc, cur, wr, wc, l2 & 15, l2 >> 4); }
        if (!has_next) break;
#pragma unroll
        for (int a = 0; a < 2; ++a)
#pragma unroll
            for (int b = 0; b < 2; ++b)
#pragma unroll
                for (int m = 0; m < 4; ++m)
#pragma unroll
                    for (int n = 0; n < 2; ++n) acc[a][b][m][n] = (f32x4){0.f, 0.f, 0.f, 0.f};
        cur = nxt; cA = nA; cB = nB; ++ui;
        if constexpr (ALIGN_EPI) { if (wr == 1) PG8_BAR; }
    }
    PG8_WAIT_V(0);
    if constexpr (!ALIGN_EPI) { if (wr == 0) PG8_BAR; }
    PG8_BAR;
#undef PG8_SA
#undef PG8_SB
#undef PG8_STAGE
#undef PG8_LDA
#undef PG8_LDB
#undef PG8_MMA
#undef PG8_WAIT_V
#undef PG8_WAIT_L
#undef PG8_BAR
#undef PG8_SCHED
}
}

using pg8::bf16_t; using pg8::f32x4; using pg8::u32x4; using pg8::Unit; using pg8::cvt_pk_bf16;
#define LAS __attribute__((address_space(3)))
constexpr int NB = 4, SEQ = 4096, T = NB * SEQ, DM = 2048, DIN = 5632, DFF = 5632, DPLE = 256, DEPTH = 2;
constexpr float EPS = 1e-6f;
constexpr float LOG2E = 1.4426950408889634f;
constexpr float QSCALE = 0.125f * LOG2E;
constexpr int NWAVES = 8, NTHR = 512;
constexpr int LDS_BYTES = 147456;

constexpr size_t MiB = 1u << 20;
constexpr size_t WS_STAT = 0;
constexpr size_t WS_LBT = 768 * 1024;
constexpr size_t WS_CS = 1 * MiB;
constexpr size_t WS_W = 5 * MiB;
constexpr size_t WL_IN = 0, WL_OUT = 22 * MiB, WL_GU = 30 * MiB, WL_DOWN = 74 * MiB, WL_PG = 96 * MiB, WL_PP = 104 * MiB, WL_SIZE = 105 * MiB;
constexpr size_t WS_PBF = 215 * MiB;
constexpr size_t WS_HA = 231 * MiB;
constexpr size_t WS_R = 295 * MiB;
constexpr size_t WS_QH = WS_R, WS_K = WS_R + 64 * MiB, WS_V = WS_R + 72 * MiB, WS_G = WS_R + 80 * MiB, WS_KIN = WS_R + 144 * MiB, WS_HI = WS_R + 176 * MiB, WS_HG = WS_R + 208 * MiB;
constexpr size_t WS_M = WS_G, WS_ACT = WS_R, WS_F = WS_R + 176 * MiB, WS_PP = WS_R;
constexpr size_t WS_END = WS_R + 240 * MiB;
enum { SQ_X = 0, SQ_A = 2, SQ_M = 4, SQ_2 = 6, SQ_F = 8, SQ_3 = 10 };

__constant__ double c_invf[32] = {1.0, 0.7498942093324559, 0.5623413251903491, 0.4216965034285822, 0.31622776601683794, 0.23713737056616552, 0.1778279410038923, 0.1333521432163324, 0.09999999999999999, 0.07498942093324558, 0.056234132519034905, 0.042169650342858224, 0.03162277660168379, 0.023713737056616554, 0.01778279410038923, 0.013335214321633239, 0.01, 0.007498942093324559, 0.005623413251903491, 0.004216965034285822, 0.0031622776601683794, 0.002371373705661655, 0.0017782794100389228, 0.0013335214321633238, 0.001, 0.0007498942093324559, 0.000562341325190349, 0.00042169650342858224, 0.00031622776601683794, 0.00023713737056616554, 0.0001778279410038923, 0.0001333521432163324};

__device__ __forceinline__ float bf2f(unsigned h) { return __uint_as_float(h << 16); }
__device__ __forceinline__ float bflo(unsigned w) { return __uint_as_float(w << 16); }
__device__ __forceinline__ float bfhi(unsigned w) { return __uint_as_float(w & 0xffff0000u); }
__device__ __forceinline__ unsigned f2bf(float f) { unsigned u = __float_as_uint(f); return (u + 0x7fffu + ((u >> 16) & 1u)) >> 16; }
__device__ __forceinline__ unsigned pk2(float lo, float hi) { return f2bf(lo) | (f2bf(hi) << 16); }
__device__ __forceinline__ float shx(float v, int lane, int m) { return __int_as_float(__builtin_amdgcn_ds_bpermute((lane ^ m) << 2, __float_as_int(v))); }
__device__ __forceinline__ float wave_sum(float v, int lane) {
#pragma unroll
    for (int o = 1; o < 64; o <<= 1) v += shx(v, lane, o);
    return v;
}
__device__ __forceinline__ float sigmoidf_(float z) { return 1.0f / (1.0f + __expf(-z)); }
__device__ __forceinline__ float siluf_(float z) { return z / (1.0f + __expf(-z)); }

struct EpiIn {
    static constexpr bool PERM = true, MID = false;
    int kmid;
    const float* ssqX; const float* cs; const float* lb;
    bf16_t* QH; bf16_t* Kb; bf16_t* Vb; float* G; bf16_t* KIN; bf16_t* HI; bf16_t* HG;
    __device__ __forceinline__ void mid(f32x4 (&acc)[2][2][4][2], const Unit& u, int wr, int wc, int fr, int fq) const {}
    __device__ __forceinline__ void operator()(const f32x4 (&acc)[2][2][4][2], const Unit& u, int wr, int wc, int fr, int fq) const {
        const int pn = u.pn;
#pragma unroll
        for (int ai = 0; ai < 2; ++ai)
#pragma unroll
            for (int m = 0; m < 4; ++m) {
                const int row = u.pm * 256 + ai * 128 + wr * 64 + m * 16 + fr;
                const float rs = rsqrtf(ssqX[row] * (1.0f / DM) + EPS);
                if (pn <= 4) {
                    const int d0 = 8 * fq;
                    const f32x4 c0 = *(const f32x4*)(cs + (size_t)row * 64 + d0), c1 = *(const f32x4*)(cs + (size_t)row * 64 + d0 + 4);
                    const f32x4 s0 = *(const f32x4*)(cs + (size_t)row * 64 + 32 + d0), s1 = *(const f32x4*)(cs + (size_t)row * 64 + 32 + d0 + 4);
                    const float sc = (pn < 4) ? rs * QSCALE : rs;
                    const f32x4 a0 = acc[ai][0][m][0] * sc, a1 = acc[ai][0][m][1] * sc, b0 = acc[ai][1][m][0] * sc, b1 = acc[ai][1][m][1] * sc;
                    const f32x4 o10 = a0 * c0 - b0 * s0, o11 = a1 * c1 - b1 * s1, o20 = b0 * c0 + a0 * s0, o21 = b1 * c1 + a1 * s1;
                    u32x4 w1, w2;
                    w1.x = cvt_pk_bf16(o10[0], o10[1]); w1.y = cvt_pk_bf16(o10[2], o10[3]); w1.z = cvt_pk_bf16(o11[0], o11[1]); w1.w = cvt_pk_bf16(o11[2], o11[3]);
                    w2.x = cvt_pk_bf16(o20[0], o20[1]); w2.y = cvt_pk_bf16(o20[2], o20[3]); w2.z = cvt_pk_bf16(o21[0], o21[1]); w2.w = cvt_pk_bf16(o21[2], o21[3]);
                    bf16_t* dst = (pn < 4) ? (QH + (size_t)row * 2048 + (pn * 4 + wc) * 64 + d0) : (Kb + (size_t)row * 256 + wc * 64 + d0);
                    *(u32x4*)dst = w1; *(u32x4*)(dst + 32) = w2;
                } else {
#pragma unroll
                    for (int bj = 0; bj < 2; ++bj) {
                        const int cl = bj * 128 + wc * 32 + 8 * fq;
                        f32x4 v0 = acc[ai][bj][m][0] * rs, v1 = acc[ai][bj][m][1] * rs;
                        if (pn == 5) {
                            u32x4 w; w.x = cvt_pk_bf16(v0[0], v0[1]); w.y = cvt_pk_bf16(v0[2], v0[3]); w.z = cvt_pk_bf16(v1[0], v1[1]); w.w = cvt_pk_bf16(v1[2], v1[3]);
                            *(u32x4*)(Vb + (size_t)row * 256 + cl) = w;
                        } else if (pn < 10) {
                            const int c = (pn - 6) * 256 + cl;
#pragma unroll
                            for (int j = 0; j < 4; ++j) { v0[j] = siluf_(v0[j]); v1[j] = siluf_(v1[j]); }
                            u32x4 w; w.x = cvt_pk_bf16(v0[0], v0[1]); w.y = cvt_pk_bf16(v0[2], v0[3]); w.z = cvt_pk_bf16(v1[0], v1[1]); w.w = cvt_pk_bf16(v1[2], v1[3]);
                            *(u32x4*)(QH + (size_t)row * 2048 + 1024 + c) = w;
                        } else if (pn < 14) {
                            const int c = (pn - 10) * 256 + cl;
                            const f32x4 l0 = *(const f32x4*)(lb + c), l1 = *(const f32x4*)(lb + c + 4);
                            f32x4 g0, g1, k0, k1;
#pragma unroll
                            for (int j = 0; j < 4; ++j) {
                                { const float z = fminf(fmaxf(v0[j], -30.f), 30.f), e = __expf(-z), sg = 1.0f / (1.0f + e), om = 1.0f - l0[j]; g0[j] = __logf(l0[j] + om * sg); k0[j] = om * e * sg; }
                                { const float z = fminf(fmaxf(v1[j], -30.f), 30.f), e = __expf(-z), sg = 1.0f / (1.0f + e), om = 1.0f - l1[j]; g1[j] = __logf(l1[j] + om * sg); k1[j] = om * e * sg; }
                            }
                            *(f32x4*)(G + (size_t)row * 1024 + c) = g0; *(f32x4*)(G + (size_t)row * 1024 + c + 4) = g1;
                            u32x4 w; w.x = cvt_pk_bf16(k0[0], k0[1]); w.y = cvt_pk_bf16(k0[2], k0[3]); w.z = cvt_pk_bf16(k1[0], k1[1]); w.w = cvt_pk_bf16(k1[2], k1[3]);
                            *(u32x4*)(KIN + (size_t)row * 1024 + c) = w;
                        } else if (pn < 18) {
                            const int c = (pn - 14) * 256 + cl;
                            u32x4 w; w.x = cvt_pk_bf16(v0[0], v0[1]); w.y = cvt_pk_bf16(v0[2], v0[3]); w.z = cvt_pk_bf16(v1[0], v1[1]); w.w = cvt_pk_bf16(v1[2], v1[3]);
                            *(u32x4*)(HI + (size_t)row * 1024 + c) = w;
                        } else {
                            const int c = (pn - 18) * 256 + cl;
#pragma unroll
                            for (int j = 0; j < 4; ++j) { v0[j] = siluf_(v0[j]); v1[j] = siluf_(v1[j]); }
                            u32x4 w; w.x = cvt_pk_bf16(v0[0], v0[1]); w.y = cvt_pk_bf16(v0[2], v0[3]); w.z = cvt_pk_bf16(v1[0], v1[1]); w.w = cvt_pk_bf16(v1[2], v1[3]);
                            *(u32x4*)(HG + (size_t)row * 1024 + c) = w;
                        }
                    }
                }
                asm volatile("" ::: "memory");
            }
    }
};

template <bool MIDS> struct EpiRowSsq {
    static constexpr bool PERM = true, MID = MIDS;
    int kmid;
    bf16_t* O; float* ssq; const float* ssqA;
    __device__ __forceinline__ void mid(f32x4 (&acc)[2][2][4][2], const Unit& u, int wr, int wc, int fr, int fq) const {
#pragma unroll
        for (int ai = 0; ai < 2; ++ai)
#pragma unroll
            for (int m = 0; m < 4; ++m) {
                const int row = u.pm * 256 + ai * 128 + wr * 64 + m * 16 + fr;
                const float s = rsqrtf(ssqA[row] * (1.0f / 1024.0f) + EPS);
#pragma unroll
                for (int bj = 0; bj < 2; ++bj)
#pragma unroll
                    for (int n = 0; n < 2; ++n) acc[ai][bj][m][n] = acc[ai][bj][m][n] * s;
            }
    }
    __device__ __forceinline__ void operator()(const f32x4 (&acc)[2][2][4][2], const Unit& u, int wr, int wc, int fr, int fq) const {
#pragma unroll
        for (int ai = 0; ai < 2; ++ai)
#pragma unroll
            for (int m = 0; m < 4; ++m) {
                const int row = u.pm * 256 + ai * 128 + wr * 64 + m * 16 + fr;
                float q = 0.f;
#pragma unroll
                for (int bj = 0; bj < 2; ++bj) {
                    const f32x4 v0 = acc[ai][bj][m][0], v1 = acc[ai][bj][m][1];
                    q += (v0[0] * v0[0] + v0[1] * v0[1]) + (v0[2] * v0[2] + v0[3] * v0[3]) + (v1[0] * v1[0] + v1[1] * v1[1]) + (v1[2] * v1[2] + v1[3] * v1[3]);
                    u32x4 w; w.x = cvt_pk_bf16(v0[0], v0[1]); w.y = cvt_pk_bf16(v0[2], v0[3]); w.z = cvt_pk_bf16(v1[0], v1[1]); w.w = cvt_pk_bf16(v1[2], v1[3]);
                    *(u32x4*)(O + (size_t)row * 2048 + u.pn * 256 + bj * 128 + wc * 32 + 8 * fq) = w;
                }
                q += shx(q, fq * 16 + fr, 16); q += shx(q, fq * 16 + fr, 32);
                if (fq == 0) atomicAdd(ssq + row, q);
                asm volatile("" ::: "memory");
            }
    }
};

struct EpiGU {
    static constexpr bool PERM = true, MID = false;
    int kmid;
    const float* ssq2; bf16_t* ACT;
    __device__ __forceinline__ void mid(f32x4 (&acc)[2][2][4][2], const Unit& u, int wr, int wc, int fr, int fq) const {}
    __device__ __forceinline__ void operator()(const f32x4 (&acc)[2][2][4][2], const Unit& u, int wr, int wc, int fr, int fq) const {
#pragma unroll
        for (int ai = 0; ai < 2; ++ai)
#pragma unroll
            for (int m = 0; m < 4; ++m) {
                const int row = u.pm * 256 + ai * 128 + wr * 64 + m * 16 + fr;
                const float rs = rsqrtf(ssq2[row] * (1.0f / DM) + EPS);
                f32x4 o0, o1;
#pragma unroll
                for (int j = 0; j < 4; ++j) {
                    const float g0 = acc[ai][0][m][0][j] * rs, u0 = acc[ai][1][m][0][j] * rs, g1 = acc[ai][0][m][1][j] * rs, u1 = acc[ai][1][m][1][j] * rs;
                    o0[j] = siluf_(g0) * u0; o1[j] = siluf_(g1) * u1;
                }
                u32x4 w; w.x = cvt_pk_bf16(o0[0], o0[1]); w.y = cvt_pk_bf16(o0[2], o0[3]); w.z = cvt_pk_bf16(o1[0], o1[1]); w.w = cvt_pk_bf16(o1[2], o1[3]);
                *(u32x4*)(ACT + (size_t)row * DFF + u.pn * 128 + wc * 32 + 8 * fq) = w;
                asm volatile("" ::: "memory");
            }
    }
};

struct EpiPlain {
    static constexpr bool PERM = true, MID = false;
    int kmid;
    bf16_t* O;
    __device__ __forceinline__ void mid(f32x4 (&acc)[2][2][4][2], const Unit& u, int wr, int wc, int fr, int fq) const {}
    __device__ __forceinline__ void operator()(const f32x4 (&acc)[2][2][4][2], const Unit& u, int wr, int wc, int fr, int fq) const {
#pragma unroll
        for (int ai = 0; ai < 2; ++ai)
#pragma unroll
            for (int m = 0; m < 4; ++m) {
                const int row = u.pm * 256 + ai * 128 + wr * 64 + m * 16 + fr;
#pragma unroll
                for (int bj = 0; bj < 2; ++bj) {
                    const f32x4 v0 = acc[ai][bj][m][0], v1 = acc[ai][bj][m][1];
                    u32x4 w; w.x = cvt_pk_bf16(v0[0], v0[1]); w.y = cvt_pk_bf16(v0[2], v0[3]); w.z = cvt_pk_bf16(v1[0], v1[1]); w.w = cvt_pk_bf16(v1[2], v1[3]);
                    *(u32x4*)(O + (size_t)row * 2048 + u.pn * 256 + bj * 128 + wc * 32 + 8 * fq) = w;
                }
                asm volatile("" ::: "memory");
            }
    }
};

struct EpiPle {
    static constexpr bool PERM = true, MID = false;
    int kmid;
    const float* ssq3; const bf16_t* PP; float* X; bf16_t* HA; float* ssqN; int has_next;
    __device__ __forceinline__ void mid(f32x4 (&acc)[2][2][4][2], const Unit& u, int wr, int wc, int fr, int fq) const {}
    __device__ __forceinline__ void operator()(const f32x4 (&acc)[2][2][4][2], const Unit& u, int wr, int wc, int fr, int fq) const {
#pragma unroll
        for (int ai = 0; ai < 2; ++ai)
#pragma unroll
            for (int m = 0; m < 4; ++m) {
                const int row = u.pm * 256 + ai * 128 + wr * 64 + m * 16 + fr;
                const float rs = rsqrtf(ssq3[row] * (1.0f / DM) + EPS);
                float q = 0.f;
#pragma unroll
                for (int bj = 0; bj < 2; ++bj) {
                    const size_t off = (size_t)row * 2048 + u.pn * 256 + bj * 128 + wc * 32 + 8 * fq;
                    const u32x4 pw = *(const u32x4*)(PP + off);
                    f32x4 x0 = *(const f32x4*)(X + off), x1 = *(const f32x4*)(X + off + 4);
                    const f32x4 v0 = acc[ai][bj][m][0] * rs, v1 = acc[ai][bj][m][1] * rs;
                    x0[0] += bflo(pw.x) * sigmoidf_(v0[0]); x0[1] += bfhi(pw.x) * sigmoidf_(v0[1]); x0[2] += bflo(pw.y) * sigmoidf_(v0[2]); x0[3] += bfhi(pw.y) * sigmoidf_(v0[3]);
                    x1[0] += bflo(pw.z) * sigmoidf_(v1[0]); x1[1] += bfhi(pw.z) * sigmoidf_(v1[1]); x1[2] += bflo(pw.w) * sigmoidf_(v1[2]); x1[3] += bfhi(pw.w) * sigmoidf_(v1[3]);
                    *(f32x4*)(X + off) = x0; *(f32x4*)(X + off + 4) = x1;
                    if (has_next) {
                        q += (x0[0] * x0[0] + x0[1] * x0[1]) + (x0[2] * x0[2] + x0[3] * x0[3]) + (x1[0] * x1[0] + x1[1] * x1[1]) + (x1[2] * x1[2] + x1[3] * x1[3]);
                        u32x4 w; w.x = cvt_pk_bf16(x0[0], x0[1]); w.y = cvt_pk_bf16(x0[2], x0[3]); w.z = cvt_pk_bf16(x1[0], x1[1]); w.w = cvt_pk_bf16(x1[2], x1[3]);
                        *(u32x4*)(HA + off) = w;
                    }
                }
                if (has_next) { q += shx(q, fq * 16 + fr, 16); q += shx(q, fq * 16 + fr, 32); if (fq == 0) atomicAdd(ssqN + row, q); }
                asm volatile("" ::: "memory");
            }
    }
};

__device__ __forceinline__ void tr_item(const float* W, int ldw, int K, int k0, int n0, bf16_t* WT, int prow0, const float* gain, LAS float* scr, int lane) {
#pragma unroll 8
    for (int i = 0; i < 32; ++i) { const int kk = 2 * i + (lane >> 5); float w = W[(size_t)(k0 + kk) * ldw + n0 + (lane & 31)]; if (gain) w *= gain[k0 + kk]; scr[kk * 33 + (lane & 31)] = w; }
    asm volatile("s_waitcnt lgkmcnt(0)" ::: "memory");
    const int c = lane & 7;
#pragma unroll
    for (int j = 0; j < 4; ++j) { const int n = (lane >> 3) + 8 * j; const LAS float* s = scr + (8 * c) * 33 + n;
        u32x4 o; o.x = pk2(s[0 * 33], s[1 * 33]); o.y = pk2(s[2 * 33], s[3 * 33]); o.z = pk2(s[4 * 33], s[5 * 33]); o.w = pk2(s[6 * 33], s[7 * 33]);
        *(u32x4*)(WT + (size_t)(prow0 + n) * K + k0 + 8 * c) = o; }
    asm volatile("s_waitcnt lgkmcnt(0)" ::: "memory");
}

struct Args { const void* in[19]; float* out; unsigned char* ws; };

__device__ __forceinline__ void row_phase(const float* xsrc, float* xdst, const bf16_t* Mb, const float* ssqIn, const float* gain, bf16_t* HA, float* ssqOut, int gw, int ngw, int lane) {
    for (int row = gw; row < T; row += ngw) {
        const float rm = rsqrtf(ssqIn[row] * (1.0f / DM) + EPS);
        float ss = 0.f;
#pragma unroll
        for (int j = 0; j < 4; ++j) {
            const int c = j * 512 + lane * 8; const size_t off = (size_t)row * 2048 + c;
            const u32x4 mv = *(const u32x4*)(Mb + off);
            f32x4 x0 = *(const f32x4*)(xsrc + off), x1 = *(const f32x4*)(xsrc + off + 4);
            const f32x4 g0 = *(const f32x4*)(gain + c), g1 = *(const f32x4*)(gain + c + 4);
            x0[0] += bflo(mv.x) * rm * g0[0]; x0[1] += bfhi(mv.x) * rm * g0[1]; x0[2] += bflo(mv.y) * rm * g0[2]; x0[3] += bfhi(mv.y) * rm * g0[3];
            x1[0] += bflo(mv.z) * rm * g1[0]; x1[1] += bfhi(mv.z) * rm * g1[1]; x1[2] += bflo(mv.w) * rm * g1[2]; x1[3] += bfhi(mv.w) * rm * g1[3];
            *(f32x4*)(xdst + off) = x0; *(f32x4*)(xdst + off + 4) = x1;
            u32x4 w; w.x = pk2(x0[0], x0[1]); w.y = pk2(x0[2], x0[3]); w.z = pk2(x1[0], x1[1]); w.w = pk2(x1[2], x1[3]);
            *(u32x4*)(HA + off) = w;
            ss += (x0[0] * x0[0] + x0[1] * x0[1]) + (x0[2] * x0[2] + x0[3] * x0[3]) + (x1[0] * x1[0] + x1[1] * x1[1]) + (x1[2] * x1[2] + x1[3] * x1[3]);
        }
        ss = wave_sum(ss, lane);
        if (lane == 0) ssqOut[row] = ss;
    }
}

__device__ __forceinline__ void attn_naive(bf16_t* QH, const bf16_t* Kb, const bf16_t* Vb, const float* sinks, float* ssqA, int gtid, int nthr) {
    for (int item = gtid; item < T * 16; item += nthr) {
        const int head = item / T, row = item % T, b = row / SEQ, t = row % SEQ, hk = head >> 2;
        float q[64], acc[64];
        const u32x4* qp = (const u32x4*)(QH + (size_t)row * 2048 + head * 64);
#pragma unroll
        for (int c = 0; c < 8; ++c) { const u32x4 w = qp[c]; q[8 * c] = bflo(w.x); q[8 * c + 1] = bfhi(w.x); q[8 * c + 2] = bflo(w.y); q[8 * c + 3] = bfhi(w.y); q[8 * c + 4] = bflo(w.z); q[8 * c + 5] = bfhi(w.z); q[8 * c + 6] = bflo(w.w); q[8 * c + 7] = bfhi(w.w); }
#pragma unroll
        for (int d = 0; d < 64; ++d) acc[d] = 0.f;
        float mx = sinks[head] * LOG2E, l = 1.0f;
        const int j0 = t - 127 < 0 ? 0 : t - 127;
        for (int j = j0; j <= t; ++j) {
            const size_t kr = (size_t)(b * SEQ + j) * 256 + hk * 64;
            const u32x4* kp = (const u32x4*)(Kb + kr);
            float s = 0.f;
#pragma unroll
            for (int c = 0; c < 8; ++c) { const u32x4 w = kp[c]; s += q[8 * c] * bflo(w.x) + q[8 * c + 1] * bfhi(w.x) + q[8 * c + 2] * bflo(w.y) + q[8 * c + 3] * bfhi(w.y) + q[8 * c + 4] * bflo(w.z) + q[8 * c + 5] * bfhi(w.z) + q[8 * c + 6] * bflo(w.w) + q[8 * c + 7] * bfhi(w.w); }
            if (s > mx) { const float cf = exp2f(mx - s); l *= cf;
#pragma unroll
                for (int d = 0; d < 64; ++d) acc[d] *= cf;
                mx = s; }
            const float p = exp2f(s - mx); l += p;
            const u32x4* vp = (const u32x4*)(Vb + kr);
#pragma unroll
            for (int c = 0; c < 8; ++c) { const u32x4 w = vp[c]; acc[8 * c] += p * bflo(w.x); acc[8 * c + 1] += p * bfhi(w.x); acc[8 * c + 2] += p * bflo(w.y); acc[8 * c + 3] += p * bfhi(w.y); acc[8 * c + 4] += p * bflo(w.z); acc[8 * c + 5] += p * bfhi(w.z); acc[8 * c + 6] += p * bflo(w.w); acc[8 * c + 7] += p * bfhi(w.w); }
        }
        const float il = 1.0f / l; float ss = 0.f;
        u32x4* op = (u32x4*)(QH + (size_t)row * 2048 + head * 64);
#pragma unroll
        for (int c = 0; c < 8; ++c) {
            float o[8];
#pragma unroll
            for (int e = 0; e < 8; ++e) { o[e] = acc[8 * c + e] * il; ss += o[e] * o[e]; }
            u32x4 w; w.x = pk2(o[0], o[1]); w.y = pk2(o[2], o[3]); w.z = pk2(o[4], o[5]); w.w = pk2(o[6], o[7]); op[c] = w;
        }
        atomicAdd(ssqA + row, ss);
    }
}

__device__ __forceinline__ void hgrn_naive(const bf16_t* QH, const bf16_t* KIN, const float* G, const bf16_t* HI, float* tmpO, int item, int lane) {
    const int bh = item >> 1, b = bh >> 3, h = bh & 7, v = (item & 1) * 64 + lane;
    float S[128];
#pragma unroll
    for (int k = 0; k < 128; ++k) S[k] = 0.f;
    int z = 0; asm volatile("v_mov_b32 %0, 0" : "=v"(z));
    for (int t = 0; t < SEQ; ++t) {
        const size_t row = (size_t)b * SEQ + t;
        const float vv = bf2f(HI[row * 1024 + h * 128 + v]);
        const u32x4* qp = (const u32x4*)(QH + row * 2048 + 1024 + h * 128 + z);
        const u32x4* kp = (const u32x4*)(KIN + row * 1024 + h * 128 + z);
        const f32x4* gp = (const f32x4*)(G + row * 1024 + h * 128 + z);
        float o = 0.f;
#pragma unroll
        for (int c = 0; c < 16; ++c) {
            const u32x4 qw = qp[c], kw = kp[c]; const f32x4 g0 = gp[2 * c], g1 = gp[2 * c + 1];
            const float qq[8] = {bflo(qw.x), bfhi(qw.x), bflo(qw.y), bfhi(qw.y), bflo(qw.z), bfhi(qw.z), bflo(qw.w), bfhi(qw.w)};
            const float kk[8] = {bflo(kw.x), bfhi(kw.x), bflo(kw.y), bfhi(kw.y), bflo(kw.z), bfhi(kw.z), bflo(kw.w), bfhi(kw.w)};
            const float gg[8] = {g0[0], g0[1], g0[2], g0[3], g1[0], g1[1], g1[2], g1[3]};
#pragma unroll
            for (int e = 0; e < 8; ++e) { const float f = __expf(gg[e]); S[8 * c + e] = f * S[8 * c + e] + kk[e] * vv; o += S[8 * c + e] * qq[e]; }
        }
        tmpO[row * 1024 + h * 128 + v] = o;
    }
}
__device__ __forceinline__ void hgrn_norm_naive(const float* tmpO, const bf16_t* HG, bf16_t* QH, int gw, int ngw, int lane) {
    for (int row = gw; row < T; row += ngw) {
        const size_t off = (size_t)row * 1024 + lane * 16;
        f32x4 o[4]; float ss = 0.f;
#pragma unroll
        for (int j = 0; j < 4; ++j) { o[j] = *(const f32x4*)(tmpO + off + 4 * j); ss += (o[j][0] * o[j][0] + o[j][1] * o[j][1]) + (o[j][2] * o[j][2] + o[j][3] * o[j][3]); }
        ss += shx(ss, lane, 1); ss += shx(ss, lane, 2); ss += shx(ss, lane, 4);
        const float r = rsqrtf(ss * (1.0f / 128.0f) + EPS);
        const u32x4 g0 = *(const u32x4*)(HG + off), g1 = *(const u32x4*)(HG + off + 8);
        u32x4 w0, w1;
        w0.x = pk2(o[0][0] * r * bflo(g0.x), o[0][1] * r * bfhi(g0.x)); w0.y = pk2(o[0][2] * r * bflo(g0.y), o[0][3] * r * bfhi(g0.y));
        w0.z = pk2(o[1][0] * r * bflo(g0.z), o[1][1] * r * bfhi(g0.z)); w0.w = pk2(o[1][2] * r * bflo(g0.w), o[1][3] * r * bfhi(g0.w));
        w1.x = pk2(o[2][0] * r * bflo(g1.x), o[2][1] * r * bfhi(g1.x)); w1.y = pk2(o[2][2] * r * bflo(g1.y), o[2][3] * r * bfhi(g1.y));
        w1.z = pk2(o[3][0] * r * bflo(g1.z), o[3][1] * r * bfhi(g1.z)); w1.w = pk2(o[3][2] * r * bflo(g1.w), o[3][3] * r * bfhi(g1.w));
        bf16_t* dst = QH + (size_t)row * 2048 + 1024 + lane * 16;
        *(u32x4*)dst = w0; *(u32x4*)(dst + 8) = w1;
    }
}

__global__ void __launch_bounds__(NTHR, 2) fwd_megakernel(Args args) {
    extern __shared__ __attribute__((aligned(16))) unsigned char lds_raw[];
    LAS unsigned char* lds = (LAS unsigned char*)lds_raw;
    cg::grid_group grid = cg::this_grid();
    const int G = gridDim.x, bx = blockIdx.x, ngw = G * NWAVES, nthr = G * NTHR;
    const int wave = __builtin_amdgcn_readfirstlane((int)threadIdx.x >> 6);
#define PHASE_IDS() int lane_; asm volatile("v_mbcnt_lo_u32_b32 %0, -1, 0\n\tv_mbcnt_hi_u32_b32 %0, -1, %0" : "=v"(lane_)); const int lane = lane_, tid = wave * 64 + lane, gw = bx * NWAVES + wave, gtid = bx * NTHR + tid; (void)gw; (void)gtid
    unsigned char* ws = args.ws;
    const float* x_in = (const float*)args.in[0]; const float* p_in = (const float*)args.in[1]; const int* pos = (const int*)args.in[2];
    const float* w_in = (const float*)args.in[3]; const float* sinks = (const float*)args.in[4]; const float* lb_logits = (const float*)args.in[5];
    const float* attn_gain = (const float*)args.in[6]; const float* hgrn_gain = (const float*)args.in[7]; const float* w_out = (const float*)args.in[8];
    const float* pre_mix = (const float*)args.in[9]; const float* post_mix = (const float*)args.in[10]; const float* pre_ffn = (const float*)args.in[11]; const float* post_ffn = (const float*)args.in[12];
    const float* w_gate = (const float*)args.in[13]; const float* w_up = (const float*)args.in[14]; const float* w_down = (const float*)args.in[15];
    const float* ple_gain = (const float*)args.in[16]; const float* w_pg = (const float*)args.in[17]; const float* w_pp = (const float*)args.in[18];
    float* out = args.out;
    float* stat = (float*)(ws + WS_STAT); float* lbt = (float*)(ws + WS_LBT); float* cs = (float*)(ws + WS_CS);
    bf16_t* PBF = (bf16_t*)(ws + WS_PBF); bf16_t* HA = (bf16_t*)(ws + WS_HA); float* tmpO = (float*)(ws + WS_HA);
    bf16_t* QH = (bf16_t*)(ws + WS_QH); bf16_t* Kb = (bf16_t*)(ws + WS_K); bf16_t* Vb = (bf16_t*)(ws + WS_V); float* Gb = (float*)(ws + WS_G);
    bf16_t* KIN = (bf16_t*)(ws + WS_KIN); bf16_t* HI = (bf16_t*)(ws + WS_HI); bf16_t* HG = (bf16_t*)(ws + WS_HG);
    bf16_t* Mb = (bf16_t*)(ws + WS_M); bf16_t* ACT = (bf16_t*)(ws + WS_ACT); bf16_t* Fb = (bf16_t*)(ws + WS_F); bf16_t* PP = (bf16_t*)(ws + WS_PP);

    {
        PHASE_IDS();
        LAS float* scr = (LAS float*)(lds + wave * 16384);
        constexpr int I_IN = 32 * 176, I_OUT = 32 * 64, I_G = 32 * 176, I_D = 88 * 64, I_PG = 32 * 64, I_PP = 4 * 64;
        constexpr int I_L = I_IN + I_OUT + 2 * I_G + I_D + I_PG + I_PP;
        for (int it = gw; it < DEPTH * I_L; it += ngw) {
            const int l = it / I_L; int r = it % I_L;
            unsigned char* wl = ws + WS_W + (size_t)l * WL_SIZE;
            if (r < I_IN) {
                const int kb = r / 176, nb = r % 176, n0 = nb * 32, pn = n0 >> 8; int prow0 = n0;
                if (pn <= 4) { const int lc = n0 & 255; prow0 = (pn << 8) + 128 * ((lc >> 5) & 1) + 32 * ((lc >> 6) & 3); }
                tr_item(w_in + (size_t)l * DM * DIN, DIN, DM, kb * 64, n0, (bf16_t*)(wl + WL_IN), prow0, pre_mix + l * DM, scr, lane); continue; }
            r -= I_IN;
            if (r < I_OUT) {
                const int kb = r / 64, nb = r % 64; const int k0 = kb * 64;
                const float* gp = (k0 < 1024) ? (attn_gain + l * 1024) : (hgrn_gain + l * 1024 - 1024);
                tr_item(w_out + (size_t)l * DM * DM, DM, DM, k0, nb * 32, (bf16_t*)(wl + WL_OUT), nb * 32, gp, scr, lane); continue; }
            r -= I_OUT;
            if (r < 2 * I_G) {
                const int up = r >= I_G; if (up) r -= I_G;
                const int kb = r / 176, nb = r % 176, n0 = nb * 32; const int prow0 = 256 * (n0 >> 7) + (n0 & 127) + (up ? 128 : 0);
                tr_item((up ? w_up : w_gate) + (size_t)l * DM * DFF, DFF, DM, kb * 64, n0, (bf16_t*)(wl + WL_GU), prow0, pre_ffn + l * DM, scr, lane); continue; }
            r -= 2 * I_G;
            if (r < I_D) { const int kb = r / 64, nb = r % 64;
                tr_item(w_down + (size_t)l * DFF * DM, DM, DFF, kb * 64, nb * 32, (bf16_t*)(wl + WL_DOWN), nb * 32, nullptr, scr, lane); continue; }
            r -= I_D;
            if (r < I_PG) { const int kb = r / 64, nb = r % 64;
                tr_item(w_pg + (size_t)l * DM * DM, DM, DM, kb * 64, nb * 32, (bf16_t*)(wl + WL_PG), nb * 32, ple_gain + l * DM, scr, lane); continue; }
            r -= I_PG;
            { const int kb = r / 64, nb = r % 64;
                tr_item(w_pp + (size_t)l * DPLE * DM, DM, DPLE, kb * 64, nb * 32, (bf16_t*)(wl + WL_PP), nb * 32, nullptr, scr, lane); }
        }
        for (int i = gtid; i < 12 * T; i += nthr) stat[i] = 0.f;
        for (int i = gtid; i < 1024; i += nthr) {
            const float l0 = lb_logits[i], l1 = lb_logits[1024 + i];
            lbt[i] = 0.f; lbt[1024 + i] = 1.0f / (1.0f + expf(l0 - l1));
        }
        for (int i = gtid; i < T * 32; i += nthr) {
            const int row = i >> 5, d = i & 31;
            const double rev = (double)pos[row] * c_invf[d] * 0.15915494309189535;
            const float fr = (float)(rev - rint(rev));
            cs[(size_t)row * 64 + d] = __builtin_amdgcn_cosf(fr); cs[(size_t)row * 64 + 32 + d] = __builtin_amdgcn_sinf(fr);
        }
        for (int i = gtid; i < DEPTH * T * DPLE / 8; i += nthr) {
            const f32x4 a = *(const f32x4*)(p_in + (size_t)i * 8), b = *(const f32x4*)(p_in + (size_t)i * 8 + 4);
            u32x4 w; w.x = pk2(a[0], a[1]); w.y = pk2(a[2], a[3]); w.z = pk2(b[0], b[1]); w.w = pk2(b[2], b[3]);
            *(u32x4*)(PBF + (size_t)i * 8) = w;
        }
    }
    grid.sync();
    { PHASE_IDS();
    for (int row = gw; row < T; row += ngw) {
        float ss = 0.f;
#pragma unroll
        for (int j = 0; j < 4; ++j) {
            const int c = j * 512 + lane * 8; const size_t off = (size_t)row * 2048 + c;
            const f32x4 x0 = *(const f32x4*)(x_in + off), x1 = *(const f32x4*)(x_in + off + 4);
            u32x4 w; w.x = pk2(x0[0], x0[1]); w.y = pk2(x0[2], x0[3]); w.z = pk2(x1[0], x1[1]); w.w = pk2(x1[2], x1[3]);
            *(u32x4*)(HA + off) = w;
            ss += (x0[0] * x0[0] + x0[1] * x0[1]) + (x0[2] * x0[2] + x0[3] * x0[3]) + (x1[0] * x1[0] + x1[1] * x1[1]) + (x1[2] * x1[2] + x1[3] * x1[3]);
        }
        ss = wave_sum(ss, lane);
        if (lane == 0) stat[(SQ_X + 0) * T + row] = ss;
    } }
    grid.sync();

    for (int l = 0; l < DEPTH; ++l) {
        unsigned char* wl = ws + WS_W + (size_t)l * WL_SIZE;
        float* ssqX = stat + (SQ_X + l) * T; float* ssqA = stat + (SQ_A + l) * T; float* ssqM = stat + (SQ_M + l) * T;
        float* ssq2 = stat + (SQ_2 + l) * T; float* ssqF = stat + (SQ_F + l) * T; float* ssq3 = stat + (SQ_3 + l) * T;
        {
            PHASE_IDS(); pg8::Gemm g{l == 0 ? HA : (const bf16_t*)(ws + WS_W + (size_t)(l - 1) * WL_SIZE), (const bf16_t*)(wl + WL_IN), T, DIN, DM}; pg8::StaticOrder S; S.init(T, DIN, G, bx);
            EpiIn E{0, ssqX, cs, lbt + l * 1024, QH, Kb, Vb, Gb, KIN, HI, HG};
            if (PH & 1) pg8::gemm_phase<EpiIn, pg8::StaticOrder, true, true>(lds, g, S, E, tid);
        }
        grid.sync();
#if NAIVE_MIX
        { PHASE_IDS();
        if (bx < 64 && wave == 0) hgrn_naive(QH, KIN, Gb, HI, tmpO, bx, lane);
        attn_naive(QH, Kb, Vb, sinks + l * 16, ssqA, gtid, nthr); }
        grid.sync();
        { PHASE_IDS(); hgrn_norm_naive(tmpO, HG, QH, gw, ngw, lane); }
        grid.sync();
#endif
        {
            PHASE_IDS(); pg8::Gemm g{QH, (const bf16_t*)(wl + WL_OUT), T, DM, DM}; pg8::StaticOrder S; S.init(T, DM, G, bx);
            EpiRowSsq<true> E{16, Mb, ssqM, ssqA};
            if (PH & 2) pg8::gemm_phase<EpiRowSsq<true>, pg8::StaticOrder, true, true>(lds, g, S, E, tid);
        }
        grid.sync();
        { PHASE_IDS(); row_phase(l == 0 ? x_in : out, out, Mb, ssqM, post_mix + l * DM, HA, ssq2, gw, ngw, lane); }
        grid.sync();
        {
            PHASE_IDS(); pg8::Gemm g{HA, (const bf16_t*)(wl + WL_GU), T, 2 * DFF, DM}; pg8::StaticOrder S; S.init(T, 2 * DFF, G, bx);
            EpiGU E{0, ssq2, ACT};
            if (PH & 4) pg8::gemm_phase<EpiGU, pg8::StaticOrder, true, true>(lds, g, S, E, tid);
        }
        grid.sync();
        {
            PHASE_IDS(); pg8::Gemm g{ACT, (const bf16_t*)(wl + WL_DOWN), T, DM, DFF}; pg8::StaticOrder S; S.init(T, DM, G, bx);
            EpiRowSsq<false> E{0, Fb, ssqF, nullptr};
            if (PH & 8) pg8::gemm_phase<EpiRowSsq<false>, pg8::StaticOrder, true, true>(lds, g, S, E, tid);
        }
        grid.sync();
        { PHASE_IDS(); row_phase(out, out, Fb, ssqF, post_ffn + l * DM, HA, ssq3, gw, ngw, lane); }
        grid.sync();
        {
            PHASE_IDS(); int kpp = DPLE; asm volatile("" : "+s"(kpp)); pg8::Gemm g{PBF + (size_t)l * T * DPLE, (const bf16_t*)(wl + WL_PP), T, DM, kpp}; pg8::StaticOrder S; S.init(T, DM, G, bx);
            EpiPlain E{0, PP};
            if (PH & 16) pg8::gemm_phase<EpiPlain, pg8::StaticOrder, true, true>(lds, g, S, E, tid);
        }
        {
            PHASE_IDS(); pg8::Gemm g{HA, (const bf16_t*)(wl + WL_PG), T, DM, DM}; pg8::StaticOrder S; S.init(T, DM, G, bx);
            EpiPle E{0, ssq3, PP, out, (bf16_t*)wl, stat + (SQ_X + (l + 1 < DEPTH ? l + 1 : 0)) * T, l + 1 < DEPTH ? 1 : 0};
            if (PH & 32) pg8::gemm_phase<EpiPle, pg8::StaticOrder, true, true>(lds, g, S, E, tid);
        }
        if (l + 1 < DEPTH) grid.sync();
    }
}

extern "C" void kernel_launch(void* const* d_in, const int* in_sizes, int n_in, void* d_out, int out_size, void* d_ws, size_t ws_size, hipStream_t stream) {
    static int grid = 0;
    if (grid == 0) {
        if (n_in != 19 || out_size != T * DM || ws_size < WS_END) { fprintf(stderr, "kernel_launch: unexpected shapes (n_in %d out %d ws %zu need %zu)\n", n_in, out_size, ws_size, (size_t)WS_END); grid = -1; return; }
        int dev = 0, cus = 0, per_cu = 0;
        hipGetDevice(&dev);
        hipDeviceGetAttribute(&cus, hipDeviceAttributeMultiprocessorCount, dev);
        if (hipFuncSetAttribute((const void*)fwd_megakernel, hipFuncAttributeMaxDynamicSharedMemorySize, LDS_BYTES) != hipSuccess) { fprintf(stderr, "kernel_launch: hipFuncSetAttribute failed\n"); grid = -1; return; }
        if (hipOccupancyMaxActiveBlocksPerMultiprocessor(&per_cu, (const void*)fwd_megakernel, NTHR, LDS_BYTES) != hipSuccess || per_cu < 1) { fprintf(stderr, "kernel_launch: occupancy query gave %d\n", per_cu); per_cu = 1; }
        (void)hipGetLastError();
        grid = cus * per_cu;
    }
    if (grid < 0) return;
    Args a{};
    for (int i = 0; i < 19; ++i) a.in[i] = d_in[i];
    a.out = (float*)d_out; a.ws = (unsigned char*)d_ws;
    void* kargs[] = {&a};
    hipError_t e = hipLaunchCooperativeKernel((const void*)fwd_megakernel, dim3(grid), dim3(NTHR), kargs, LDS_BYTES, stream);
    if (e != hipSuccess) fprintf(stderr, "cooperative launch failed: %s (grid %d)\n", hipGetErrorString(e), grid);
}
```

```cpp
#include <hip/hip_runtime.h>
#include <hip/hip_cooperative_groups.h>
#include <cstdio>
#include <cstdint>
namespace cg = cooperative_groups;

#ifndef PH
#define PH 63
#endif
#ifndef NAIVE_MIX
#define NAIVE_MIX 0
#endif

namespace pg8 {
#define PG8_LAS __attribute__((address_space(3)))
typedef unsigned short bf16_t;
typedef short bf16x8 __attribute__((ext_vector_type(8)));
typedef float f32x4 __attribute__((ext_vector_type(4)));
typedef unsigned u32x4 __attribute__((ext_vector_type(4)));
constexpr int BM = 256, BK = 64, HALF = 128, HTB = HALF * BK * 2, STAGE_BYTES = 8 * HTB, NXCD = 8, WGM = 8;

__host__ __device__ __forceinline__ int lds_byte(int r, int c) { const int st = (r >> 4) * 2 + (c >> 5), rr = r & 15, cc = c & 31, ob = rr * 64 + cc * 2; return st * 1024 + (ob ^ (((ob >> 9) & 1) << 5)); }
__host__ __device__ __forceinline__ void stage_rc(int b, int& R, int& C) { const int st = b / 1024, sb = b % 1024, swz = sb ^ (((sb >> 9) & 1) << 5); R = (st >> 1) * 16 + swz / 64; C = (st & 1) * 32 + (swz % 64) / 2; }
__host__ __device__ __forceinline__ int perm32(int rho) { const int n = rho >> 4, i = rho & 15; return 8 * (i >> 2) + 4 * n + (i & 3); }

struct Unit { int pm, pn; };
struct Gemm { const bf16_t* A; const bf16_t* Bt; int M, N, K; };

struct StaticOrder {
    int nM, nN, nwg, G, c;
    __host__ __device__ void init(int M, int N, int G_, int c_) { nM = M / BM; nN = N / BM; nwg = nM * nN; G = G_; c = c_; }
    __host__ __device__ bool next(int i, Unit& u) const {
        const long L = (long)i * G + c; if (L >= nwg) return false;
        int wgid = (int)L; { const int q = nwg / NXCD, r = nwg % NXCD, xcd = wgid % NXCD, off = wgid / NXCD; wgid = (xcd < r ? xcd * (q + 1) : r * (q + 1) + (xcd - r) * q) + off; }
        const int nig = WGM * nN, gid = wgid / nig, fm = gid * WGM, gsz = (nM - fm) < WGM ? (nM - fm) : WGM;
        u.pm = fm + ((wgid % nig) % gsz); u.pn = (wgid % nig) / gsz; return true;
    }
    __device__ __forceinline__ void a_ready(const Unit&) const {}
    __device__ __forceinline__ void done(const Unit&) const {}
};

__device__ __forceinline__ unsigned cvt_pk_bf16(float lo, float hi) { unsigned r; asm volatile("v_cvt_pk_bf16_f32 %0, %1, %2" : "=v"(r) : "v"(lo), "v"(hi)); return r; }

template <class Epi, class Sched, bool ALIGN_EPI = false, bool SP2 = false>
__device__ __forceinline__ void gemm_phase(PG8_LAS unsigned char* lds, const Gemm g, const Sched& S, const Epi& E, int tid_in) {
    int tid_ = tid_in; asm volatile("" : "+v"(tid_));
    const int tid = tid_, wid = __builtin_amdgcn_readfirstlane(tid >> 6), lane = tid & 63, wr = wid >> 2, wc = wid & 3, fr = lane & 15, fq = lane >> 4;
    const int K = g.K, nt = K / BK;
    unsigned voffA[2], voffB[2];
#pragma unroll
    for (int i = 0; i < 2; ++i) { int R, C; stage_rc(tid * 16 + i * 8192, R, C); const int Rb = Epi::PERM ? ((R & ~31) + perm32(R & 31)) : R;
        voffA[i] = (unsigned)(R * K + C) * 2u; voffB[i] = (unsigned)(Rb * K + C) * 2u; }
    const size_t kstep = (size_t)(BK * 2);
    const size_t hstep = (size_t)HALF * K * 2;
    const size_t tstep = 2 * hstep;
    const unsigned ldsw = (unsigned)wid * 1024u;
    const int aoff = lds_byte(wr * 64 + fr, fq * 8), boff = lds_byte(wc * 32 + fr, fq * 8);
#define PG8_SA(b, h) (((b) * 2 + (h)) * HTB)
#define PG8_SB(b, h) ((4 + (b) * 2 + (h)) * HTB)
#define PG8_STAGE(bufoff, gbase, voff) do { _Pragma("unroll") for (int _i = 0; _i < 2; ++_i) \
        __builtin_amdgcn_global_load_lds((const unsigned*)((const char*)(gbase) + (voff)[_i]), (PG8_LAS unsigned*)(lds + (bufoff) + ldsw + _i * 8192), 16, 0, 0); } while (0)
#define PG8_LDA(dst, b, h) do { _Pragma("unroll") for (int m = 0; m < 4; ++m) _Pragma("unroll") for (int k = 0; k < 2; ++k) dst[m][k] = *(const PG8_LAS bf16x8*)(lds + PG8_SA(b, h) + aoff + m * 2048 + k * 1024); } while (0)
#define PG8_LDB(dst, b, h) do { _Pragma("unroll") for (int n = 0; n < 2; ++n) _Pragma("unroll") for (int k = 0; k < 2; ++k) dst[n][k] = *(const PG8_LAS bf16x8*)(lds + PG8_SB(b, h) + boff + n * 2048 + k * 1024); } while (0)
#define PG8_MMA(ai, bj, At, Bt) do { __builtin_amdgcn_s_setprio(1); _Pragma("unroll") for (int m = 0; m < 4; ++m) _Pragma("unroll") for (int n = 0; n < 2; ++n) _Pragma("unroll") for (int k = 0; k < 2; ++k) \
        acc[ai][bj][m][n] = __builtin_amdgcn_mfma_f32_16x16x32_bf16(Bt[n][k], At[m][k], acc[ai][bj][m][n], 0, 0, 0); __builtin_amdgcn_s_setprio(0); } while (0)
#define PG8_WAIT_V(n) asm volatile("s_waitcnt vmcnt(" #n ")" ::: "memory")
#define PG8_WAIT_L(n) asm volatile("s_waitcnt lgkmcnt(" #n ")" ::: "memory")
#define PG8_BAR __builtin_amdgcn_s_barrier()
#define PG8_SCHED __builtin_amdgcn_sched_barrier(0)
    Unit cur, nxt; int ui = 0;
    if (!S.next(0, cur)) return;
    f32x4 acc[2][2][4][2];
#pragma unroll
    for (int a = 0; a < 2; ++a)
#pragma unroll
        for (int b = 0; b < 2; ++b)
#pragma unroll
            for (int m = 0; m < 4; ++m)
#pragma unroll
                for (int n = 0; n < 2; ++n) acc[a][b][m][n] = (f32x4){0.f, 0.f, 0.f, 0.f};
    bf16x8 At[4][2], B0[2][2], B1[2][2];
    const char* cA = (const char*)g.A + (size_t)cur.pm * tstep; const char* cB = (const char*)g.Bt + (size_t)cur.pn * tstep;
    S.a_ready(cur);
    if constexpr (SP2) {
        PG8_STAGE(PG8_SB(0, 0), cB, voffB); PG8_STAGE(PG8_SB(0, 1), cB + hstep, voffB); PG8_STAGE(PG8_SA(0, 0), cA, voffA); PG8_STAGE(PG8_SA(0, 1), cA + hstep, voffA);
        if (wr == 1) PG8_BAR;
        PG8_WAIT_V(2); PG8_BAR;
        PG8_STAGE(PG8_SB(1, 0), cB + kstep, voffB); PG8_STAGE(PG8_SA(1, 0), cA + kstep, voffA); PG8_STAGE(PG8_SB(1, 1), cB + hstep + kstep, voffB);
        PG8_WAIT_V(6); PG8_BAR;
    } else {
        PG8_STAGE(PG8_SB(0, 0), cB, voffB); PG8_STAGE(PG8_SA(0, 0), cA, voffA); PG8_STAGE(PG8_SB(0, 1), cB + hstep, voffB); PG8_STAGE(PG8_SA(0, 1), cA + hstep, voffA);
        if (wr == 1) PG8_BAR;
        PG8_WAIT_V(4); PG8_BAR;
        PG8_STAGE(PG8_SB(1, 0), cB + kstep, voffB); PG8_STAGE(PG8_SA(1, 0), cA + kstep, voffA); PG8_STAGE(PG8_SB(1, 1), cB + hstep + kstep, voffB);
        PG8_WAIT_V(6); PG8_BAR;
    }
    for (;;) {
        const bool has_next = S.next(ui + 1, nxt);
        const char* nA = has_next ? (const char*)g.A + (size_t)nxt.pm * tstep : cA; const char* nB = has_next ? (const char*)g.Bt + (size_t)nxt.pn * tstep : cB;
        for (int t = 0; t < nt; t += 2) {
            const bool last = (t == nt - 2);
            const char* a1 = cA + (size_t)(t + 1) * kstep;
            const char* a2 = last ? nA : cA + (size_t)(t + 2) * kstep; const char* b2 = last ? nB : cB + (size_t)(t + 2) * kstep;
            const char* a3 = a2 + kstep; const char* b3 = b2 + kstep;
            if (last && has_next) S.a_ready(nxt);
            if constexpr (Epi::MID) { if (t == E.kmid) { int l2 = lane; asm volatile("" : "+v"(l2)); E.mid(acc, cur, wr, wc, l2 & 15, l2 >> 4); } }
            if constexpr (SP2) {
            PG8_LDB(B0, 0, 0); PG8_LDB(B1, 0, 1); PG8_SCHED; PG8_LDA(At, 0, 0); PG8_STAGE(PG8_SA(1, 1), a1 + hstep, voffA);
            PG8_WAIT_V(8); PG8_WAIT_L(0); PG8_BAR; PG8_MMA(0, 0, At, B0); PG8_MMA(0, 1, At, B1); PG8_BAR; PG8_SCHED;
            PG8_LDA(At, 0, 1); PG8_STAGE(PG8_SB(0, 0), b2, voffB); PG8_STAGE(PG8_SB(0, 1), b2 + hstep, voffB); PG8_STAGE(PG8_SA(0, 0), a2, voffA);
            PG8_WAIT_V(8); PG8_WAIT_L(0); PG8_BAR; PG8_MMA(1, 0, At, B0); PG8_MMA(1, 1, At, B1); PG8_BAR; PG8_SCHED;
            PG8_LDB(B0, 1, 0); PG8_LDB(B1, 1, 1); PG8_SCHED; PG8_LDA(At, 1, 0); PG8_STAGE(PG8_SA(0, 1), a2 + hstep, voffA);
            PG8_WAIT_V(8); PG8_WAIT_L(0); PG8_BAR; PG8_MMA(0, 0, At, B0); PG8_MMA(0, 1, At, B1); PG8_BAR; PG8_SCHED;
            PG8_LDA(At, 1, 1); PG8_STAGE(PG8_SB(1, 0), b3, voffB); PG8_STAGE(PG8_SB(1, 1), b3 + hstep, voffB); PG8_STAGE(PG8_SA(1, 0), a3, voffA);
            PG8_WAIT_V(8); PG8_WAIT_L(0); PG8_BAR; PG8_MMA(1, 0, At, B0); PG8_MMA(1, 1, At, B1); PG8_BAR; PG8_SCHED;
            } else {
            PG8_LDB(B0, 0, 0); PG8_SCHED; PG8_LDA(At, 0, 0); PG8_STAGE(PG8_SA(1, 1), a1 + hstep, voffA);
            PG8_WAIT_L(8); PG8_BAR; PG8_WAIT_L(0); PG8_MMA(0, 0, At, B0); PG8_BAR; PG8_SCHED;
            PG8_LDB(B1, 0, 1); PG8_STAGE(PG8_SB(0, 0), b2, voffB);
            PG8_BAR; PG8_WAIT_L(0); PG8_MMA(0, 1, At, B1); PG8_BAR;
            PG8_LDA(At, 0, 1); PG8_STAGE(PG8_SA(0, 0), a2, voffA);
            PG8_BAR; PG8_WAIT_L(0); PG8_MMA(1, 0, At, B0); PG8_BAR; PG8_SCHED;
            PG8_STAGE(PG8_SB(0, 1), b2 + hstep, voffB);
            PG8_WAIT_V(6); PG8_BAR; PG8_MMA(1, 1, At, B1); PG8_BAR;
            PG8_LDB(B0, 1, 0); PG8_SCHED; PG8_LDA(At, 1, 0); PG8_STAGE(PG8_SA(0, 1), a2 + hstep, voffA);
            PG8_WAIT_L(8); PG8_BAR; PG8_WAIT_L(0); PG8_MMA(0, 0, At, B0); PG8_BAR; PG8_SCHED;
            PG8_LDB(B1, 1, 1); PG8_STAGE(PG8_SB(1, 0), b3, voffB);
            PG8_BAR; PG8_WAIT_L(0); PG8_MMA(0, 1, At, B1); PG8_BAR;
            PG8_LDA(At, 1, 1); PG8_STAGE(PG8_SA(1, 0), a3, voffA);
            PG8_BAR; PG8_WAIT_L(0); PG8_MMA(1, 0, At, B0); PG8_BAR; PG8_SCHED;
            PG8_STAGE(PG8_SB(1, 1), b3 + hstep, voffB);
            PG8_WAIT_V(6); PG8_BAR; PG8_MMA(1, 1, At, B1); PG8_BAR;
            }
        }
        if constexpr (ALIGN_EPI) { if (wr == 0) PG8_BAR; }
        { int l2 = lane; asm volatile("" : "+v"(l2)); E(acc, cur, wr, wc, l2 & 15, l2 >> 4); }
        if (!has_next) break;
#pragma unroll
        for (int a = 0; a < 2; ++a)
#pragma unroll
            for (int b = 0; b < 2; ++b)
#pragma unroll
                for (int m = 0; m < 4; ++m)
#pragma unroll
                    for (int n = 0; n < 2; ++n) acc[a][b][m][n] = (f32x4){0.f, 0.f, 0.f, 0.f};
        cur = nxt; cA = nA; cB = nB; ++ui;
        if constexpr (ALIGN_EPI) { if (wr == 1) PG8_BAR; }
    }
    PG8_WAIT_V(0);
    if constexpr (!ALIGN_EPI) { if (wr == 0) PG8_BAR; }
    PG8_BAR;
#undef PG8_SA
#undef PG8_SB
#undef PG8_STAGE
#undef PG8_LDA
#undef PG8_LDB
#undef PG8_MMA
#undef PG8_WAIT_V
#undef PG8_WAIT_L
#undef PG8_BAR
#undef PG8_SCHED
}
}

using pg8::bf16_t; using pg8::f32x4; using pg8::u32x4; using pg8::Unit; using pg8::cvt_pk_bf16;
#define LAS __attribute__((address_space(3)))
constexpr int NB = 4, SEQ = 4096, T = NB * SEQ, DM = 2048, DIN = 5632, DFF = 5632, DPLE = 256, DEPTH = 2;
constexpr float EPS = 1e-6f;
constexpr float LOG2E = 1.4426950408889634f;
constexpr float QSCALE = 0.125f * LOG2E;
constexpr int NWAVES = 8, NTHR = 512;
constexpr int LDS_BYTES = 147456;

constexpr size_t MiB = 1u << 20;
constexpr size_t WS_STAT = 0;
constexpr size_t WS_LBT = 768 * 1024;
constexpr size_t WS_CS = 1 * MiB;
constexpr size_t WS_W = 5 * MiB;
constexpr size_t WL_IN = 0, WL_OUT = 22 * MiB, WL_GU = 30 * MiB, WL_DOWN = 74 * MiB, WL_PG = 96 * MiB, WL_PP = 104 * MiB, WL_SIZE = 105 * MiB;
constexpr size_t WS_PBF = 215 * MiB;
constexpr size_t WS_HA = 231 * MiB;
constexpr size_t WS_R = 295 * MiB;
constexpr size_t WS_QH = WS_R, WS_K = WS_R + 64 * MiB, WS_V = WS_R + 72 * MiB, WS_G = WS_R + 80 * MiB, WS_KIN = WS_R + 144 * MiB, WS_HI = WS_R + 176 * MiB, WS_HG = WS_R + 208 * MiB;
constexpr size_t WS_M = WS_G, WS_ACT = WS_R, WS_F = WS_R + 176 * MiB, WS_PP = WS_R;
constexpr size_t WS_DEC = WS_R + 240 * MiB;
constexpr size_t WS_END = WS_DEC + 1 * MiB;
enum { SQ_X = 0, SQ_A = 2, SQ_M = 4, SQ_2 = 6, SQ_F = 8, SQ_3 = 10 };

__constant__ double c_invf[32] = {1.0, 0.7498942093324559, 0.5623413251903491, 0.4216965034285822, 0.31622776601683794, 0.23713737056616552, 0.1778279410038923, 0.1333521432163324, 0.09999999999999999, 0.07498942093324558, 0.056234132519034905, 0.042169650342858224, 0.03162277660168379, 0.023713737056616554, 0.01778279410038923, 0.013335214321633239, 0.01, 0.007498942093324559, 0.005623413251903491, 0.004216965034285822, 0.0031622776601683794, 0.002371373705661655, 0.0017782794100389228, 0.0013335214321633238, 0.001, 0.0007498942093324559, 0.000562341325190349, 0.00042169650342858224, 0.00031622776601683794, 0.00023713737056616554, 0.0001778279410038923, 0.0001333521432163324};

__device__ __forceinline__ float bf2f(unsigned h) { return __uint_as_float(h << 16); }
__device__ __forceinline__ float bflo(unsigned w) { return __uint_as_float(w << 16); }
__device__ __forceinline__ float bfhi(unsigned w) { return __uint_as_float(w & 0xffff0000u); }
__device__ __forceinline__ unsigned f2bf(float f) { unsigned u = __float_as_uint(f); return (u + 0x7fffu + ((u >> 16) & 1u)) >> 16; }
__device__ __forceinline__ unsigned pk2(float lo, float hi) { return f2bf(lo) | (f2bf(hi) << 16); }
__device__ __forceinline__ float shx(float v, int lane, int m) { return __int_as_float(__builtin_amdgcn_ds_bpermute((lane ^ m) << 2, __float_as_int(v))); }
__device__ __forceinline__ float wave_sum(float v, int lane) {
#pragma unroll
    for (int o = 1; o < 64; o <<= 1) v += shx(v, lane, o);
    return v;
}
__device__ __forceinline__ float sigmoidf_(float z) { return 1.0f / (1.0f + __expf(-z)); }
__device__ __forceinline__ float siluf_(float z) { return z / (1.0f + __expf(-z)); }

struct EpiIn {
    static constexpr bool PERM = true, MID = false;
    int kmid;
    const float* ssqX; const float* cs; const float* lb;
    bf16_t* QH; bf16_t* Kb; bf16_t* Vb; float* G; bf16_t* KIN; bf16_t* HI; bf16_t* HG;
    __device__ __forceinline__ void mid(f32x4 (&acc)[2][2][4][2], const Unit& u, int wr, int wc, int fr, int fq) const {}
    __device__ __forceinline__ void operator()(const f32x4 (&acc)[2][2][4][2], const Unit& u, int wr, int wc, int fr, int fq) const {
        const int pn = u.pn;
#pragma unroll
        for (int ai = 0; ai < 2; ++ai)
#pragma unroll
            for (int m = 0; m < 4; ++m) {
                const int row = u.pm * 256 + ai * 128 + wr * 64 + m * 16 + fr;
                const float rs = rsqrtf(ssqX[row] * (1.0f / DM) + EPS);
                if (pn <= 4) {
                    const int d0 = 8 * fq;
                    const f32x4 c0 = *(const f32x4*)(cs + (size_t)row * 64 + d0), c1 = *(const f32x4*)(cs + (size_t)row * 64 + d0 + 4);
                    const f32x4 s0 = *(const f32x4*)(cs + (size_t)row * 64 + 32 + d0), s1 = *(const f32x4*)(cs + (size_t)row * 64 + 32 + d0 + 4);
                    const float sc = (pn < 4) ? rs * QSCALE : rs;
                    const f32x4 a0 = acc[ai][0][m][0] * sc, a1 = acc[ai][0][m][1] * sc, b0 = acc[ai][1][m][0] * sc, b1 = acc[ai][1][m][1] * sc;
                    const f32x4 o10 = a0 * c0 - b0 * s0, o11 = a1 * c1 - b1 * s1, o20 = b0 * c0 + a0 * s0, o21 = b1 * c1 + a1 * s1;
                    u32x4 w1, w2;
                    w1.x = cvt_pk_bf16(o10[0], o10[1]); w1.y = cvt_pk_bf16(o10[2], o10[3]); w1.z = cvt_pk_bf16(o11[0], o11[1]); w1.w = cvt_pk_bf16(o11[2], o11[3]);
                    w2.x = cvt_pk_bf16(o20[0], o20[1]); w2.y = cvt_pk_bf16(o20[2], o20[3]); w2.z = cvt_pk_bf16(o21[0], o21[1]); w2.w = cvt_pk_bf16(o21[2], o21[3]);
                    bf16_t* dst = (pn < 4) ? (QH + (size_t)row * 2048 + (pn * 4 + wc) * 64 + d0) : (Kb + (size_t)row * 256 + wc * 64 + d0);
                    *(u32x4*)dst = w1; *(u32x4*)(dst + 32) = w2;
                } else {
#pragma unroll
                    for (int bj = 0; bj < 2; ++bj) {
                        const int cl = bj * 128 + wc * 32 + 8 * fq;
                        f32x4 v0 = acc[ai][bj][m][0] * rs, v1 = acc[ai][bj][m][1] * rs;
                        if (pn == 5) {
                            u32x4 w; w.x = cvt_pk_bf16(v0[0], v0[1]); w.y = cvt_pk_bf16(v0[2], v0[3]); w.z = cvt_pk_bf16(v1[0], v1[1]); w.w = cvt_pk_bf16(v1[2], v1[3]);
                            *(u32x4*)(Vb + (size_t)row * 256 + cl) = w;
                        } else if (pn < 10) {
                            const int c = (pn - 6) * 256 + cl;
#pragma unroll
                            for (int j = 0; j < 4; ++j) { v0[j] = siluf_(v0[j]); v1[j] = siluf_(v1[j]); }
                            u32x4 w; w.x = cvt_pk_bf16(v0[0], v0[1]); w.y = cvt_pk_bf16(v0[2], v0[3]); w.z = cvt_pk_bf16(v1[0], v1[1]); w.w = cvt_pk_bf16(v1[2], v1[3]);
                            *(u32x4*)(QH + (size_t)row * 2048 + 1024 + c) = w;
                        } else if (pn < 14) {
                            const int c = (pn - 10) * 256 + cl;
                            const f32x4 l0 = *(const f32x4*)(lb + c), l1 = *(const f32x4*)(lb + c + 4);
                            f32x4 g0, g1, k0, k1;
#pragma unroll
                            for (int j = 0; j < 4; ++j) {
                                { const float z = fminf(fmaxf(v0[j], -30.f), 30.f), e = __expf(-z), sg = 1.0f / (1.0f + e), om = 1.0f - l0[j]; g0[j] = __logf(l0[j] + om * sg); k0[j] = om * e * sg; }
                                { const float z = fminf(fmaxf(v1[j], -30.f), 30.f), e = __expf(-z), sg = 1.0f / (1.0f + e), om = 1.0f - l1[j]; g1[j] = __logf(l1[j] + om * sg); k1[j] = om * e * sg; }
                            }
                            *(f32x4*)(G + (size_t)row * 1024 + c) = g0; *(f32x4*)(G + (size_t)row * 1024 + c + 4) = g1;
                            u32x4 w; w.x = cvt_pk_bf16(k0[0], k0[1]); w.y = cvt_pk_bf16(k0[2], k0[3]); w.z = cvt_pk_bf16(k1[0], k1[1]); w.w = cvt_pk_bf16(k1[2], k1[3]);
                            *(u32x4*)(KIN + (size_t)row * 1024 + c) = w;
                        } else if (pn < 18) {
                            const int c = (pn - 14) * 256 + cl;
                            u32x4 w; w.x = cvt_pk_bf16(v0[0], v0[1]); w.y = cvt_pk_bf16(v0[2], v0[3]); w.z = cvt_pk_bf16(v1[0], v1[1]); w.w = cvt_pk_bf16(v1[2], v1[3]);
                            *(u32x4*)(HI + (size_t)row * 1024 + c) = w;
                        } else {
                            const int c = (pn - 18) * 256 + cl;
#pragma unroll
                            for (int j = 0; j < 4; ++j) { v0[j] = siluf_(v0[j]); v1[j] = siluf_(v1[j]); }
                            u32x4 w; w.x = cvt_pk_bf16(v0[0], v0[1]); w.y = cvt_pk_bf16(v0[2], v0[3]); w.z = cvt_pk_bf16(v1[0], v1[1]); w.w = cvt_pk_bf16(v1[2], v1[3]);
                            *(u32x4*)(HG + (size_t)row * 1024 + c) = w;
                        }
                    }
                }
                asm volatile("" ::: "memory");
            }
    }
};

template <bool MIDS> struct EpiRowSsq {
    static constexpr bool PERM = true, MID = MIDS;
    int kmid;
    bf16_t* O; float* ssq; const float* ssqA;
    __device__ __forceinline__ void mid(f32x4 (&acc)[2][2][4][2], const Unit& u, int wr, int wc, int fr, int fq) const {
#pragma unroll
        for (int ai = 0; ai < 2; ++ai)
#pragma unroll
            for (int m = 0; m < 4; ++m) {
                const int row = u.pm * 256 + ai * 128 + wr * 64 + m * 16 + fr;
                const float s = rsqrtf(ssqA[row] * (1.0f / 1024.0f) + EPS);
#pragma unroll
                for (int bj = 0; bj < 2; ++bj)
#pragma unroll
                    for (int n = 0; n < 2; ++n) acc[ai][bj][m][n] = acc[ai][bj][m][n] * s;
            }
    }
    __device__ __forceinline__ void operator()(const f32x4 (&acc)[2][2][4][2], const Unit& u, int wr, int wc, int fr, int fq) const {
#pragma unroll
        for (int ai = 0; ai < 2; ++ai)
#pragma unroll
            for (int m = 0; m < 4; ++m) {
                const int row = u.pm * 256 + ai * 128 + wr * 64 + m * 16 + fr;
                float q = 0.f;
#pragma unroll
                for (int bj = 0; bj < 2; ++bj) {
                    const f32x4 v0 = acc[ai][bj][m][0], v1 = acc[ai][bj][m][1];
                    q += (v0[0] * v0[0] + v0[1] * v0[1]) + (v0[2] * v0[2] + v0[3] * v0[3]) + (v1[0] * v1[0] + v1[1] * v1[1]) + (v1[2] * v1[2] + v1[3] * v1[3]);
                    u32x4 w; w.x = cvt_pk_bf16(v0[0], v0[1]); w.y = cvt_pk_bf16(v0[2], v0[3]); w.z = cvt_pk_bf16(v1[0], v1[1]); w.w = cvt_pk_bf16(v1[2], v1[3]);
                    *(u32x4*)(O + (size_t)row * 2048 + u.pn * 256 + bj * 128 + wc * 32 + 8 * fq) = w;
                }
                q += shx(q, fq * 16 + fr, 16); q += shx(q, fq * 16 + fr, 32);
                if (fq == 0) atomicAdd(ssq + row, q);
                asm volatile("" ::: "memory");
            }
    }
};

struct EpiGU {
    static constexpr bool PERM = true, MID = false;
    int kmid;
    const float* ssq2; bf16_t* ACT;
    __device__ __forceinline__ void mid(f32x4 (&acc)[2][2][4][2], const Unit& u, int wr, int wc, int fr, int fq) const {}
    __device__ __forceinline__ void operator()(const f32x4 (&acc)[2][2][4][2], const Unit& u, int wr, int wc, int fr, int fq) const {
#pragma unroll
        for (int ai = 0; ai < 2; ++ai)
#pragma unroll
            for (int m = 0; m < 4; ++m) {
                const int row = u.pm * 256 + ai * 128 + wr * 64 + m * 16 + fr;
                const float rs = rsqrtf(ssq2[row] * (1.0f / DM) + EPS);
                f32x4 o0, o1;
#pragma unroll
                for (int j = 0; j < 4; ++j) {
                    const float g0 = acc[ai][0][m][0][j] * rs, u0 = acc[ai][1][m][0][j] * rs, g1 = acc[ai][0][m][1][j] * rs, u1 = acc[ai][1][m][1][j] * rs;
                    o0[j] = siluf_(g0) * u0; o1[j] = siluf_(g1) * u1;
                }
                u32x4 w; w.x = cvt_pk_bf16(o0[0], o0[1]); w.y = cvt_pk_bf16(o0[2], o0[3]); w.z = cvt_pk_bf16(o1[0], o1[1]); w.w = cvt_pk_bf16(o1[2], o1[3]);
                *(u32x4*)(ACT + (size_t)row * DFF + u.pn * 128 + wc * 32 + 8 * fq) = w;
                asm volatile("" ::: "memory");
            }
    }
};

struct EpiPlain {
    static constexpr bool PERM = true, MID = false;
    int kmid;
    bf16_t* O;
    __device__ __forceinline__ void mid(f32x4 (&acc)[2][2][4][2], const Unit& u, int wr, int wc, int fr, int fq) const {}
    __device__ __forceinline__ void operator()(const f32x4 (&acc)[2][2][4][2], const Unit& u, int wr, int wc, int fr, int fq) const {
#pragma unroll
        for (int ai = 0; ai < 2; ++ai)
#pragma unroll
            for (int m = 0; m < 4; ++m) {
                const int row = u.pm * 256 + ai * 128 + wr * 64 + m * 16 + fr;
#pragma unroll
                for (int bj = 0; bj < 2; ++bj) {
                    const f32x4 v0 = acc[ai][bj][m][0], v1 = acc[ai][bj][m][1];
                    u32x4 w; w.x = cvt_pk_bf16(v0[0], v0[1]); w.y = cvt_pk_bf16(v0[2], v0[3]); w.z = cvt_pk_bf16(v1[0], v1[1]); w.w = cvt_pk_bf16(v1[2], v1[3]);
                    *(u32x4*)(O + (size_t)row * 2048 + u.pn * 256 + bj * 128 + wc * 32 + 8 * fq) = w;
                }
                asm volatile("" ::: "memory");
            }
    }
};

struct EpiPle {
    static constexpr bool PERM = true, MID = false;
    int kmid;
    const float* ssq3; const bf16_t* PP; float* X; bf16_t* HA; float* ssqN; int has_next;
    __device__ __forceinline__ void mid(f32x4 (&acc)[2][2][4][2], const Unit& u, int wr, int wc, int fr, int fq) const {}
    __device__ __forceinline__ void operator()(const f32x4 (&acc)[2][2][4][2], const Unit& u, int wr, int wc, int fr, int fq) const {
#pragma unroll
        for (int ai = 0; ai < 2; ++ai)
#pragma unroll
            for (int m = 0; m < 4; ++m) {
                const int row = u.pm * 256 + ai * 128 + wr * 64 + m * 16 + fr;
                const float rs = rsqrtf(ssq3[row] * (1.0f / DM) + EPS);
                float q = 0.f;
#pragma unroll
                for (int bj = 0; bj < 2; ++bj) {
                    const size_t off = (size_t)row * 2048 + u.pn * 256 + bj * 128 + wc * 32 + 8 * fq;
                    const u32x4 pw = *(const u32x4*)(PP + off);
                    f32x4 x0 = *(const f32x4*)(X + off), x1 = *(const f32x4*)(X + off + 4);
                    const f32x4 v0 = acc[ai][bj][m][0] * rs, v1 = acc[ai][bj][m][1] * rs;
                    x0[0] += bflo(pw.x) * sigmoidf_(v0[0]); x0[1] += bfhi(pw.x) * sigmoidf_(v0[1]); x0[2] += bflo(pw.y) * sigmoidf_(v0[2]); x0[3] += bfhi(pw.y) * sigmoidf_(v0[3]);
                    x1[0] += bflo(pw.z) * sigmoidf_(v1[0]); x1[1] += bfhi(pw.z) * sigmoidf_(v1[1]); x1[2] += bflo(pw.w) * sigmoidf_(v1[2]); x1[3] += bfhi(pw.w) * sigmoidf_(v1[3]);
                    *(f32x4*)(X + off) = x0; *(f32x4*)(X + off + 4) = x1;
                    if (has_next) {
                        q += (x0[0] * x0[0] + x0[1] * x0[1]) + (x0[2] * x0[2] + x0[3] * x0[3]) + (x1[0] * x1[0] + x1[1] * x1[1]) + (x1[2] * x1[2] + x1[3] * x1[3]);
                        u32x4 w; w.x = cvt_pk_bf16(x0[0], x0[1]); w.y = cvt_pk_bf16(x0[2], x0[3]); w.z = cvt_pk_bf16(x1[0], x1[1]); w.w = cvt_pk_bf16(x1[2], x1[3]);
                        *(u32x4*)(HA + off) = w;
                    }
                }
                if (has_next) { q += shx(q, fq * 16 + fr, 16); q += shx(q, fq * 16 + fr, 32); if (fq == 0) atomicAdd(ssqN + row, q); }
                asm volatile("" ::: "memory");
            }
    }
};

__device__ __forceinline__ void tr_item(const float* W, int ldw, int K, int k0, int n0, bf16_t* WT, int prow0, const float* gain, LAS float* scr, int lane) {
#pragma unroll 8
    for (int i = 0; i < 32; ++i) { const int kk = 2 * i + (lane >> 5); float w = W[(size_t)(k0 + kk) * ldw + n0 + (lane & 31)]; if (gain) w *= gain[k0 + kk]; scr[kk * 33 + (lane & 31)] = w; }
    asm volatile("s_waitcnt lgkmcnt(0)" ::: "memory");
    const int c = lane & 7;
#pragma unroll
    for (int j = 0; j < 4; ++j) { const int n = (lane >> 3) + 8 * j; const LAS float* s = scr + (8 * c) * 33 + n;
        u32x4 o; o.x = pk2(s[0 * 33], s[1 * 33]); o.y = pk2(s[2 * 33], s[3 * 33]); o.z = pk2(s[4 * 33], s[5 * 33]); o.w = pk2(s[6 * 33], s[7 * 33]);
        *(u32x4*)(WT + (size_t)(prow0 + n) * K + k0 + 8 * c) = o; }
    asm volatile("s_waitcnt lgkmcnt(0)" ::: "memory");
}

struct Args { const void* in[19]; float* out; unsigned char* ws; };

__device__ __forceinline__ void row_phase(const float* xsrc, float* xdst, const bf16_t* Mb, const float* ssqIn, const float* gain, bf16_t* HA, float* ssqOut, int gw, int ngw, int lane) {
    for (int row = gw; row < T; row += ngw) {
        const float rm = rsqrtf(ssqIn[row] * (1.0f / DM) + EPS);
        float ss = 0.f;
#pragma unroll
        for (int j = 0; j < 4; ++j) {
            const int c = j * 512 + lane * 8; const size_t off = (size_t)row * 2048 + c;
            const u32x4 mv = *(const u32x4*)(Mb + off);
            f32x4 x0 = *(const f32x4*)(xsrc + off), x1 = *(const f32x4*)(xsrc + off + 4);
            const f32x4 g0 = *(const f32x4*)(gain + c), g1 = *(const f32x4*)(gain + c + 4);
            x0[0] += bflo(mv.x) * rm * g0[0]; x0[1] += bfhi(mv.x) * rm * g0[1]; x0[2] += bflo(mv.y) * rm * g0[2]; x0[3] += bfhi(mv.y) * rm * g0[3];
            x1[0] += bflo(mv.z) * rm * g1[0]; x1[1] += bfhi(mv.z) * rm * g1[1]; x1[2] += bflo(mv.w) * rm * g1[2]; x1[3] += bfhi(mv.w) * rm * g1[3];
            *(f32x4*)(xdst + off) = x0; *(f32x4*)(xdst + off + 4) = x1;
            u32x4 w; w.x = pk2(x0[0], x0[1]); w.y = pk2(x0[2], x0[3]); w.z = pk2(x1[0], x1[1]); w.w = pk2(x1[2], x1[3]);
            *(u32x4*)(HA + off) = w;
            ss += (x0[0] * x0[0] + x0[1] * x0[1]) + (x0[2] * x0[2] + x0[3] * x0[3]) + (x1[0] * x1[0] + x1[1] * x1[1]) + (x1[2] * x1[2] + x1[3] * x1[3]);
        }
        ss = wave_sum(ss, lane);
        if (lane == 0) ssqOut[row] = ss;
    }
}

__device__ __forceinline__ void attn_naive(bf16_t* QH, const bf16_t* Kb, const bf16_t* Vb, const float* sinks, float* ssqA, int gtid, int nthr) {
    for (int item = gtid; item < T * 16; item += nthr) {
        const int head = item / T, row = item % T, b = row / SEQ, t = row % SEQ, hk = head >> 2;
        float q[64], acc[64];
        const u32x4* qp = (const u32x4*)(QH + (size_t)row * 2048 + head * 64);
#pragma unroll
        for (int c = 0; c < 8; ++c) { const u32x4 w = qp[c]; q[8 * c] = bflo(w.x); q[8 * c + 1] = bfhi(w.x); q[8 * c + 2] = bflo(w.y); q[8 * c + 3] = bfhi(w.y); q[8 * c + 4] = bflo(w.z); q[8 * c + 5] = bfhi(w.z); q[8 * c + 6] = bflo(w.w); q[8 * c + 7] = bfhi(w.w); }
#pragma unroll
        for (int d = 0; d < 64; ++d) acc[d] = 0.f;
        float mx = sinks[head] * LOG2E, l = 1.0f;
        const int j0 = t - 127 < 0 ? 0 : t - 127;
        for (int j = j0; j <= t; ++j) {
            const size_t kr = (size_t)(b * SEQ + j) * 256 + hk * 64;
            const u32x4* kp = (const u32x4*)(Kb + kr);
            float s = 0.f;
#pragma unroll
            for (int c = 0; c < 8; ++c) { const u32x4 w = kp[c]; s += q[8 * c] * bflo(w.x) + q[8 * c + 1] * bfhi(w.x) + q[8 * c + 2] * bflo(w.y) + q[8 * c + 3] * bfhi(w.y) + q[8 * c + 4] * bflo(w.z) + q[8 * c + 5] * bfhi(w.z) + q[8 * c + 6] * bflo(w.w) + q[8 * c + 7] * bfhi(w.w); }
            if (s > mx) { const float cf = exp2f(mx - s); l *= cf;
#pragma unroll
                for (int d = 0; d < 64; ++d) acc[d] *= cf;
                mx = s; }
            const float p = exp2f(s - mx); l += p;
            const u32x4* vp = (const u32x4*)(Vb + kr);
#pragma unroll
            for (int c = 0; c < 8; ++c) { const u32x4 w = vp[c]; acc[8 * c] += p * bflo(w.x); acc[8 * c + 1] += p * bfhi(w.x); acc[8 * c + 2] += p * bflo(w.y); acc[8 * c + 3] += p * bfhi(w.y); acc[8 * c + 4] += p * bflo(w.z); acc[8 * c + 5] += p * bfhi(w.z); acc[8 * c + 6] += p * bflo(w.w); acc[8 * c + 7] += p * bfhi(w.w); }
        }
        const float il = 1.0f / l; float ss = 0.f;
        u32x4* op = (u32x4*)(QH + (size_t)row * 2048 + head * 64);
#pragma unroll
        for (int c = 0; c < 8; ++c) {
            float o[8];
#pragma unroll
            for (int e = 0; e < 8; ++e) { o[e] = acc[8 * c + e] * il; ss += o[e] * o[e]; }
            u32x4 w; w.x = pk2(o[0], o[1]); w.y = pk2(o[2], o[3]); w.z = pk2(o[4], o[5]); w.w = pk2(o[6], o[7]); op[c] = w;
        }
        atomicAdd(ssqA + row, ss);
    }
}

__device__ __forceinline__ void hgrn_naive(const bf16_t* QH, const bf16_t* KIN, const float* G, const bf16_t* HI, float* tmpO, int item, int lane) {
    const int bh = item >> 1, b = bh >> 3, h = bh & 7, v = (item & 1) * 64 + lane;
    float S[128];
#pragma unroll
    for (int k = 0; k < 128; ++k) S[k] = 0.f;
    int z = 0; asm volatile("v_mov_b32 %0, 0" : "=v"(z));
    for (int t = 0; t < SEQ; ++t) {
        const size_t row = (size_t)b * SEQ + t;
        const float vv = bf2f(HI[row * 1024 + h * 128 + v]);
        const u32x4* qp = (const u32x4*)(QH + row * 2048 + 1024 + h * 128 + z);
        const u32x4* kp = (const u32x4*)(KIN + row * 1024 + h * 128 + z);
        const f32x4* gp = (const f32x4*)(G + row * 1024 + h * 128 + z);
        float o = 0.f;
#pragma unroll
        for (int c = 0; c < 16; ++c) {
            const u32x4 qw = qp[c], kw = kp[c]; const f32x4 g0 = gp[2 * c], g1 = gp[2 * c + 1];
            const float qq[8] = {bflo(qw.x), bfhi(qw.x), bflo(qw.y), bfhi(qw.y), bflo(qw.z), bfhi(qw.z), bflo(qw.w), bfhi(qw.w)};
            const float kk[8] = {bflo(kw.x), bfhi(kw.x), bflo(kw.y), bfhi(kw.y), bflo(kw.z), bfhi(kw.z), bflo(kw.w), bfhi(kw.w)};
            const float gg[8] = {g0[0], g0[1], g0[2], g0[3], g1[0], g1[1], g1[2], g1[3]};
#pragma unroll
            for (int e = 0; e < 8; ++e) { const float f = __expf(gg[e]); S[8 * c + e] = f * S[8 * c + e] + kk[e] * vv; o += S[8 * c + e] * qq[e]; }
        }
        tmpO[row * 1024 + h * 128 + v] = o;
    }
}
__device__ __forceinline__ void hgrn_norm_naive(const float* tmpO, const bf16_t* HG, bf16_t* QH, int gw, int ngw, int lane) {
    for (int row = gw; row < T; row += ngw) {
        const size_t off = (size_t)row * 1024 + lane * 16;
        f32x4 o[4]; float ss = 0.f;
#pragma unroll
        for (int j = 0; j < 4; ++j) { o[j] = *(const f32x4*)(tmpO + off + 4 * j); ss += (o[j][0] * o[j][0] + o[j][1] * o[j][1]) + (o[j][2] * o[j][2] + o[j][3] * o[j][3]); }
        ss += shx(ss, lane, 1); ss += shx(ss, lane, 2); ss += shx(ss, lane, 4);
        const float r = rsqrtf(ss * (1.0f / 128.0f) + EPS);
        const u32x4 g0 = *(const u32x4*)(HG + off), g1 = *(const u32x4*)(HG + off + 8);
        u32x4 w0, w1;
        w0.x = pk2(o[0][0] * r * bflo(g0.x), o[0][1] * r * bfhi(g0.x)); w0.y = pk2(o[0][2] * r * bflo(g0.y), o[0][3] * r * bfhi(g0.y));
        w0.z = pk2(o[1][0] * r * bflo(g0.z), o[1][1] * r * bfhi(g0.z)); w0.w = pk2(o[1][2] * r * bflo(g0.w), o[1][3] * r * bfhi(g0.w));
        w1.x = pk2(o[2][0] * r * bflo(g1.x), o[2][1] * r * bfhi(g1.x)); w1.y = pk2(o[2][2] * r * bflo(g1.y), o[2][3] * r * bfhi(g1.y));
        w1.z = pk2(o[3][0] * r * bflo(g1.z), o[3][1] * r * bfhi(g1.z)); w1.w = pk2(o[3][2] * r * bflo(g1.w), o[3][3] * r * bfhi(g1.w));
        bf16_t* dst = QH + (size_t)row * 2048 + 1024 + lane * 16;
        *(u32x4*)dst = w0; *(u32x4*)(dst + 8) = w1;
    }
}


typedef float f32x16 __attribute__((ext_vector_type(16)));
typedef short bf16x8 __attribute__((ext_vector_type(8)));
typedef unsigned u32x2 __attribute__((ext_vector_type(2)));
__device__ __forceinline__ int crow(int r, int hi) { return (r & 3) + 8 * (r >> 2) + 4 * hi; }
__device__ __forceinline__ bf16x8 pack8(float a0, float a1, float a2, float a3, float a4, float a5, float a6, float a7) {
    u32x4 w; w.x = cvt_pk_bf16(a0, a1); w.y = cvt_pk_bf16(a2, a3); w.z = cvt_pk_bf16(a4, a5); w.w = cvt_pk_bf16(a6, a7); return __builtin_bit_cast(bf16x8, w);
}
constexpr int AT_KSTR = 144, AT_VSTR = 528, AT_VOFF = 256 * AT_KSTR;

__device__ __forceinline__ void attn_unit(LAS unsigned char* lds, bf16_t* QH, const bf16_t* Kb, const bf16_t* Vb, const float* sinks, float* ssqA, int unit, int tid, int lane, int wave) {
    const int hk = unit & 3, n = (unit >> 2) & 31, b = unit >> 7;
    const long rowbase = (long)b * SEQ + n * 128 - 128;
    LAS unsigned char* Ks = lds; LAS unsigned char* Vt = lds + AT_VOFF;
#pragma unroll
    for (int i = 0; i < 4; ++i) {
        const int row = (tid >> 3) + 64 * i; u32x4 v = (u32x4){0u, 0u, 0u, 0u};
        if (n > 0 || row >= 128) v = *(const u32x4*)(Kb + (rowbase + row) * 256 + hk * 64 + (tid & 7) * 8);
        *(LAS u32x4*)(Ks + row * AT_KSTR + (tid & 7) * 16) = v;
    }
#pragma unroll
    for (int i = 0; i < 4; ++i) {
        const int key = lane + 64 * i; u32x4 v = (u32x4){0u, 0u, 0u, 0u};
        if (n > 0 || key >= 128) v = *(const u32x4*)(Vb + (rowbase + key) * 256 + hk * 64 + wave * 8);
        LAS unsigned short* vp = (LAS unsigned short*)(Vt + (wave * 8) * AT_VSTR + key * 2);
        vp[0 * 264] = (unsigned short)(v.x & 0xffffu); vp[1 * 264] = (unsigned short)(v.x >> 16); vp[2 * 264] = (unsigned short)(v.y & 0xffffu); vp[3 * 264] = (unsigned short)(v.y >> 16);
        vp[4 * 264] = (unsigned short)(v.z & 0xffffu); vp[5 * 264] = (unsigned short)(v.z >> 16); vp[6 * 264] = (unsigned short)(v.w & 0xffffu); vp[7 * 264] = (unsigned short)(v.w >> 16);
    }
    __syncthreads();
    const int g = wave >> 1, qh = wave & 1, head = hk * 4 + g, r = lane & 31, h = lane >> 5;
    const float sink2 = sinks[head] * LOG2E;
    for (int qt = 0; qt < 2; ++qt) {
        const int t0 = 64 * qh + 32 * qt, t = t0 + r;
        const size_t qrow = (size_t)b * SEQ + n * 128 + t;
        bf16_t* qp = QH + qrow * 2048 + head * 64;
        bf16x8 qf[4];
#pragma unroll
        for (int s4 = 0; s4 < 4; ++s4) qf[s4] = *(const bf16x8*)(qp + 16 * s4 + 8 * h);
        f32x16 S[5];
#pragma unroll
        for (int jt = 0; jt < 5; ++jt) {
            const int kb = t0 + 32 * jt;
            f32x16 a = {};
#pragma unroll
            for (int s4 = 0; s4 < 4; ++s4) { const bf16x8 kf = *(const LAS bf16x8*)(Ks + (kb + r) * AT_KSTR + (16 * s4 + 8 * h) * 2); a = __builtin_amdgcn_mfma_f32_32x32x16_bf16(kf, qf[s4], a, 0, 0, 0); }
            S[jt] = a;
        }
        float mx = sink2;
#pragma unroll
        for (int jt = 0; jt < 5; ++jt)
#pragma unroll
            for (int rg = 0; rg < 16; ++rg) {
                const int ki = t0 + 32 * jt + crow(rg, h);
                const bool ok = (ki > t) && (ki <= t + 128) && (n > 0 || ki >= 128);
                const float v = ok ? S[jt][rg] : -1e30f; S[jt][rg] = v; mx = fmaxf(mx, v);
            }
        mx = fmaxf(mx, shx(mx, lane, 32));
        float l = 0.f;
#pragma unroll
        for (int jt = 0; jt < 5; ++jt)
#pragma unroll
            for (int rg = 0; rg < 16; ++rg) { const float p = __builtin_amdgcn_exp2f(S[jt][rg] - mx); S[jt][rg] = p; l += p; }
        l += shx(l, lane, 32);
        l += __builtin_amdgcn_exp2f(sink2 - mx);
        f32x16 O[2]; O[0] = (f32x16){}; O[1] = (f32x16){};
#pragma unroll
        for (int jt = 0; jt < 5; ++jt)
#pragma unroll
            for (int sp = 0; sp < 2; ++sp) {
                const bf16x8 pf = pack8(S[jt][8 * sp], S[jt][8 * sp + 1], S[jt][8 * sp + 2], S[jt][8 * sp + 3], S[jt][8 * sp + 4], S[jt][8 * sp + 5], S[jt][8 * sp + 6], S[jt][8 * sp + 7]);
                const int kk = t0 + 32 * jt + 16 * sp + 4 * h;
#pragma unroll
                for (int dt = 0; dt < 2; ++dt) {
                    const LAS unsigned char* vrow = Vt + (32 * dt + r) * AT_VSTR + kk * 2;
                    const u32x2 lo = *(const LAS u32x2*)vrow, hi2 = *(const LAS u32x2*)(vrow + 16);
                    u32x4 w; w.x = lo.x; w.y = lo.y; w.z = hi2.x; w.w = hi2.y;
                    O[dt] = __builtin_amdgcn_mfma_f32_32x32x16_bf16(__builtin_bit_cast(bf16x8, w), pf, O[dt], 0, 0, 0);
                }
            }
        const float il = 1.0f / l; float ss = 0.f;
#pragma unroll
        for (int dt = 0; dt < 2; ++dt)
#pragma unroll
            for (int gp = 0; gp < 4; ++gp) {
                const float o0 = O[dt][4 * gp] * il, o1 = O[dt][4 * gp + 1] * il, o2 = O[dt][4 * gp + 2] * il, o3 = O[dt][4 * gp + 3] * il;
                ss += (o0 * o0 + o1 * o1) + (o2 * o2 + o3 * o3);
                u32x2 w; w.x = cvt_pk_bf16(o0, o1); w.y = cvt_pk_bf16(o2, o3);
                *(u32x2*)(qp + 32 * dt + 8 * gp + 4 * h) = w;
            }
        ss += shx(ss, lane, 32);
        if (h == 0) atomicAdd(ssqA + qrow, ss);
    }
    __syncthreads();
}

constexpr int HG_STR = 144;
__device__ __forceinline__ void hgrn_h1_unit(LAS unsigned char* lds, const bf16_t* KIN, const float* G, const bf16_t* HI, bf16_t* SB, float* DEC, int unit, int tid, int lane, int wave) {
    const int c = unit & 63, bh = unit >> 6, b = bh >> 3, h = bh & 7;
    const size_t row0 = (size_t)b * SEQ + c * 64;
    LAS unsigned char* Kt = lds;
    LAS unsigned char* Vt = lds + 128 * HG_STR;
    LAS float* tot = (LAS float*)(lds + 2 * 128 * HG_STR);
    const int k = tid & 127, sg = tid >> 7;
    float bl[16]; float run = 0.f;
#pragma unroll
    for (int i = 0; i < 16; ++i) { run += G[(row0 + sg * 16 + i) * 1024 + h * 128 + k]; bl[i] = run; }
    tot[sg * 128 + k] = run;
    float kv[16], vv[16];
#pragma unroll
    for (int i = 0; i < 16; ++i) { kv[i] = bf2f(KIN[(row0 + sg * 16 + i) * 1024 + h * 128 + k]); vv[i] = bf2f(HI[(row0 + sg * 16 + i) * 1024 + h * 128 + k]); }
    __syncthreads();
    const float t0 = tot[k], t1 = tot[128 + k], t2 = tot[256 + k], t3 = tot[384 + k];
    const float blast = (t0 + t1) + (t2 + t3);
    const float off = (sg > 0 ? t0 : 0.f) + (sg > 1 ? t1 : 0.f) + (sg > 2 ? t2 : 0.f);
    if (sg == 0) DEC[(size_t)unit * 128 + k] = __expf(blast);
    float kt[16];
#pragma unroll
    for (int i = 0; i < 16; ++i) kt[i] = kv[i] * __expf(blast - (bl[i] + off));
    {
        u32x4 w0, w1;
        w0.x = pk2(kt[0], kt[1]); w0.y = pk2(kt[2], kt[3]); w0.z = pk2(kt[4], kt[5]); w0.w = pk2(kt[6], kt[7]);
        w1.x = pk2(kt[8], kt[9]); w1.y = pk2(kt[10], kt[11]); w1.z = pk2(kt[12], kt[13]); w1.w = pk2(kt[14], kt[15]);
        *(LAS u32x4*)(Kt + k * HG_STR + sg * 32) = w0; *(LAS u32x4*)(Kt + k * HG_STR + sg * 32 + 16) = w1;
        w0.x = pk2(vv[0], vv[1]); w0.y = pk2(vv[2], vv[3]); w0.z = pk2(vv[4], vv[5]); w0.w = pk2(vv[6], vv[7]);
        w1.x = pk2(vv[8], vv[9]); w1.y = pk2(vv[10], vv[11]); w1.z = pk2(vv[12], vv[13]); w1.w = pk2(vv[14], vv[15]);
        *(LAS u32x4*)(Vt + k * HG_STR + sg * 32) = w0; *(LAS u32x4*)(Vt + k * HG_STR + sg * 32 + 16) = w1;
    }
    __syncthreads();
    const int vt = wave >> 1, kt0 = (wave & 1) * 2, r = lane & 31, hh = lane >> 5;
    f32x16 acc0 = {}, acc1 = {};
#pragma unroll
    for (int st = 0; st < 4; ++st) {
        const bf16x8 af = *(const LAS bf16x8*)(Vt + (32 * vt + r) * HG_STR + (16 * st + 8 * hh) * 2);
        const bf16x8 b0 = *(const LAS bf16x8*)(Kt + (32 * kt0 + r) * HG_STR + (16 * st + 8 * hh) * 2);
        const bf16x8 b1 = *(const LAS bf16x8*)(Kt + (32 * (kt0 + 1) + r) * HG_STR + (16 * st + 8 * hh) * 2);
        acc0 = __builtin_amdgcn_mfma_f32_32x32x16_bf16(af, b0, acc0, 0, 0, 0);
        acc1 = __builtin_amdgcn_mfma_f32_32x32x16_bf16(af, b1, acc1, 0, 0, 0);
    }
    bf16_t* sb = SB + (size_t)unit * 16384;
#pragma unroll
    for (int rg = 0; rg < 16; ++rg) {
        const int v = 32 * vt + crow(rg, hh);
        sb[v * 128 + 32 * kt0 + r] = (bf16_t)f2bf(acc0[rg]);
        sb[v * 128 + 32 * (kt0 + 1) + r] = (bf16_t)f2bf(acc1[rg]);
    }
    __syncthreads();
}

__device__ __forceinline__ void hgrn_scan(bf16_t* SB, const float* DEC, int gtid, int nthr) {
    for (int item = gtid; item < 32 * 128 * 32; item += nthr) {
        const int kq = item & 31, v = (item >> 5) & 127, bh = item >> 12;
        f32x4 st = (f32x4){0.f, 0.f, 0.f, 0.f};
        u32x2* p = (u32x2*)(SB + ((size_t)bh * 64 * 128 + v) * 128 + kq * 4);
        const f32x4* dp = (const f32x4*)(DEC + (size_t)bh * 64 * 128 + kq * 4);
#pragma unroll 8
        for (int c = 0; c < 64; ++c) {
            const u32x2 d = p[(size_t)c * 16384 / 4]; const f32x4 dc = dp[c * 32];
            u32x2 o; o.x = cvt_pk_bf16(st[0], st[1]); o.y = cvt_pk_bf16(st[2], st[3]);
            p[(size_t)c * 16384 / 4] = o;
            st[0] = dc[0] * st[0] + bflo(d.x); st[1] = dc[1] * st[1] + bfhi(d.x); st[2] = dc[2] * st[2] + bflo(d.y); st[3] = dc[3] * st[3] + bfhi(d.y);
        }
    }
}

constexpr int H3_BSTR = 528, H3_QSTR = 272, H3_B_OFF = 0, H3_Q_OFF = 64 * H3_BSTR, H3_K_OFF = H3_Q_OFF + 64 * H3_QSTR, H3_V_OFF = H3_K_OFF + 64 * H3_QSTR, H3_T_OFF = H3_V_OFF + 128 * HG_STR, H3_O_OFF = H3_T_OFF + 2048;
__device__ __forceinline__ void hgrn_h3_unit(LAS unsigned char* lds, bf16_t* QH, const bf16_t* KIN, const float* G, const bf16_t* HI, const bf16_t* HG, const bf16_t* SB, int unit, int tid, int lane, int wave) {
    const int c = unit & 63, bh = unit >> 6, b = bh >> 3, h = bh & 7;
    const size_t row0 = (size_t)b * SEQ + c * 64;
    LAS unsigned char* Bl = lds + H3_B_OFF;
    LAS unsigned char* Qs = lds + H3_Q_OFF;
    LAS unsigned char* Ks = lds + H3_K_OFF;
    LAS unsigned char* Vt = lds + H3_V_OFF;
    LAS float* tot = (LAS float*)(lds + H3_T_OFF);
    LAS float* osq = (LAS float*)(lds + H3_O_OFF);
    {
        const int k = tid & 127, sg = tid >> 7;
        float bl[16]; float run = 0.f;
#pragma unroll
        for (int i = 0; i < 16; ++i) { run += G[(row0 + sg * 16 + i) * 1024 + h * 128 + k]; bl[i] = run; }
        tot[sg * 128 + k] = run;
        float vv[16];
#pragma unroll
        for (int i = 0; i < 16; ++i) vv[i] = bf2f(HI[(row0 + sg * 16 + i) * 1024 + h * 128 + k]);
        u32x4 w0, w1;
        w0.x = pk2(vv[0], vv[1]); w0.y = pk2(vv[2], vv[3]); w0.z = pk2(vv[4], vv[5]); w0.w = pk2(vv[6], vv[7]);
        w1.x = pk2(vv[8], vv[9]); w1.y = pk2(vv[10], vv[11]); w1.z = pk2(vv[12], vv[13]); w1.w = pk2(vv[14], vv[15]);
        *(LAS u32x4*)(Vt + k * HG_STR + sg * 32) = w0; *(LAS u32x4*)(Vt + k * HG_STR + sg * 32 + 16) = w1;
#pragma unroll
        for (int i = 0; i < 2; ++i) {
            const int idx = tid + 512 * i, rr = idx >> 4, ch = idx & 15;
            *(LAS u32x4*)(Qs + rr * H3_QSTR + ch * 16) = *(const u32x4*)(QH + (row0 + rr) * 2048 + 1024 + h * 128 + ch * 8);
            *(LAS u32x4*)(Ks + rr * H3_QSTR + ch * 16) = *(const u32x4*)(KIN + (row0 + rr) * 1024 + h * 128 + ch * 8);
        }
        __syncthreads();
        const float t0 = tot[k], t1 = tot[128 + k], t2 = tot[256 + k];
        const float off = (sg > 0 ? t0 : 0.f) + (sg > 1 ? t1 : 0.f) + (sg > 2 ? t2 : 0.f);
#pragma unroll
        for (int i = 0; i < 16; ++i) *(LAS float*)(Bl + (sg * 16 + i) * H3_BSTR + k * 4) = bl[i] + off;
        __syncthreads();
    }
    const int i4 = wave & 3, vh = wave >> 2, fr = lane & 15, hh = lane >> 4;
    const int tq = 16 * i4 + fr;
    bf16x8 qhat[4], qtil[4];
#pragma unroll
    for (int ks = 0; ks < 4; ++ks) {
        const int k0 = 32 * ks + 8 * hh;
        const u32x4 qw = *(const LAS u32x4*)(Qs + tq * H3_QSTR + k0 * 2);
        const f32x4 b0 = *(const LAS f32x4*)(Bl + tq * H3_BSTR + k0 * 4), b1 = *(const LAS f32x4*)(Bl + tq * H3_BSTR + k0 * 4 + 16);
        f32x4 r0 = (f32x4){0.f, 0.f, 0.f, 0.f}, r1 = r0;
        if (i4 > 0) { r0 = *(const LAS f32x4*)(Bl + (16 * i4 - 1) * H3_BSTR + k0 * 4); r1 = *(const LAS f32x4*)(Bl + (16 * i4 - 1) * H3_BSTR + k0 * 4 + 16); }
        const float q[8] = {bflo(qw.x), bfhi(qw.x), bflo(qw.y), bfhi(qw.y), bflo(qw.z), bfhi(qw.z), bflo(qw.w), bfhi(qw.w)};
        const float bb[8] = {b0[0], b0[1], b0[2], b0[3], b1[0], b1[1], b1[2], b1[3]};
        const float rf[8] = {r0[0], r0[1], r0[2], r0[3], r1[0], r1[1], r1[2], r1[3]};
        float a[8], t8[8];
#pragma unroll
        for (int e = 0; e < 8; ++e) { a[e] = q[e] * __expf(bb[e] - rf[e]); t8[e] = q[e] * __expf(bb[e]); }
        qhat[ks] = pack8(a[0], a[1], a[2], a[3], a[4], a[5], a[6], a[7]);
        qtil[ks] = pack8(t8[0], t8[1], t8[2], t8[3], t8[4], t8[5], t8[6], t8[7]);
    }
    f32x4 at[4];
#pragma unroll
    for (int j = 0; j < 4; ++j) {
        at[j] = (f32x4){0.f, 0.f, 0.f, 0.f};
        if (j <= i4) {
            const int sr = 16 * j + fr;
#pragma unroll
            for (int ks = 0; ks < 4; ++ks) {
                const int k0 = 32 * ks + 8 * hh;
                const u32x4 kw = *(const LAS u32x4*)(Ks + sr * H3_QSTR + k0 * 2);
                const f32x4 b0 = *(const LAS f32x4*)(Bl + sr * H3_BSTR + k0 * 4), b1 = *(const LAS f32x4*)(Bl + sr * H3_BSTR + k0 * 4 + 16);
                f32x4 r0 = (f32x4){0.f, 0.f, 0.f, 0.f}, r1 = r0;
                if (i4 > 0) { r0 = *(const LAS f32x4*)(Bl + (16 * i4 - 1) * H3_BSTR + k0 * 4); r1 = *(const LAS f32x4*)(Bl + (16 * i4 - 1) * H3_BSTR + k0 * 4 + 16); }
                const float kk[8] = {bflo(kw.x), bfhi(kw.x), bflo(kw.y), bfhi(kw.y), bflo(kw.z), bfhi(kw.z), bflo(kw.w), bfhi(kw.w)};
                const float bb[8] = {b0[0], b0[1], b0[2], b0[3], b1[0], b1[1], b1[2], b1[3]};
                const float rf[8] = {r0[0], r0[1], r0[2], r0[3], r1[0], r1[1], r1[2], r1[3]};
                float a[8];
#pragma unroll
                for (int e = 0; e < 8; ++e) a[e] = kk[e] * __expf(fminf(rf[e] - bb[e], 80.f));
                const bf16x8 kf = pack8(a[0], a[1], a[2], a[3], a[4], a[5], a[6], a[7]);
                at[j] = __builtin_amdgcn_mfma_f32_16x16x32_bf16(kf, qhat[ks], at[j], 0, 0, 0);
            }
            if (j == i4) {
#pragma unroll
                for (int rg = 0; rg < 4; ++rg) if (4 * hh + rg > fr) at[j][rg] = 0.f;
            }
        }
    }
    f32x4 o[4];
#pragma unroll
    for (int vt = 0; vt < 4; ++vt) o[vt] = (f32x4){0.f, 0.f, 0.f, 0.f};
#pragma unroll
    for (int p = 0; p < 2; ++p) {
        if (2 * p <= i4) {
            const bf16x8 pf = pack8(at[2 * p][0], at[2 * p][1], at[2 * p][2], at[2 * p][3], at[2 * p + 1][0], at[2 * p + 1][1], at[2 * p + 1][2], at[2 * p + 1][3]);
#pragma unroll
            for (int vt = 0; vt < 4; ++vt) {
                const LAS unsigned char* vrow = Vt + (64 * vh + 16 * vt + fr) * HG_STR;
                const u32x2 lo = *(const LAS u32x2*)(vrow + (32 * p + 4 * hh) * 2), hi2 = *(const LAS u32x2*)(vrow + (32 * p + 16 + 4 * hh) * 2);
                u32x4 w; w.x = lo.x; w.y = lo.y; w.z = hi2.x; w.w = hi2.y;
                o[vt] = __builtin_amdgcn_mfma_f32_16x16x32_bf16(__builtin_bit_cast(bf16x8, w), pf, o[vt], 0, 0, 0);
            }
        }
    }
    {
        const bf16_t* sb = SB + (size_t)unit * 16384;
#pragma unroll
        for (int vt = 0; vt < 4; ++vt)
#pragma unroll
            for (int ks = 0; ks < 4; ++ks) {
                const bf16x8 sf = *(const bf16x8*)(sb + (64 * vh + 16 * vt + fr) * 128 + 32 * ks + 8 * hh);
                o[vt] = __builtin_amdgcn_mfma_f32_16x16x32_bf16(sf, qtil[ks], o[vt], 0, 0, 0);
            }
    }
    float ss = 0.f;
#pragma unroll
    for (int vt = 0; vt < 4; ++vt) ss += (o[vt][0] * o[vt][0] + o[vt][1] * o[vt][1]) + (o[vt][2] * o[vt][2] + o[vt][3] * o[vt][3]);
    ss += shx(ss, lane, 16); ss += shx(ss, lane, 32);
    if (hh == 0) osq[vh * 64 + tq] = ss;
    __syncthreads();
    const float rn = rsqrtf((osq[tq] + osq[64 + tq]) * (1.0f / 128.0f) + EPS);
#pragma unroll
    for (int vt = 0; vt < 4; ++vt) {
        const int v = 64 * vh + 16 * vt + 4 * hh;
        const u32x2 gw = *(const u32x2*)(HG + (row0 + tq) * 1024 + h * 128 + v);
        u32x2 w; w.x = cvt_pk_bf16(o[vt][0] * rn * bflo(gw.x), o[vt][1] * rn * bfhi(gw.x)); w.y = cvt_pk_bf16(o[vt][2] * rn * bflo(gw.y), o[vt][3] * rn * bfhi(gw.y));
        *(u32x2*)(QH + (row0 + tq) * 2048 + 1024 + h * 128 + v) = w;
    }
    __syncthreads();
}

__global__ void __launch_bounds__(NTHR, 2) fwd_megakernel(Args args) {
    extern __shared__ __attribute__((aligned(16))) unsigned char lds_raw[];
    LAS unsigned char* lds = (LAS unsigned char*)lds_raw;
    cg::grid_group grid = cg::this_grid();
    const int G = gridDim.x, bx = blockIdx.x, ngw = G * NWAVES, nthr = G * NTHR;
    const int wave = __builtin_amdgcn_readfirstlane((int)threadIdx.x >> 6);
#define PHASE_IDS() int lane_; asm volatile("v_mbcnt_lo_u32_b32 %0, -1, 0\n\tv_mbcnt_hi_u32_b32 %0, -1, %0" : "=v"(lane_)); const int lane = lane_, tid = wave * 64 + lane, gw = bx * NWAVES + wave, gtid = bx * NTHR + tid; (void)gw; (void)gtid
    unsigned char* ws = args.ws;
    const float* x_in = (const float*)args.in[0]; const float* p_in = (const float*)args.in[1]; const int* pos = (const int*)args.in[2];
    const float* w_in = (const float*)args.in[3]; const float* sinks = (const float*)args.in[4]; const float* lb_logits = (const float*)args.in[5];
    const float* attn_gain = (const float*)args.in[6]; const float* hgrn_gain = (const float*)args.in[7]; const float* w_out = (const float*)args.in[8];
    const float* pre_mix = (const float*)args.in[9]; const float* post_mix = (const float*)args.in[10]; const float* pre_ffn = (const float*)args.in[11]; const float* post_ffn = (const float*)args.in[12];
    const float* w_gate = (const float*)args.in[13]; const float* w_up = (const float*)args.in[14]; const float* w_down = (const float*)args.in[15];
    const float* ple_gain = (const float*)args.in[16]; const float* w_pg = (const float*)args.in[17]; const float* w_pp = (const float*)args.in[18];
    float* out = args.out;
    float* stat = (float*)(ws + WS_STAT); float* lbt = (float*)(ws + WS_LBT); float* cs = (float*)(ws + WS_CS);
    bf16_t* PBF = (bf16_t*)(ws + WS_PBF); bf16_t* HA = (bf16_t*)(ws + WS_HA); float* tmpO = (float*)(ws + WS_HA);
    bf16_t* QH = (bf16_t*)(ws + WS_QH); bf16_t* Kb = (bf16_t*)(ws + WS_K); bf16_t* Vb = (bf16_t*)(ws + WS_V); float* Gb = (float*)(ws + WS_G);
    bf16_t* KIN = (bf16_t*)(ws + WS_KIN); bf16_t* HI = (bf16_t*)(ws + WS_HI); bf16_t* HG = (bf16_t*)(ws + WS_HG);
    bf16_t* SBuf = (bf16_t*)(ws + WS_HA); float* DEC = (float*)(ws + WS_DEC);
    bf16_t* Mb = (bf16_t*)(ws + WS_M); bf16_t* ACT = (bf16_t*)(ws + WS_ACT); bf16_t* Fb = (bf16_t*)(ws + WS_F); bf16_t* PP = (bf16_t*)(ws + WS_PP);

    {
        PHASE_IDS();
        LAS float* scr = (LAS float*)(lds + wave * 16384);
        constexpr int I_IN = 32 * 176, I_OUT = 32 * 64, I_G = 32 * 176, I_D = 88 * 64, I_PG = 32 * 64, I_PP = 4 * 64;
        constexpr int I_L = I_IN + I_OUT + 2 * I_G + I_D + I_PG + I_PP;
        for (int it = gw; it < DEPTH * I_L; it += ngw) {
            const int l = it / I_L; int r = it % I_L;
            unsigned char* wl = ws + WS_W + (size_t)l * WL_SIZE;
            if (r < I_IN) {
                const int kb = r / 176, nb = r % 176, n0 = nb * 32, pn = n0 >> 8; int prow0 = n0;
                if (pn <= 4) { const int lc = n0 & 255; prow0 = (pn << 8) + 128 * ((lc >> 5) & 1) + 32 * ((lc >> 6) & 3); }
                tr_item(w_in + (size_t)l * DM * DIN, DIN, DM, kb * 64, n0, (bf16_t*)(wl + WL_IN), prow0, pre_mix + l * DM, scr, lane); continue; }
            r -= I_IN;
            if (r < I_OUT) {
                const int kb = r / 64, nb = r % 64; const int k0 = kb * 64;
                const float* gp = (k0 < 1024) ? (attn_gain + l * 1024) : (hgrn_gain + l * 1024 - 1024);
                tr_item(w_out + (size_t)l * DM * DM, DM, DM, k0, nb * 32, (bf16_t*)(wl + WL_OUT), nb * 32, gp, scr, lane); continue; }
            r -= I_OUT;
            if (r < 2 * I_G) {
                const int up = r >= I_G; if (up) r -= I_G;
                const int kb = r / 176, nb = r % 176, n0 = nb * 32; const int prow0 = 256 * (n0 >> 7) + (n0 & 127) + (up ? 128 : 0);
                tr_item((up ? w_up : w_gate) + (size_t)l * DM * DFF, DFF, DM, kb * 64, n0, (bf16_t*)(wl + WL_GU), prow0, pre_ffn + l * DM, scr, lane); continue; }
            r -= 2 * I_G;
            if (r < I_D) { const int kb = r / 64, nb = r % 64;
                tr_item(w_down + (size_t)l * DFF * DM, DM, DFF, kb * 64, nb * 32, (bf16_t*)(wl + WL_DOWN), nb * 32, nullptr, scr, lane); continue; }
            r -= I_D;
            if (r < I_PG) { const int kb = r / 64, nb = r % 64;
                tr_item(w_pg + (size_t)l * DM * DM, DM, DM, kb * 64, nb * 32, (bf16_t*)(wl + WL_PG), nb * 32, ple_gain + l * DM, scr, lane); continue; }
            r -= I_PG;
            { const int kb = r / 64, nb = r % 64;
                tr_item(w_pp + (size_t)l * DPLE * DM, DM, DPLE, kb * 64, nb * 32, (bf16_t*)(wl + WL_PP), nb * 32, nullptr, scr, lane); }
        }
        for (int i = gtid; i < 12 * T; i += nthr) stat[i] = 0.f;
        for (int i = gtid; i < 1024; i += nthr) {
            const float l0 = lb_logits[i], l1 = lb_logits[1024 + i];
            lbt[i] = 0.f; lbt[1024 + i] = 1.0f / (1.0f + expf(l0 - l1));
        }
        for (int i = gtid; i < T * 32; i += nthr) {
            const int row = i >> 5, d = i & 31;
            const double rev = (double)pos[row] * c_invf[d] * 0.15915494309189535;
            const float fr = (float)(rev - rint(rev));
            cs[(size_t)row * 64 + d] = __builtin_amdgcn_cosf(fr); cs[(size_t)row * 64 + 32 + d] = __builtin_amdgcn_sinf(fr);
        }
        for (int i = gtid; i < DEPTH * T * DPLE / 8; i += nthr) {
            const f32x4 a = *(const f32x4*)(p_in + (size_t)i * 8), b = *(const f32x4*)(p_in + (size_t)i * 8 + 4);
            u32x4 w; w.x = pk2(a[0], a[1]); w.y = pk2(a[2], a[3]); w.z = pk2(b[0], b[1]); w.w = pk2(b[2], b[3]);
            *(u32x4*)(PBF + (size_t)i * 8) = w;
        }
    }
    grid.sync();
    { PHASE_IDS();
    for (int row = gw; row < T; row += ngw) {
        float ss = 0.f;
#pragma unroll
        for (int j = 0; j < 4; ++j) {
            const int c = j * 512 + lane * 8; const size_t off = (size_t)row * 2048 + c;
            const f32x4 x0 = *(const f32x4*)(x_in + off), x1 = *(const f32x4*)(x_in + off + 4);
            u32x4 w; w.x = pk2(x0[0], x0[1]); w.y = pk2(x0[2], x0[3]); w.z = pk2(x1[0], x1[1]); w.w = pk2(x1[2], x1[3]);
            *(u32x4*)(HA + off) = w;
            ss += (x0[0] * x0[0] + x0[1] * x0[1]) + (x0[2] * x0[2] + x0[3] * x0[3]) + (x1[0] * x1[0] + x1[1] * x1[1]) + (x1[2] * x1[2] + x1[3] * x1[3]);
        }
        ss = wave_sum(ss, lane);
        if (lane == 0) stat[(SQ_X + 0) * T + row] = ss;
    } }
    grid.sync();

    for (int l = 0; l < DEPTH; ++l) {
        unsigned char* wl = ws + WS_W + (size_t)l * WL_SIZE;
        float* ssqX = stat + (SQ_X + l) * T; float* ssqA = stat + (SQ_A + l) * T; float* ssqM = stat + (SQ_M + l) * T;
        float* ssq2 = stat + (SQ_2 + l) * T; float* ssqF = stat + (SQ_F + l) * T; float* ssq3 = stat + (SQ_3 + l) * T;
        {
            PHASE_IDS(); pg8::Gemm g{l == 0 ? HA : (const bf16_t*)(ws + WS_W + (size_t)(l - 1) * WL_SIZE), (const bf16_t*)(wl + WL_IN), T, DIN, DM}; pg8::StaticOrder S; S.init(T, DIN, G, bx);
            EpiIn E{0, ssqX, cs, lbt + l * 1024, QH, Kb, Vb, Gb, KIN, HI, HG};
            if (PH & 1) pg8::gemm_phase<EpiIn, pg8::StaticOrder, true, true>(lds, g, S, E, tid);
        }
        grid.sync();
#if !NAIVE_MIX
        { PHASE_IDS();
          for (int u = bx; u < 512; u += G) attn_unit(lds, QH, Kb, Vb, sinks + l * 16, ssqA, u, tid, lane, wave);
          for (int u = bx; u < 2048; u += G) hgrn_h1_unit(lds, KIN, Gb, HI, SBuf, DEC, u, tid, lane, wave); }
        grid.sync();
        { PHASE_IDS(); hgrn_scan(SBuf, DEC, gtid, nthr); }
        grid.sync();
        { PHASE_IDS();
          for (int u = bx; u < 2048; u += G) hgrn_h3_unit(lds, QH, KIN, Gb, HI, HG, SBuf, u, tid, lane, wave); }
        grid.sync();
#else
        { PHASE_IDS();
        if (bx < 64 && wave == 0) hgrn_naive(QH, KIN, Gb, HI, tmpO, bx, lane);
        attn_naive(QH, Kb, Vb, sinks + l * 16, ssqA, gtid, nthr); }
        grid.sync();
        { PHASE_IDS(); hgrn_norm_naive(tmpO, HG, QH, gw, ngw, lane); }
        grid.sync();
#endif
        {
            PHASE_IDS(); pg8::Gemm g{QH, (const bf16_t*)(wl + WL_OUT), T, DM, DM}; pg8::StaticOrder S; S.init(T, DM, G, bx);
            EpiRowSsq<true> E{16, Mb, ssqM, ssqA};
            if (PH & 2) pg8::gemm_phase<EpiRowSsq<true>, pg8::StaticOrder, true, true>(lds, g, S, E, tid);
        }
        grid.sync();
        { PHASE_IDS(); row_phase(l == 0 ? x_in : out, out, Mb, ssqM, post_mix + l * DM, HA, ssq2, gw, ngw, lane); }
        grid.sync();
        {
            PHASE_IDS(); pg8::Gemm g{HA, (const bf16_t*)(wl + WL_GU), T, 2 * DFF, DM}; pg8::StaticOrder S; S.init(T, 2 * DFF, G, bx);
            EpiGU E{0, ssq2, ACT};
            if (PH & 4) pg8::gemm_phase<EpiGU, pg8::StaticOrder, true, true>(lds, g, S, E, tid);
        }
        grid.sync();
        {
            PHASE_IDS(); pg8::Gemm g{ACT, (const bf16_t*)(wl + WL_DOWN), T, DM, DFF}; pg8::StaticOrder S; S.init(T, DM, G, bx);
            EpiRowSsq<false> E{0, Fb, ssqF, nullptr};
            if (PH & 8) pg8::gemm_phase<EpiRowSsq<false>, pg8::StaticOrder, true, true>(lds, g, S, E, tid);
        }
        grid.sync();
        { PHASE_IDS(); row_phase(out, out, Fb, ssqF, post_ffn + l * DM, HA, ssq3, gw, ngw, lane); }
        grid.sync();
        {
            PHASE_IDS(); int kpp = DPLE; asm volatile("" : "+s"(kpp)); pg8::Gemm g{PBF + (size_t)l * T * DPLE, (const bf16_t*)(wl + WL_PP), T, DM, kpp}; pg8::StaticOrder S; S.init(T, DM, G, bx);
            EpiPlain E{0, PP};
            if (PH & 16) pg8::gemm_phase<EpiPlain, pg8::StaticOrder, true, true>(lds, g, S, E, tid);
        }
        {
            PHASE_IDS(); pg8::Gemm g{HA, (const bf16_t*)(wl + WL_PG), T, DM, DM}; pg8::StaticOrder S; S.init(T, DM, G, bx);
            EpiPle E{0, ssq3, PP, out, (bf16_t*)wl, stat + (SQ_X + (l + 1 < DEPTH ? l + 1 : 0)) * T, l + 1 < DEPTH ? 1 : 0};
            if (PH & 32) pg8::gemm_phase<EpiPle, pg8::StaticOrder, true, true>(lds, g, S, E, tid);
        }
        if (l + 1 < DEPTH) grid.sync();
    }
}

extern "C" void kernel_launch(void* const* d_in, const int* in_sizes, int n_in, void* d_out, int out_size, void* d_ws, size_t ws_size, hipStream_t stream) {
    static int grid = 0;
    if (grid == 0) {
        if (n_in != 19 || out_size != T * DM || ws_size < WS_END) { fprintf(stderr, "kernel_launch: unexpected shapes (n_in %d out %d ws %zu need %zu)\n", n_in, out_size, ws_size, (size_t)WS_END); grid = -1; return; }
        int dev = 0, cus = 0, per_cu = 0;
        hipGetDevice(&dev);
        hipDeviceGetAttribute(&cus, hipDeviceAttributeMultiprocessorCount, dev);
        if (hipFuncSetAttribute((const void*)fwd_megakernel, hipFuncAttributeMaxDynamicSharedMemorySize, LDS_BYTES) != hipSuccess) { fprintf(stderr, "kernel_launch: hipFuncSetAttribute failed\n"); grid = -1; return; }
        if (hipOccupancyMaxActiveBlocksPerMultiprocessor(&per_cu, (const void*)fwd_megakernel, NTHR, LDS_BYTES) != hipSuccess || per_cu < 1) { fprintf(stderr, "kernel_launch: occupancy query gave %d\n", per_cu); per_cu = 1; }
        (void)hipGetLastError();
        grid = cus * per_cu;
    }
    if (grid < 0) return;
    Args a{};
    for (int i = 0; i < 19; ++i) a.in[i] = d_in[i];
    a.out = (float*)d_out; a.ws = (unsigned char*)d_ws;
    void* kargs[] = {&a};
    hipError_t e = hipLaunchCooperativeKernel((const void*)fwd_megakernel, dim3(grid), dim3(NTHR), kargs, LDS_BYTES, stream);
    if (e != hipSuccess) fprintf(stderr, "cooperative launch failed: %s (grid %d)\n", hipGetErrorString(e), grid);
}
```

```cpp
#include <hip/hip_runtime.h>
#include <hip/hip_cooperative_groups.h>
#include <cstdio>
#include <cstdint>
namespace cg = cooperative_groups;

#ifndef PH
#define PH 63
#endif
#ifndef NAIVE_MIX
#define NAIVE_MIX 0
#endif

namespace pg8 {
#define PG8_LAS __attribute__((address_space(3)))
typedef unsigned short bf16_t;
typedef short bf16x8 __attribute__((ext_vector_type(8)));
typedef float f32x4 __attribute__((ext_vector_type(4)));
typedef unsigned u32x4 __attribute__((ext_vector_type(4)));
constexpr int BM = 256, BK = 64, HALF = 128, HTB = HALF * BK * 2, STAGE_BYTES = 8 * HTB, NXCD = 8, WGM = 8;

__host__ __device__ __forceinline__ int lds_byte(int r, int c) { const int st = (r >> 4) * 2 + (c >> 5), rr = r & 15, cc = c & 31, ob = rr * 64 + cc * 2; return st * 1024 + (ob ^ (((ob >> 9) & 1) << 5)); }
__host__ __device__ __forceinline__ void stage_rc(int b, int& R, int& C) { const int st = b / 1024, sb = b % 1024, swz = sb ^ (((sb >> 9) & 1) << 5); R = (st >> 1) * 16 + swz / 64; C = (st & 1) * 32 + (swz % 64) / 2; }
__host__ __device__ __forceinline__ int perm32(int rho) { const int n = rho >> 4, i = rho & 15; return 8 * (i >> 2) + 4 * n + (i & 3); }

struct Unit { int pm, pn; };
struct Gemm { const bf16_t* A; const bf16_t* Bt; int M, N, K; };

struct StaticOrder {
    int nM, nN, nwg, G, c;
    __host__ __device__ void init(int M, int N, int G_, int c_) { nM = M / BM; nN = N / BM; nwg = nM * nN; G = G_; c = c_; }
    __host__ __device__ bool next(int i, Unit& u) const {
        const long L = (long)i * G + c; if (L >= nwg) return false;
        int wgid = (int)L; { const int q = nwg / NXCD, r = nwg % NXCD, xcd = wgid % NXCD, off = wgid / NXCD; wgid = (xcd < r ? xcd * (q + 1) : r * (q + 1) + (xcd - r) * q) + off; }
        const int nig = WGM * nN, gid = wgid / nig, fm = gid * WGM, gsz = (nM - fm) < WGM ? (nM - fm) : WGM;
        u.pm = fm + ((wgid % nig) % gsz); u.pn = (wgid % nig) / gsz; return true;
    }
    __device__ __forceinline__ void a_ready(const Unit&) const {}
    __device__ __forceinline__ void done(const Unit&) const {}
};

__device__ __forceinline__ unsigned cvt_pk_bf16(float lo, float hi) { unsigned r; asm volatile("v_cvt_pk_bf16_f32 %0, %1, %2" : "=v"(r) : "v"(lo), "v"(hi)); return r; }

template <class Epi, class Sched, bool ALIGN_EPI = false, bool SP2 = false>
__device__ __forceinline__ void gemm_phase(PG8_LAS unsigned char* lds, const Gemm g, const Sched& S, const Epi& E, int tid_in) {
    int tid_ = tid_in; asm volatile("" : "+v"(tid_));
    const int tid = tid_, wid = __builtin_amdgcn_readfirstlane(tid >> 6), lane = tid & 63, wr = wid >> 2, wc = wid & 3, fr = lane & 15, fq = lane >> 4;
    const int K = g.K, nt = K / BK;
    unsigned voffA[2], voffB[2];
#pragma unroll
    for (int i = 0; i < 2; ++i) { int R, C; stage_rc(tid * 16 + i * 8192, R, C); const int Rb = Epi::PERM ? ((R & ~31) + perm32(R & 31)) : R;
        voffA[i] = (unsigned)(R * K + C) * 2u; voffB[i] = (unsigned)(Rb * K + C) * 2u; }
    const size_t kstep = (size_t)(BK * 2);
    const size_t hstep = (size_t)HALF * K * 2;
    const size_t tstep = 2 * hstep;
    const unsigned ldsw = (unsigned)wid * 1024u;
    const int aoff = lds_byte(wr * 64 + fr, fq * 8), boff = lds_byte(wc * 32 + fr, fq * 8);
#define PG8_SA(b, h) (((b) * 2 + (h)) * HTB)
#define PG8_SB(b, h) ((4 + (b) * 2 + (h)) * HTB)
#define PG8_STAGE(bufoff, gbase, voff) do { _Pragma("unroll") for (int _i = 0; _i < 2; ++_i) \
        __builtin_amdgcn_global_load_lds((const unsigned*)((const char*)(gbase) + (voff)[_i]), (PG8_LAS unsigned*)(lds + (bufoff) + ldsw + _i * 8192), 16, 0, 0); } while (0)
#define PG8_LDA(dst, b, h) do { _Pragma("unroll") for (int m = 0; m < 4; ++m) _Pragma("unroll") for (int k = 0; k < 2; ++k) dst[m][k] = *(const PG8_LAS bf16x8*)(lds + PG8_SA(b, h) + aoff + m * 2048 + k * 1024); } while (0)
#define PG8_LDB(dst, b, h) do { _Pragma("unroll") for (int n = 0; n < 2; ++n) _Pragma("unroll") for (int k = 0; k < 2; ++k) dst[n][k] = *(const PG8_LAS bf16x8*)(lds + PG8_SB(b, h) + boff + n * 2048 + k * 1024); } while (0)
#define PG8_MMA(ai, bj, At, Bt) do { __builtin_amdgcn_s_setprio(1); _Pragma("unroll") for (int m = 0; m < 4; ++m) _Pragma("unroll") for (int n = 0; n < 2; ++n) _Pragma("unroll") for (int k = 0; k < 2; ++k) \
        acc[ai][bj][m][n] = __builtin_amdgcn_mfma_f32_16x16x32_bf16(Bt[n][k], At[m][k], acc[ai][bj][m][n], 0, 0, 0); __builtin_amdgcn_s_setprio(0); } while (0)
#define PG8_WAIT_V(n) asm volatile("s_waitcnt vmcnt(" #n ")" ::: "memory")
#define PG8_WAIT_L(n) asm volatile("s_waitcnt lgkmcnt(" #n ")" ::: "memory")
#define PG8_BAR __builtin_amdgcn_s_barrier()
#define PG8_SCHED __builtin_amdgcn_sched_barrier(0)
    Unit cur, nxt; int ui = 0;
    if (!S.next(0, cur)) return;
    f32x4 acc[2][2][4][2];
#pragma unroll
    for (int a = 0; a < 2; ++a)
#pragma unroll
        for (int b = 0; b < 2; ++b)
#pragma unroll
            for (int m = 0; m < 4; ++m)
#pragma unroll
                for (int n = 0; n < 2; ++n) acc[a][b][m][n] = (f32x4){0.f, 0.f, 0.f, 0.f};
    bf16x8 At[4][2], B0[2][2], B1[2][2];
    const char* cA = (const char*)g.A + (size_t)cur.pm * tstep; const char* cB = (const char*)g.Bt + (size_t)cur.pn * tstep;
    S.a_ready(cur);
    if constexpr (SP2) {
        PG8_STAGE(PG8_SB(0, 0), cB, voffB); PG8_STAGE(PG8_SB(0, 1), cB + hstep, voffB); PG8_STAGE(PG8_SA(0, 0), cA, voffA); PG8_STAGE(PG8_SA(0, 1), cA + hstep, voffA);
        if (wr == 1) PG8_BAR;
        PG8_WAIT_V(2); PG8_BAR;
        PG8_STAGE(PG8_SB(1, 0), cB + kstep, voffB); PG8_STAGE(PG8_SA(1, 0), cA + kstep, voffA); PG8_STAGE(PG8_SB(1, 1), cB + hstep + kstep, voffB);
        PG8_WAIT_V(6); PG8_BAR;
    } else {
        PG8_STAGE(PG8_SB(0, 0), cB, voffB); PG8_STAGE(PG8_SA(0, 0), cA, voffA); PG8_STAGE(PG8_SB(0, 1), cB + hstep, voffB); PG8_STAGE(PG8_SA(0, 1), cA + hstep, voffA);
        if (wr == 1) PG8_BAR;
        PG8_WAIT_V(4); PG8_BAR;
        PG8_STAGE(PG8_SB(1, 0), cB + kstep, voffB); PG8_STAGE(PG8_SA(1, 0), cA + kstep, voffA); PG8_STAGE(PG8_SB(1, 1), cB + hstep + kstep, voffB);
        PG8_WAIT_V(6); PG8_BAR;
    }
    for (;;) {
        const bool has_next = S.next(ui + 1, nxt);
        const char* nA = has_next ? (const char*)g.A + (size_t)nxt.pm * tstep : cA; const char* nB = has_next ? (const char*)g.Bt + (size_t)nxt.pn * tstep : cB;
        for (int t = 0; t < nt; t += 2) {
            const bool last = (t == nt - 2);
            const char* a1 = cA + (size_t)(t + 1) * kstep;
            const char* a2 = last ? nA : cA + (size_t)(t + 2) * kstep; const char* b2 = last ? nB : cB + (size_t)(t + 2) * kstep;
            const char* a3 = a2 + kstep; const char* b3 = b2 + kstep;
            if (last && has_next) S.a_ready(nxt);
            if constexpr (Epi::MID) { if (t == E.kmid) { int l2 = lane; asm volatile("" : "+v"(l2)); E.mid(acc, cur, wr, wc, l2 & 15, l2 >> 4); } }
            if constexpr (SP2) {
            PG8_LDB(B0, 0, 0); PG8_LDB(B1, 0, 1); PG8_SCHED; PG8_LDA(At, 0, 0); PG8_STAGE(PG8_SA(1, 1), a1 + hstep, voffA);
            PG8_WAIT_V(8); PG8_WAIT_L(0); PG8_BAR; PG8_MMA(0, 0, At, B0); PG8_MMA(0, 1, At, B1); PG8_BAR; PG8_SCHED;
            PG8_LDA(At, 0, 1); PG8_STAGE(PG8_SB(0, 0), b2, voffB); PG8_STAGE(PG8_SB(0, 1), b2 + hstep, voffB); PG8_STAGE(PG8_SA(0, 0), a2, voffA);
            PG8_WAIT_V(8); PG8_WAIT_L(0); PG8_BAR; PG8_MMA(1, 0, At, B0); PG8_MMA(1, 1, At, B1); PG8_BAR; PG8_SCHED;
            PG8_LDB(B0, 1, 0); PG8_LDB(B1, 1, 1); PG8_SCHED; PG8_LDA(At, 1, 0); PG8_STAGE(PG8_SA(0, 1), a2 + hstep, voffA);
            PG8_WAIT_V(8); PG8_WAIT_L(0); PG8_BAR; PG8_MMA(0, 0, At, B0); PG8_MMA(0, 1, At, B1); PG8_BAR; PG8_SCHED;
            PG8_LDA(At, 1, 1); PG8_STAGE(PG8_SB(1, 0), b3, voffB); PG8_STAGE(PG8_SB(1, 1), b3 + hstep, voffB); PG8_STAGE(PG8_SA(1, 0), a3, voffA);
            PG8_WAIT_V(8); PG8_WAIT_L(0); PG8_BAR; PG8_MMA(1, 0, At, B0); PG8_MMA(1, 1, At, B1); PG8_BAR; PG8_SCHED;
            } else {
            PG8_LDB(B0, 0, 0); PG8_SCHED; PG8_LDA(At, 0, 0); PG8_STAGE(PG8_SA(1, 1), a1 + hstep, voffA);
            PG8_WAIT_L(8); PG8_BAR; PG8_WAIT_L(0); PG8_MMA(0, 0, At, B0); PG8_BAR; PG8_SCHED;
            PG8_LDB(B1, 0, 1); PG8_STAGE(PG8_SB(0, 0), b2, voffB);
            PG8_BAR; PG8_WAIT_L(0); PG8_MMA(0, 1, At, B1); PG8_BAR;
            PG8_LDA(At, 0, 1); PG8_STAGE(PG8_SA(0, 0), a2, voffA);
            PG8_BAR; PG8_WAIT_L(0); PG8_MMA(1, 0, At, B0); PG8_BAR; PG8_SCHED;
            PG8_STAGE(PG8_SB(0, 1), b2 + hstep, voffB);
            PG8_WAIT_V(6); PG8_BAR; PG8_MMA(1, 1, At, B1); PG8_BAR;
            PG8_LDB(B0, 1, 0); PG8_SCHED; PG8_LDA(At, 1, 0); PG8_STAGE(PG8_SA(0, 1), a2 + hstep, voffA);
            PG8_WAIT_L(8); PG8_BAR; PG8_WAIT_L(0); PG8_MMA(0, 0, At, B0); PG8_BAR; PG8_SCHED;
            PG8_LDB(B1, 1, 1); PG8_STAGE(PG8_SB(1, 0), b3, voffB);
            PG8_BAR; PG8_WAIT_L(0); PG8_MMA(0, 1, At, B1); PG8_BAR;
            PG8_LDA(At, 1, 1); PG8_STAGE(PG8_SA(1, 0), a3, voffA);
            PG8_BAR; PG8_WAIT_L(0); PG8_MMA(1, 0, At, B0); PG8_BAR; PG8_SCHED;
            PG8_STAGE(PG8_SB(1, 1), b3 + hstep, voffB);
            PG8_WAIT_V(6); PG8_BAR; PG8_MMA(1, 1, At, B1); PG8_BAR;
            }
        }
        if constexpr (ALIGN_EPI) { if (wr == 0) PG8_BAR; }
        { int l2 = lane; asm volatile("" : "+v"(l2)); E(acc, cur, wr, wc, l2 & 15, l2 >> 4); }
        if (!has_next) break;
#pragma unroll
        for (int a = 0; a < 2; ++a)
#pragma unroll
            for (int b = 0; b < 2; ++b)
#pragma unroll
                for (int m = 0; m < 4; ++m)
#pragma unroll
                    for (int n = 0; n < 2; ++n) acc[a][b][m][n] = (f32x4){0.f, 0.f, 0.f, 0.f};
        cur = nxt; cA = nA; cB = nB; ++ui;
        if constexpr (ALIGN_EPI) { if (wr == 1) PG8_BAR; }
    }
    PG8_WAIT_V(0);
    if constexpr (!ALIGN_EPI) { if (wr == 0) PG8_BAR; }
    PG8_BAR;
#undef PG8_SA
#undef PG8_SB
#undef PG8_STAGE
#undef PG8_LDA
#undef PG8_LDB
#undef PG8_MMA
#undef PG8_WAIT_V
#undef PG8_WAIT_L
#undef PG8_BAR
#undef PG8_SCHED
}
}

using pg8::bf16_t; using pg8::f32x4; using pg8::u32x4; using pg8::Unit; using pg8::cvt_pk_bf16;
#define LAS __attribute__((address_space(3)))
constexpr int NB = 4, SEQ = 4096, T = NB * SEQ, DM = 2048, DIN = 5632, DFF = 5632, DPLE = 256, DEPTH = 2;
constexpr float EPS = 1e-6f;
constexpr float LOG2E = 1.4426950408889634f;
constexpr float QSCALE = 0.125f * LOG2E;
constexpr int NWAVES = 8, NTHR = 512;
constexpr int LDS_BYTES = 147456;

constexpr size_t MiB = 1u << 20;
constexpr size_t WS_STAT = 0;
constexpr size_t WS_LBT = 768 * 1024;
constexpr size_t WS_BAR = 800 * 1024;
constexpr size_t WS_CS = 1 * MiB;
constexpr size_t WS_W = 5 * MiB;
constexpr size_t WL_IN = 0, WL_OUT = 22 * MiB, WL_GU = 30 * MiB, WL_DOWN = 74 * MiB, WL_PG = 96 * MiB, WL_PP = 104 * MiB, WL_SIZE = 105 * MiB;
constexpr size_t WS_PBF = 215 * MiB;
constexpr size_t WS_HA = 231 * MiB;
constexpr size_t WS_R = 295 * MiB;
constexpr size_t WS_QH = WS_R, WS_K = WS_R + 64 * MiB, WS_V = WS_R + 72 * MiB, WS_G = WS_R + 80 * MiB, WS_KIN = WS_R + 144 * MiB, WS_HI = WS_R + 176 * MiB, WS_HG = WS_R + 208 * MiB;
constexpr size_t WS_M = WS_G, WS_ACT = WS_R, WS_F = WS_R + 176 * MiB, WS_PP = WS_R;
constexpr size_t WS_DEC = WS_R + 240 * MiB;
constexpr size_t WS_END = WS_DEC + 1 * MiB;
enum { SQ_X = 0, SQ_A = 2, SQ_M = 4, SQ_2 = 6, SQ_F = 8, SQ_3 = 10 };

__constant__ double c_invf[32] = {1.0, 0.7498942093324559, 0.5623413251903491, 0.4216965034285822, 0.31622776601683794, 0.23713737056616552, 0.1778279410038923, 0.1333521432163324, 0.09999999999999999, 0.07498942093324558, 0.056234132519034905, 0.042169650342858224, 0.03162277660168379, 0.023713737056616554, 0.01778279410038923, 0.013335214321633239, 0.01, 0.007498942093324559, 0.005623413251903491, 0.004216965034285822, 0.0031622776601683794, 0.002371373705661655, 0.0017782794100389228, 0.0013335214321633238, 0.001, 0.0007498942093324559, 0.000562341325190349, 0.00042169650342858224, 0.00031622776601683794, 0.00023713737056616554, 0.0001778279410038923, 0.0001333521432163324};

__device__ __forceinline__ float bf2f(unsigned h) { return __uint_as_float(h << 16); }
__device__ __forceinline__ float bflo(unsigned w) { return __uint_as_float(w << 16); }
__device__ __forceinline__ float bfhi(unsigned w) { return __uint_as_float(w & 0xffff0000u); }
__device__ __forceinline__ unsigned f2bf(float f) { unsigned u = __float_as_uint(f); return (u + 0x7fffu + ((u >> 16) & 1u)) >> 16; }
__device__ __forceinline__ unsigned pk2(float lo, float hi) { return f2bf(lo) | (f2bf(hi) << 16); }
__device__ __forceinline__ float shx(float v, int lane, int m) { return __int_as_float(__builtin_amdgcn_ds_bpermute((lane ^ m) << 2, __float_as_int(v))); }
__device__ __forceinline__ float wave_sum(float v, int lane) {
#pragma unroll
    for (int o = 1; o < 64; o <<= 1) v += shx(v, lane, o);
    return v;
}
__device__ __forceinline__ float sigmoidf_(float z) { return 1.0f / (1.0f + __expf(-z)); }
__device__ __forceinline__ float siluf_(float z) { return z / (1.0f + __expf(-z)); }

struct EpiIn {
    static constexpr bool PERM = true, MID = false;
    int kmid;
    const float* ssqX; const float* cs; const float* lb;
    bf16_t* QH; bf16_t* Kb; bf16_t* Vb; float* G; bf16_t* KIN; bf16_t* HI; bf16_t* HG;
    __device__ __forceinline__ void mid(f32x4 (&acc)[2][2][4][2], const Unit& u, int wr, int wc, int fr, int fq) const {}
    __device__ __forceinline__ void operator()(const f32x4 (&acc)[2][2][4][2], const Unit& u, int wr, int wc, int fr, int fq) const {
        const int pn = u.pn;
#pragma unroll
        for (int ai = 0; ai < 2; ++ai)
#pragma unroll
            for (int m = 0; m < 4; ++m) {
                const int row = u.pm * 256 + ai * 128 + wr * 64 + m * 16 + fr;
                const float rs = rsqrtf(ssqX[row] * (1.0f / DM) + EPS);
                if (pn <= 4) {
                    const int d0 = 8 * fq;
                    const f32x4 c0 = *(const f32x4*)(cs + (size_t)row * 64 + d0), c1 = *(const f32x4*)(cs + (size_t)row * 64 + d0 + 4);
                    const f32x4 s0 = *(const f32x4*)(cs + (size_t)row * 64 + 32 + d0), s1 = *(const f32x4*)(cs + (size_t)row * 64 + 32 + d0 + 4);
                    const float sc = (pn < 4) ? rs * QSCALE : rs;
                    const f32x4 a0 = acc[ai][0][m][0] * sc, a1 = acc[ai][0][m][1] * sc, b0 = acc[ai][1][m][0] * sc, b1 = acc[ai][1][m][1] * sc;
                    const f32x4 o10 = a0 * c0 - b0 * s0, o11 = a1 * c1 - b1 * s1, o20 = b0 * c0 + a0 * s0, o21 = b1 * c1 + a1 * s1;
                    u32x4 w1, w2;
                    w1.x = cvt_pk_bf16(o10[0], o10[1]); w1.y = cvt_pk_bf16(o10[2], o10[3]); w1.z = cvt_pk_bf16(o11[0], o11[1]); w1.w = cvt_pk_bf16(o11[2], o11[3]);
                    w2.x = cvt_pk_bf16(o20[0], o20[1]); w2.y = cvt_pk_bf16(o20[2], o20[3]); w2.z = cvt_pk_bf16(o21[0], o21[1]); w2.w = cvt_pk_bf16(o21[2], o21[3]);
                    bf16_t* dst = (pn < 4) ? (QH + (size_t)row * 2048 + (pn * 4 + wc) * 64 + d0) : (Kb + (size_t)row * 256 + wc * 64 + d0);
                    *(u32x4*)dst = w1; *(u32x4*)(dst + 32) = w2;
                } else {
#pragma unroll
                    for (int bj = 0; bj < 2; ++bj) {
                        const int cl = bj * 128 + wc * 32 + 8 * fq;
                        f32x4 v0 = acc[ai][bj][m][0] * rs, v1 = acc[ai][bj][m][1] * rs;
                        if (pn == 5) {
                            u32x4 w; w.x = cvt_pk_bf16(v0[0], v0[1]); w.y = cvt_pk_bf16(v0[2], v0[3]); w.z = cvt_pk_bf16(v1[0], v1[1]); w.w = cvt_pk_bf16(v1[2], v1[3]);
                            *(u32x4*)(Vb + (size_t)row * 256 + cl) = w;
                        } else if (pn < 10) {
                            const int c = (pn - 6) * 256 + cl;
#pragma unroll
                            for (int j = 0; j < 4; ++j) { v0[j] = siluf_(v0[j]); v1[j] = siluf_(v1[j]); }
                            u32x4 w; w.x = cvt_pk_bf16(v0[0], v0[1]); w.y = cvt_pk_bf16(v0[2], v0[3]); w.z = cvt_pk_bf16(v1[0], v1[1]); w.w = cvt_pk_bf16(v1[2], v1[3]);
                            *(u32x4*)(QH + (size_t)row * 2048 + 1024 + c) = w;
                        } else if (pn < 14) {
                            const int c = (pn - 10) * 256 + cl;
                            const f32x4 l0 = *(const f32x4*)(lb + c), l1 = *(const f32x4*)(lb + c + 4);
                            f32x4 g0, g1, k0, k1;
#pragma unroll
                            for (int j = 0; j < 4; ++j) {
                                { const float z = fminf(fmaxf(v0[j], -30.f), 30.f), e = __expf(-z), sg = 1.0f / (1.0f + e), om = 1.0f - l0[j]; g0[j] = __logf(l0[j] + om * sg); k0[j] = om * e * sg; }
                                { const float z = fminf(fmaxf(v1[j], -30.f), 30.f), e = __expf(-z), sg = 1.0f / (1.0f + e), om = 1.0f - l1[j]; g1[j] = __logf(l1[j] + om * sg); k1[j] = om * e * sg; }
                            }
                            *(f32x4*)(G + (size_t)row * 1024 + c) = g0; *(f32x4*)(G + (size_t)row * 1024 + c + 4) = g1;
                            u32x4 w; w.x = cvt_pk_bf16(k0[0], k0[1]); w.y = cvt_pk_bf16(k0[2], k0[3]); w.z = cvt_pk_bf16(k1[0], k1[1]); w.w = cvt_pk_bf16(k1[2], k1[3]);
                            *(u32x4*)(KIN + (size_t)row * 1024 + c) = w;
                        } else if (pn < 18) {
                            const int c = (pn - 14) * 256 + cl;
                            u32x4 w; w.x = cvt_pk_bf16(v0[0], v0[1]); w.y = cvt_pk_bf16(v0[2], v0[3]); w.z = cvt_pk_bf16(v1[0], v1[1]); w.w = cvt_pk_bf16(v1[2], v1[3]);
                            *(u32x4*)(HI + (size_t)row * 1024 + c) = w;
                        } else {
                            const int c = (pn - 18) * 256 + cl;
#pragma unroll
                            for (int j = 0; j < 4; ++j) { v0[j] = siluf_(v0[j]); v1[j] = siluf_(v1[j]); }
                            u32x4 w; w.x = cvt_pk_bf16(v0[0], v0[1]); w.y = cvt_pk_bf16(v0[2], v0[3]); w.z = cvt_pk_bf16(v1[0], v1[1]); w.w = cvt_pk_bf16(v1[2], v1[3]);
                            *(u32x4*)(HG + (size_t)row * 1024 + c) = w;
                        }
                    }
                }
                asm volatile("" ::: "memory");
            }
    }
};

template <bool MIDS> struct EpiRowSsq {
    static constexpr bool PERM = true, MID = MIDS;
    int kmid;
    bf16_t* O; float* ssq; const float* ssqA;
    __device__ __forceinline__ void mid(f32x4 (&acc)[2][2][4][2], const Unit& u, int wr, int wc, int fr, int fq) const {
#pragma unroll
        for (int ai = 0; ai < 2; ++ai)
#pragma unroll
            for (int m = 0; m < 4; ++m) {
                const int row = u.pm * 256 + ai * 128 + wr * 64 + m * 16 + fr;
                const float s = rsqrtf(ssqA[row] * (1.0f / 1024.0f) + EPS);
#pragma unroll
                for (int bj = 0; bj < 2; ++bj)
#pragma unroll
                    for (int n = 0; n < 2; ++n) acc[ai][bj][m][n] = acc[ai][bj][m][n] * s;
            }
    }
    __device__ __forceinline__ void operator()(const f32x4 (&acc)[2][2][4][2], const Unit& u, int wr, int wc, int fr, int fq) const {
#pragma unroll
        for (int ai = 0; ai < 2; ++ai)
#pragma unroll
            for (int m = 0; m < 4; ++m) {
                const int row = u.pm * 256 + ai * 128 + wr * 64 + m * 16 + fr;
                float q = 0.f;
#pragma unroll
                for (int bj = 0; bj < 2; ++bj) {
                    const f32x4 v0 = acc[ai][bj][m][0], v1 = acc[ai][bj][m][1];
                    q += (v0[0] * v0[0] + v0[1] * v0[1]) + (v0[2] * v0[2] + v0[3] * v0[3]) + (v1[0] * v1[0] + v1[1] * v1[1]) + (v1[2] * v1[2] + v1[3] * v1[3]);
                    u32x4 w; w.x = cvt_pk_bf16(v0[0], v0[1]); w.y = cvt_pk_bf16(v0[2], v0[3]); w.z = cvt_pk_bf16(v1[0], v1[1]); w.w = cvt_pk_bf16(v1[2], v1[3]);
                    *(u32x4*)(O + (size_t)row * 2048 + u.pn * 256 + bj * 128 + wc * 32 + 8 * fq) = w;
                }
                q += shx(q, fq * 16 + fr, 16); q += shx(q, fq * 16 + fr, 32);
                if (fq == 0) atomicAdd(ssq + row, q);
                asm volatile("" ::: "memory");
            }
    }
};

struct EpiGU {
    static constexpr bool PERM = true, MID = false;
    int kmid;
    const float* ssq2; bf16_t* ACT;
    __device__ __forceinline__ void mid(f32x4 (&acc)[2][2][4][2], const Unit& u, int wr, int wc, int fr, int fq) const {}
    __device__ __forceinline__ void operator()(const f32x4 (&acc)[2][2][4][2], const Unit& u, int wr, int wc, int fr, int fq) const {
#pragma unroll
        for (int ai = 0; ai < 2; ++ai)
#pragma unroll
            for (int m = 0; m < 4; ++m) {
                const int row = u.pm * 256 + ai * 128 + wr * 64 + m * 16 + fr;
                const float rs = rsqrtf(ssq2[row] * (1.0f / DM) + EPS);
                f32x4 o0, o1;
#pragma unroll
                for (int j = 0; j < 4; ++j) {
                    const float g0 = acc[ai][0][m][0][j] * rs, u0 = acc[ai][1][m][0][j] * rs, g1 = acc[ai][0][m][1][j] * rs, u1 = acc[ai][1][m][1][j] * rs;
                    o0[j] = siluf_(g0) * u0; o1[j] = siluf_(g1) * u1;
                }
                u32x4 w; w.x = cvt_pk_bf16(o0[0], o0[1]); w.y = cvt_pk_bf16(o0[2], o0[3]); w.z = cvt_pk_bf16(o1[0], o1[1]); w.w = cvt_pk_bf16(o1[2], o1[3]);
                *(u32x4*)(ACT + (size_t)row * DFF + u.pn * 128 + wc * 32 + 8 * fq) = w;
                asm volatile("" ::: "memory");
            }
    }
};

struct EpiPlain {
    static constexpr bool PERM = true, MID = false;
    int kmid;
    bf16_t* O;
    __device__ __forceinline__ void mid(f32x4 (&acc)[2][2][4][2], const Unit& u, int wr, int wc, int fr, int fq) const {}
    __device__ __forceinline__ void operator()(const f32x4 (&acc)[2][2][4][2], const Unit& u, int wr, int wc, int fr, int fq) const {
#pragma unroll
        for (int ai = 0; ai < 2; ++ai)
#pragma unroll
            for (int m = 0; m < 4; ++m) {
                const int row = u.pm * 256 + ai * 128 + wr * 64 + m * 16 + fr;
#pragma unroll
                for (int bj = 0; bj < 2; ++bj) {
                    const f32x4 v0 = acc[ai][bj][m][0], v1 = acc[ai][bj][m][1];
                    u32x4 w; w.x = cvt_pk_bf16(v0[0], v0[1]); w.y = cvt_pk_bf16(v0[2], v0[3]); w.z = cvt_pk_bf16(v1[0], v1[1]); w.w = cvt_pk_bf16(v1[2], v1[3]);
                    *(u32x4*)(O + (size_t)row * 2048 + u.pn * 256 + bj * 128 + wc * 32 + 8 * fq) = w;
                }
                asm volatile("" ::: "memory");
            }
    }
};

struct EpiPle {
    static constexpr bool PERM = true, MID = false;
    int kmid;
    const float* ssq3; const bf16_t* PP; float* X; bf16_t* HA; float* ssqN; int has_next;
    __device__ __forceinline__ void mid(f32x4 (&acc)[2][2][4][2], const Unit& u, int wr, int wc, int fr, int fq) const {}
    __device__ __forceinline__ void operator()(const f32x4 (&acc)[2][2][4][2], const Unit& u, int wr, int wc, int fr, int fq) const {
#pragma unroll
        for (int ai = 0; ai < 2; ++ai)
#pragma unroll
            for (int m = 0; m < 4; ++m) {
                const int row = u.pm * 256 + ai * 128 + wr * 64 + m * 16 + fr;
                const float rs = rsqrtf(ssq3[row] * (1.0f / DM) + EPS);
                float q = 0.f;
#pragma unroll
                for (int bj = 0; bj < 2; ++bj) {
                    const size_t off = (size_t)row * 2048 + u.pn * 256 + bj * 128 + wc * 32 + 8 * fq;
                    const u32x4 pw = *(const u32x4*)(PP + off);
                    f32x4 x0 = *(const f32x4*)(X + off), x1 = *(const f32x4*)(X + off + 4);
                    const f32x4 v0 = acc[ai][bj][m][0] * rs, v1 = acc[ai][bj][m][1] * rs;
                    x0[0] += bflo(pw.x) * sigmoidf_(v0[0]); x0[1] += bfhi(pw.x) * sigmoidf_(v0[1]); x0[2] += bflo(pw.y) * sigmoidf_(v0[2]); x0[3] += bfhi(pw.y) * sigmoidf_(v0[3]);
                    x1[0] += bflo(pw.z) * sigmoidf_(v1[0]); x1[1] += bfhi(pw.z) * sigmoidf_(v1[1]); x1[2] += bflo(pw.w) * sigmoidf_(v1[2]); x1[3] += bfhi(pw.w) * sigmoidf_(v1[3]);
                    *(f32x4*)(X + off) = x0; *(f32x4*)(X + off + 4) = x1;
                    if (has_next) {
                        q += (x0[0] * x0[0] + x0[1] * x0[1]) + (x0[2] * x0[2] + x0[3] * x0[3]) + (x1[0] * x1[0] + x1[1] * x1[1]) + (x1[2] * x1[2] + x1[3] * x1[3]);
                        u32x4 w; w.x = cvt_pk_bf16(x0[0], x0[1]); w.y = cvt_pk_bf16(x0[2], x0[3]); w.z = cvt_pk_bf16(x1[0], x1[1]); w.w = cvt_pk_bf16(x1[2], x1[3]);
                        *(u32x4*)(HA + off) = w;
                    }
                }
                if (has_next) { q += shx(q, fq * 16 + fr, 16); q += shx(q, fq * 16 + fr, 32); if (fq == 0) atomicAdd(ssqN + row, q); }
                asm volatile("" ::: "memory");
            }
    }
};

__device__ __forceinline__ void tr_item(const float* W, int ldw, int K, int k0, int n0, bf16_t* WT, int prow0, const float* gain, LAS float* scr, int lane) {
#pragma unroll 8
    for (int i = 0; i < 32; ++i) { const int kk = 2 * i + (lane >> 5); float w = W[(size_t)(k0 + kk) * ldw + n0 + (lane & 31)]; if (gain) w *= gain[k0 + kk]; scr[kk * 33 + (lane & 31)] = w; }
    asm volatile("s_waitcnt lgkmcnt(0)" ::: "memory");
    const int c = lane & 7;
#pragma unroll
    for (int j = 0; j < 4; ++j) { const int n = (lane >> 3) + 8 * j; const LAS float* s = scr + (8 * c) * 33 + n;
        u32x4 o; o.x = pk2(s[0 * 33], s[1 * 33]); o.y = pk2(s[2 * 33], s[3 * 33]); o.z = pk2(s[4 * 33], s[5 * 33]); o.w = pk2(s[6 * 33], s[7 * 33]);
        *(u32x4*)(WT + (size_t)(prow0 + n) * K + k0 + 8 * c) = o; }
    asm volatile("s_waitcnt lgkmcnt(0)" ::: "memory");
}

struct Args { const void* in[19]; float* out; unsigned char* ws; };

__device__ __forceinline__ void row_phase(const float* xsrc, float* xdst, const bf16_t* Mb, const float* ssqIn, const float* gain, bf16_t* HA, float* ssqOut, int gw, int ngw, int lane) {
    for (int row = gw; row < T; row += ngw) {
        const float rm = rsqrtf(ssqIn[row] * (1.0f / DM) + EPS);
        float ss = 0.f;
#pragma unroll
        for (int j = 0; j < 4; ++j) {
            const int c = j * 512 + lane * 8; const size_t off = (size_t)row * 2048 + c;
            const u32x4 mv = *(const u32x4*)(Mb + off);
            f32x4 x0 = *(const f32x4*)(xsrc + off), x1 = *(const f32x4*)(xsrc + off + 4);
            const f32x4 g0 = *(const f32x4*)(gain + c), g1 = *(const f32x4*)(gain + c + 4);
            x0[0] += bflo(mv.x) * rm * g0[0]; x0[1] += bfhi(mv.x) * rm * g0[1]; x0[2] += bflo(mv.y) * rm * g0[2]; x0[3] += bfhi(mv.y) * rm * g0[3];
            x1[0] += bflo(mv.z) * rm * g1[0]; x1[1] += bfhi(mv.z) * rm * g1[1]; x1[2] += bflo(mv.w) * rm * g1[2]; x1[3] += bfhi(mv.w) * rm * g1[3];
            *(f32x4*)(xdst + off) = x0; *(f32x4*)(xdst + off + 4) = x1;
            u32x4 w; w.x = pk2(x0[0], x0[1]); w.y = pk2(x0[2], x0[3]); w.z = pk2(x1[0], x1[1]); w.w = pk2(x1[2], x1[3]);
            *(u32x4*)(HA + off) = w;
            ss += (x0[0] * x0[0] + x0[1] * x0[1]) + (x0[2] * x0[2] + x0[3] * x0[3]) + (x1[0] * x1[0] + x1[1] * x1[1]) + (x1[2] * x1[2] + x1[3] * x1[3]);
        }
        ss = wave_sum(ss, lane);
        if (lane == 0) ssqOut[row] = ss;
    }
}

__device__ __forceinline__ void attn_naive(bf16_t* QH, const bf16_t* Kb, const bf16_t* Vb, const float* sinks, float* ssqA, int gtid, int nthr) {
    for (int item = gtid; item < T * 16; item += nthr) {
        const int head = item / T, row = item % T, b = row / SEQ, t = row % SEQ, hk = head >> 2;
        float q[64], acc[64];
        const u32x4* qp = (const u32x4*)(QH + (size_t)row * 2048 + head * 64);
#pragma unroll
        for (int c = 0; c < 8; ++c) { const u32x4 w = qp[c]; q[8 * c] = bflo(w.x); q[8 * c + 1] = bfhi(w.x); q[8 * c + 2] = bflo(w.y); q[8 * c + 3] = bfhi(w.y); q[8 * c + 4] = bflo(w.z); q[8 * c + 5] = bfhi(w.z); q[8 * c + 6] = bflo(w.w); q[8 * c + 7] = bfhi(w.w); }
#pragma unroll
        for (int d = 0; d < 64; ++d) acc[d] = 0.f;
        float mx = sinks[head] * LOG2E, l = 1.0f;
        const int j0 = t - 127 < 0 ? 0 : t - 127;
        for (int j = j0; j <= t; ++j) {
            const size_t kr = (size_t)(b * SEQ + j) * 256 + hk * 64;
            const u32x4* kp = (const u32x4*)(Kb + kr);
            float s = 0.f;
#pragma unroll
            for (int c = 0; c < 8; ++c) { const u32x4 w = kp[c]; s += q[8 * c] * bflo(w.x) + q[8 * c + 1] * bfhi(w.x) + q[8 * c + 2] * bflo(w.y) + q[8 * c + 3] * bfhi(w.y) + q[8 * c + 4] * bflo(w.z) + q[8 * c + 5] * bfhi(w.z) + q[8 * c + 6] * bflo(w.w) + q[8 * c + 7] * bfhi(w.w); }
            if (s > mx) { const float cf = exp2f(mx - s); l *= cf;
#pragma unroll
                for (int d = 0; d < 64; ++d) acc[d] *= cf;
                mx = s; }
            const float p = exp2f(s - mx); l += p;
            const u32x4* vp = (const u32x4*)(Vb + kr);
#pragma unroll
            for (int c = 0; c < 8; ++c) { const u32x4 w = vp[c]; acc[8 * c] += p * bflo(w.x); acc[8 * c + 1] += p * bfhi(w.x); acc[8 * c + 2] += p * bflo(w.y); acc[8 * c + 3] += p * bfhi(w.y); acc[8 * c + 4] += p * bflo(w.z); acc[8 * c + 5] += p * bfhi(w.z); acc[8 * c + 6] += p * bflo(w.w); acc[8 * c + 7] += p * bfhi(w.w); }
        }
        const float il = 1.0f / l; float ss = 0.f;
        u32x4* op = (u32x4*)(QH + (size_t)row * 2048 + head * 64);
#pragma unroll
        for (int c = 0; c < 8; ++c) {
            float o[8];
#pragma unroll
            for (int e = 0; e < 8; ++e) { o[e] = acc[8 * c + e] * il; ss += o[e] * o[e]; }
            u32x4 w; w.x = pk2(o[0], o[1]); w.y = pk2(o[2], o[3]); w.z = pk2(o[4], o[5]); w.w = pk2(o[6], o[7]); op[c] = w;
        }
        atomicAdd(ssqA + row, ss);
    }
}

__device__ __forceinline__ void hgrn_naive(const bf16_t* QH, const bf16_t* KIN, const float* G, const bf16_t* HI, float* tmpO, int item, int lane) {
    const int bh = item >> 1, b = bh >> 3, h = bh & 7, v = (item & 1) * 64 + lane;
    float S[128];
#pragma unroll
    for (int k = 0; k < 128; ++k) S[k] = 0.f;
    int z = 0; asm volatile("v_mov_b32 %0, 0" : "=v"(z));
    for (int t = 0; t < SEQ; ++t) {
        const size_t row = (size_t)b * SEQ + t;
        const float vv = bf2f(HI[row * 1024 + h * 128 + v]);
        const u32x4* qp = (const u32x4*)(QH + row * 2048 + 1024 + h * 128 + z);
        const u32x4* kp = (const u32x4*)(KIN + row * 1024 + h * 128 + z);
        const f32x4* gp = (const f32x4*)(G + row * 1024 + h * 128 + z);
        float o = 0.f;
#pragma unroll
        for (int c = 0; c < 16; ++c) {
            const u32x4 qw = qp[c], kw = kp[c]; const f32x4 g0 = gp[2 * c], g1 = gp[2 * c + 1];
            const float qq[8] = {bflo(qw.x), bfhi(qw.x), bflo(qw.y), bfhi(qw.y), bflo(qw.z), bfhi(qw.z), bflo(qw.w), bfhi(qw.w)};
            const float kk[8] = {bflo(kw.x), bfhi(kw.x), bflo(kw.y), bfhi(kw.y), bflo(kw.z), bfhi(kw.z), bflo(kw.w), bfhi(kw.w)};
            const float gg[8] = {g0[0], g0[1], g0[2], g0[3], g1[0], g1[1], g1[2], g1[3]};
#pragma unroll
            for (int e = 0; e < 8; ++e) { const float f = __expf(gg[e]); S[8 * c + e] = f * S[8 * c + e] + kk[e] * vv; o += S[8 * c + e] * qq[e]; }
        }
        tmpO[row * 1024 + h * 128 + v] = o;
    }
}
__device__ __forceinline__ void hgrn_norm_naive(const float* tmpO, const bf16_t* HG, bf16_t* QH, int gw, int ngw, int lane) {
    for (int row = gw; row < T; row += ngw) {
        const size_t off = (size_t)row * 1024 + lane * 16;
        f32x4 o[4]; float ss = 0.f;
#pragma unroll
        for (int j = 0; j < 4; ++j) { o[j] = *(const f32x4*)(tmpO + off + 4 * j); ss += (o[j][0] * o[j][0] + o[j][1] * o[j][1]) + (o[j][2] * o[j][2] + o[j][3] * o[j][3]); }
        ss += shx(ss, lane, 1); ss += shx(ss, lane, 2); ss += shx(ss, lane, 4);
        const float r = rsqrtf(ss * (1.0f / 128.0f) + EPS);
        const u32x4 g0 = *(const u32x4*)(HG + off), g1 = *(const u32x4*)(HG + off + 8);
        u32x4 w0, w1;
        w0.x = pk2(o[0][0] * r * bflo(g0.x), o[0][1] * r * bfhi(g0.x)); w0.y = pk2(o[0][2] * r * bflo(g0.y), o[0][3] * r * bfhi(g0.y));
        w0.z = pk2(o[1][0] * r * bflo(g0.z), o[1][1] * r * bfhi(g0.z)); w0.w = pk2(o[1][2] * r * bflo(g0.w), o[1][3] * r * bfhi(g0.w));
        w1.x = pk2(o[2][0] * r * bflo(g1.x), o[2][1] * r * bfhi(g1.x)); w1.y = pk2(o[2][2] * r * bflo(g1.y), o[2][3] * r * bfhi(g1.y));
        w1.z = pk2(o[3][0] * r * bflo(g1.z), o[3][1] * r * bfhi(g1.z)); w1.w = pk2(o[3][2] * r * bflo(g1.w), o[3][3] * r * bfhi(g1.w));
        bf16_t* dst = QH + (size_t)row * 2048 + 1024 + lane * 16;
        *(u32x4*)dst = w0; *(u32x4*)(dst + 8) = w1;
    }
}


typedef float f32x16 __attribute__((ext_vector_type(16)));
typedef short bf16x8 __attribute__((ext_vector_type(8)));
typedef unsigned u32x2 __attribute__((ext_vector_type(2)));
__device__ __forceinline__ int crow(int r, int hi) { return (r & 3) + 8 * (r >> 2) + 4 * hi; }
__device__ __forceinline__ bf16x8 pack8(float a0, float a1, float a2, float a3, float a4, float a5, float a6, float a7) {
    u32x4 w; w.x = cvt_pk_bf16(a0, a1); w.y = cvt_pk_bf16(a2, a3); w.z = cvt_pk_bf16(a4, a5); w.w = cvt_pk_bf16(a6, a7); return __builtin_bit_cast(bf16x8, w);
}
constexpr int AT_KSTR = 144, AT_VSTR = 528, AT_VOFF = 256 * AT_KSTR;

__device__ __forceinline__ void attn_unit(LAS unsigned char* lds, bf16_t* QH, const bf16_t* Kb, const bf16_t* Vb, const float* sinks, float* ssqA, int unit, int tid, int lane, int wave) {
    const int hk = unit & 3, n = (unit >> 2) & 31, b = unit >> 7;
    const long rowbase = (long)b * SEQ + n * 128 - 128;
    LAS unsigned char* Ks = lds; LAS unsigned char* Vt = lds + AT_VOFF;
#pragma unroll
    for (int i = 0; i < 4; ++i) {
        const int row = (tid >> 3) + 64 * i; u32x4 v = (u32x4){0u, 0u, 0u, 0u};
        if (n > 0 || row >= 128) v = *(const u32x4*)(Kb + (rowbase + row) * 256 + hk * 64 + (tid & 7) * 8);
        *(LAS u32x4*)(Ks + row * AT_KSTR + (tid & 7) * 16) = v;
    }
#pragma unroll
    for (int i = 0; i < 4; ++i) {
        const int key = lane + 64 * i; u32x4 v = (u32x4){0u, 0u, 0u, 0u};
        if (n > 0 || key >= 128) v = *(const u32x4*)(Vb + (rowbase + key) * 256 + hk * 64 + wave * 8);
        LAS unsigned short* vp = (LAS unsigned short*)(Vt + (wave * 8) * AT_VSTR + key * 2);
        vp[0 * 264] = (unsigned short)(v.x & 0xffffu); vp[1 * 264] = (unsigned short)(v.x >> 16); vp[2 * 264] = (unsigned short)(v.y & 0xffffu); vp[3 * 264] = (unsigned short)(v.y >> 16);
        vp[4 * 264] = (unsigned short)(v.z & 0xffffu); vp[5 * 264] = (unsigned short)(v.z >> 16); vp[6 * 264] = (unsigned short)(v.w & 0xffffu); vp[7 * 264] = (unsigned short)(v.w >> 16);
    }
    __syncthreads();
    const int g = wave >> 1, qh = wave & 1, head = hk * 4 + g, r = lane & 31, h = lane >> 5;
    const float sink2 = sinks[head] * LOG2E;
    for (int qt = 0; qt < 2; ++qt) {
        const int t0 = 64 * qh + 32 * qt, t = t0 + r;
        const size_t qrow = (size_t)b * SEQ + n * 128 + t;
        bf16_t* qp = QH + qrow * 2048 + head * 64;
        bf16x8 qf[4];
#pragma unroll
        for (int s4 = 0; s4 < 4; ++s4) qf[s4] = *(const bf16x8*)(qp + 16 * s4 + 8 * h);
        f32x16 S[5];
#pragma unroll
        for (int jt = 0; jt < 5; ++jt) {
            const int kb = t0 + 32 * jt;
            f32x16 a = {};
#pragma unroll
            for (int s4 = 0; s4 < 4; ++s4) { const bf16x8 kf = *(const LAS bf16x8*)(Ks + (kb + r) * AT_KSTR + (16 * s4 + 8 * h) * 2); a = __builtin_amdgcn_mfma_f32_32x32x16_bf16(kf, qf[s4], a, 0, 0, 0); }
            S[jt] = a;
        }
        float mx = sink2;
#pragma unroll
        for (int jt = 0; jt < 5; ++jt)
#pragma unroll
            for (int rg = 0; rg < 16; ++rg) {
                const int ki = t0 + 32 * jt + crow(rg, h);
                const bool ok = (ki > t) && (ki <= t + 128) && (n > 0 || ki >= 128);
                const float v = ok ? S[jt][rg] : -1e30f; S[jt][rg] = v; mx = fmaxf(mx, v);
            }
        mx = fmaxf(mx, shx(mx, lane, 32));
        float l = 0.f;
#pragma unroll
        for (int jt = 0; jt < 5; ++jt)
#pragma unroll
            for (int rg = 0; rg < 16; ++rg) { const float p = __builtin_amdgcn_exp2f(S[jt][rg] - mx); S[jt][rg] = p; l += p; }
        l += shx(l, lane, 32);
        l += __builtin_amdgcn_exp2f(sink2 - mx);
        f32x16 O[2]; O[0] = (f32x16){}; O[1] = (f32x16){};
#pragma unroll
        for (int jt = 0; jt < 5; ++jt)
#pragma unroll
            for (int sp = 0; sp < 2; ++sp) {
                const bf16x8 pf = pack8(S[jt][8 * sp], S[jt][8 * sp + 1], S[jt][8 * sp + 2], S[jt][8 * sp + 3], S[jt][8 * sp + 4], S[jt][8 * sp + 5], S[jt][8 * sp + 6], S[jt][8 * sp + 7]);
                const int kk = t0 + 32 * jt + 16 * sp + 4 * h;
#pragma unroll
                for (int dt = 0; dt < 2; ++dt) {
                    const LAS unsigned char* vrow = Vt + (32 * dt + r) * AT_VSTR + kk * 2;
                    const u32x2 lo = *(const LAS u32x2*)vrow, hi2 = *(const LAS u32x2*)(vrow + 16);
                    u32x4 w; w.x = lo.x; w.y = lo.y; w.z = hi2.x; w.w = hi2.y;
                    O[dt] = __builtin_amdgcn_mfma_f32_32x32x16_bf16(__builtin_bit_cast(bf16x8, w), pf, O[dt], 0, 0, 0);
                }
            }
        const float il = 1.0f / l; float ss = 0.f;
#pragma unroll
        for (int dt = 0; dt < 2; ++dt)
#pragma unroll
            for (int gp = 0; gp < 4; ++gp) {
                const float o0 = O[dt][4 * gp] * il, o1 = O[dt][4 * gp + 1] * il, o2 = O[dt][4 * gp + 2] * il, o3 = O[dt][4 * gp + 3] * il;
                ss += (o0 * o0 + o1 * o1) + (o2 * o2 + o3 * o3);
                u32x2 w; w.x = cvt_pk_bf16(o0, o1); w.y = cvt_pk_bf16(o2, o3);
                *(u32x2*)(qp + 32 * dt + 8 * gp + 4 * h) = w;
            }
        ss += shx(ss, lane, 32);
        if (h == 0) atomicAdd(ssqA + qrow, ss);
    }
    __syncthreads();
}

constexpr int HG_STR = 144;
__device__ __forceinline__ void hgrn_h1_unit(LAS unsigned char* lds, const bf16_t* KIN, const float* G, const bf16_t* HI, bf16_t* SB, float* DEC, int unit, int tid, int lane, int wave) {
    const int c = unit & 63, bh = unit >> 6, b = bh >> 3, h = bh & 7;
    const size_t row0 = (size_t)b * SEQ + c * 64;
    LAS unsigned char* Kt = lds;
    LAS unsigned char* Vt = lds + 128 * HG_STR;
    LAS float* tot = (LAS float*)(lds + 2 * 128 * HG_STR);
    const int k = tid & 127, sg = tid >> 7;
    float bl[16]; float run = 0.f;
#pragma unroll
    for (int i = 0; i < 16; ++i) { run += G[(row0 + sg * 16 + i) * 1024 + h * 128 + k]; bl[i] = run; }
    tot[sg * 128 + k] = run;
    float kv[16], vv[16];
#pragma unroll
    for (int i = 0; i < 16; ++i) { kv[i] = bf2f(KIN[(row0 + sg * 16 + i) * 1024 + h * 128 + k]); vv[i] = bf2f(HI[(row0 + sg * 16 + i) * 1024 + h * 128 + k]); }
    __syncthreads();
    const float t0 = tot[k], t1 = tot[128 + k], t2 = tot[256 + k], t3 = tot[384 + k];
    const float blast = (t0 + t1) + (t2 + t3);
    const float off = (sg > 0 ? t0 : 0.f) + (sg > 1 ? t1 : 0.f) + (sg > 2 ? t2 : 0.f);
    if (sg == 0) DEC[(size_t)unit * 128 + k] = __expf(blast);
    float kt[16];
#pragma unroll
    for (int i = 0; i < 16; ++i) kt[i] = kv[i] * __expf(blast - (bl[i] + off));
    {
        u32x4 w0, w1;
        w0.x = pk2(kt[0], kt[1]); w0.y = pk2(kt[2], kt[3]); w0.z = pk2(kt[4], kt[5]); w0.w = pk2(kt[6], kt[7]);
        w1.x = pk2(kt[8], kt[9]); w1.y = pk2(kt[10], kt[11]); w1.z = pk2(kt[12], kt[13]); w1.w = pk2(kt[14], kt[15]);
        *(LAS u32x4*)(Kt + k * HG_STR + sg * 32) = w0; *(LAS u32x4*)(Kt + k * HG_STR + sg * 32 + 16) = w1;
        w0.x = pk2(vv[0], vv[1]); w0.y = pk2(vv[2], vv[3]); w0.z = pk2(vv[4], vv[5]); w0.w = pk2(vv[6], vv[7]);
        w1.x = pk2(vv[8], vv[9]); w1.y = pk2(vv[10], vv[11]); w1.z = pk2(vv[12], vv[13]); w1.w = pk2(vv[14], vv[15]);
        *(LAS u32x4*)(Vt + k * HG_STR + sg * 32) = w0; *(LAS u32x4*)(Vt + k * HG_STR + sg * 32 + 16) = w1;
    }
    __syncthreads();
    const int vt = wave >> 1, kt0 = (wave & 1) * 2, r = lane & 31, hh = lane >> 5;
    f32x16 acc0 = {}, acc1 = {};
#pragma unroll
    for (int st = 0; st < 4; ++st) {
        const bf16x8 af = *(const LAS bf16x8*)(Vt + (32 * vt + r) * HG_STR + (16 * st + 8 * hh) * 2);
        const bf16x8 b0 = *(const LAS bf16x8*)(Kt + (32 * kt0 + r) * HG_STR + (16 * st + 8 * hh) * 2);
        const bf16x8 b1 = *(const LAS bf16x8*)(Kt + (32 * (kt0 + 1) + r) * HG_STR + (16 * st + 8 * hh) * 2);
        acc0 = __builtin_amdgcn_mfma_f32_32x32x16_bf16(af, b0, acc0, 0, 0, 0);
        acc1 = __builtin_amdgcn_mfma_f32_32x32x16_bf16(af, b1, acc1, 0, 0, 0);
    }
    bf16_t* sb = SB + (size_t)unit * 16384;
#pragma unroll
    for (int rg = 0; rg < 16; ++rg) {
        const int v = 32 * vt + crow(rg, hh);
        sb[v * 128 + 32 * kt0 + r] = (bf16_t)f2bf(acc0[rg]);
        sb[v * 128 + 32 * (kt0 + 1) + r] = (bf16_t)f2bf(acc1[rg]);
    }
    __syncthreads();
}

__device__ __forceinline__ void hgrn_scan(bf16_t* SB, const float* DEC, int gtid, int nthr) {
    for (int item = gtid; item < 32 * 128 * 32; item += nthr) {
        const int kq = item & 31, v = (item >> 5) & 127, bh = item >> 12;
        f32x4 st = (f32x4){0.f, 0.f, 0.f, 0.f};
        u32x2* p = (u32x2*)(SB + ((size_t)bh * 64 * 128 + v) * 128 + kq * 4);
        const f32x4* dp = (const f32x4*)(DEC + (size_t)bh * 64 * 128 + kq * 4);
#pragma unroll 8
        for (int c = 0; c < 64; ++c) {
            const u32x2 d = p[(size_t)c * 16384 / 4]; const f32x4 dc = dp[c * 32];
            u32x2 o; o.x = cvt_pk_bf16(st[0], st[1]); o.y = cvt_pk_bf16(st[2], st[3]);
            p[(size_t)c * 16384 / 4] = o;
            st[0] = dc[0] * st[0] + bflo(d.x); st[1] = dc[1] * st[1] + bfhi(d.x); st[2] = dc[2] * st[2] + bflo(d.y); st[3] = dc[3] * st[3] + bfhi(d.y);
        }
    }
}

constexpr int H3_BSTR = 528, H3_QSTR = 272, H3_B_OFF = 0, H3_Q_OFF = 64 * H3_BSTR, H3_K_OFF = H3_Q_OFF + 64 * H3_QSTR, H3_V_OFF = H3_K_OFF + 64 * H3_QSTR, H3_T_OFF = H3_V_OFF + 128 * HG_STR, H3_O_OFF = H3_T_OFF + 2048;
__device__ __forceinline__ void hgrn_h3_unit(LAS unsigned char* lds, bf16_t* QH, const bf16_t* KIN, const float* G, const bf16_t* HI, const bf16_t* HG, const bf16_t* SB, int unit, int tid, int lane, int wave) {
    const int c = unit & 63, bh = unit >> 6, b = bh >> 3, h = bh & 7;
    const size_t row0 = (size_t)b * SEQ + c * 64;
    LAS unsigned char* Bl = lds + H3_B_OFF;
    LAS unsigned char* Qs = lds + H3_Q_OFF;
    LAS unsigned char* Ks = lds + H3_K_OFF;
    LAS unsigned char* Vt = lds + H3_V_OFF;
    LAS float* tot = (LAS float*)(lds + H3_T_OFF);
    LAS float* osq = (LAS float*)(lds + H3_O_OFF);
    {
        const int k = tid & 127, sg = tid >> 7;
        float bl[16]; float run = 0.f;
#pragma unroll
        for (int i = 0; i < 16; ++i) { run += G[(row0 + sg * 16 + i) * 1024 + h * 128 + k]; bl[i] = run; }
        tot[sg * 128 + k] = run;
        float vv[16];
#pragma unroll
        for (int i = 0; i < 16; ++i) vv[i] = bf2f(HI[(row0 + sg * 16 + i) * 1024 + h * 128 + k]);
        u32x4 w0, w1;
        w0.x = pk2(vv[0], vv[1]); w0.y = pk2(vv[2], vv[3]); w0.z = pk2(vv[4], vv[5]); w0.w = pk2(vv[6], vv[7]);
        w1.x = pk2(vv[8], vv[9]); w1.y = pk2(vv[10], vv[11]); w1.z = pk2(vv[12], vv[13]); w1.w = pk2(vv[14], vv[15]);
        *(LAS u32x4*)(Vt + k * HG_STR + sg * 32) = w0; *(LAS u32x4*)(Vt + k * HG_STR + sg * 32 + 16) = w1;
#pragma unroll
        for (int i = 0; i < 2; ++i) {
            const int idx = tid + 512 * i, rr = idx >> 4, ch = idx & 15;
            *(LAS u32x4*)(Qs + rr * H3_QSTR + ch * 16) = *(const u32x4*)(QH + (row0 + rr) * 2048 + 1024 + h * 128 + ch * 8);
            *(LAS u32x4*)(Ks + rr * H3_QSTR + ch * 16) = *(const u32x4*)(KIN + (row0 + rr) * 1024 + h * 128 + ch * 8);
        }
        __syncthreads();
        const float t0 = tot[k], t1 = tot[128 + k], t2 = tot[256 + k];
        const float off = (sg > 0 ? t0 : 0.f) + (sg > 1 ? t1 : 0.f) + (sg > 2 ? t2 : 0.f);
#pragma unroll
        for (int i = 0; i < 16; ++i) *(LAS float*)(Bl + (sg * 16 + i) * H3_BSTR + k * 4) = bl[i] + off;
        __syncthreads();
    }
    const int i4 = wave & 3, vh = wave >> 2, fr = lane & 15, hh = lane >> 4;
    const int tq = 16 * i4 + fr;
    bf16x8 qhat[4], qtil[4];
#pragma unroll
    for (int ks = 0; ks < 4; ++ks) {
        const int k0 = 32 * ks + 8 * hh;
        const u32x4 qw = *(const LAS u32x4*)(Qs + tq * H3_QSTR + k0 * 2);
        const f32x4 b0 = *(const LAS f32x4*)(Bl + tq * H3_BSTR + k0 * 4), b1 = *(const LAS f32x4*)(Bl + tq * H3_BSTR + k0 * 4 + 16);
        f32x4 r0 = (f32x4){0.f, 0.f, 0.f, 0.f}, r1 = r0;
        if (i4 > 0) { r0 = *(const LAS f32x4*)(Bl + (16 * i4 - 1) * H3_BSTR + k0 * 4); r1 = *(const LAS f32x4*)(Bl + (16 * i4 - 1) * H3_BSTR + k0 * 4 + 16); }
        const float q[8] = {bflo(qw.x), bfhi(qw.x), bflo(qw.y), bfhi(qw.y), bflo(qw.z), bfhi(qw.z), bflo(qw.w), bfhi(qw.w)};
        const float bb[8] = {b0[0], b0[1], b0[2], b0[3], b1[0], b1[1], b1[2], b1[3]};
        const float rf[8] = {r0[0], r0[1], r0[2], r0[3], r1[0], r1[1], r1[2], r1[3]};
        float a[8], t8[8];
#pragma unroll
        for (int e = 0; e < 8; ++e) { a[e] = q[e] * __expf(bb[e] - rf[e]); t8[e] = q[e] * __expf(bb[e]); }
        qhat[ks] = pack8(a[0], a[1], a[2], a[3], a[4], a[5], a[6], a[7]);
        qtil[ks] = pack8(t8[0], t8[1], t8[2], t8[3], t8[4], t8[5], t8[6], t8[7]);
    }
    f32x4 at[4];
#pragma unroll
    for (int j = 0; j < 4; ++j) {
        at[j] = (f32x4){0.f, 0.f, 0.f, 0.f};
        if (j <= i4) {
            const int sr = 16 * j + fr;
#pragma unroll
            for (int ks = 0; ks < 4; ++ks) {
                const int k0 = 32 * ks + 8 * hh;
                const u32x4 kw = *(const LAS u32x4*)(Ks + sr * H3_QSTR + k0 * 2);
                const f32x4 b0 = *(const LAS f32x4*)(Bl + sr * H3_BSTR + k0 * 4), b1 = *(const LAS f32x4*)(Bl + sr * H3_BSTR + k0 * 4 + 16);
                f32x4 r0 = (f32x4){0.f, 0.f, 0.f, 0.f}, r1 = r0;
                if (i4 > 0) { r0 = *(const LAS f32x4*)(Bl + (16 * i4 - 1) * H3_BSTR + k0 * 4); r1 = *(const LAS f32x4*)(Bl + (16 * i4 - 1) * H3_BSTR + k0 * 4 + 16); }
                const float kk[8] = {bflo(kw.x), bfhi(kw.x), bflo(kw.y), bfhi(kw.y), bflo(kw.z), bfhi(kw.z), bflo(kw.w), bfhi(kw.w)};
                const float bb[8] = {b0[0], b0[1], b0[2], b0[3], b1[0], b1[1], b1[2], b1[3]};
                const float rf[8] = {r0[0], r0[1], r0[2], r0[3], r1[0], r1[1], r1[2], r1[3]};
                float a[8];
#pragma unroll
                for (int e = 0; e < 8; ++e) a[e] = kk[e] * __expf(fminf(rf[e] - bb[e], 80.f));
                const bf16x8 kf = pack8(a[0], a[1], a[2], a[3], a[4], a[5], a[6], a[7]);
                at[j] = __builtin_amdgcn_mfma_f32_16x16x32_bf16(kf, qhat[ks], at[j], 0, 0, 0);
            }
            if (j == i4) {
#pragma unroll
                for (int rg = 0; rg < 4; ++rg) if (4 * hh + rg > fr) at[j][rg] = 0.f;
            }
        }
    }
    f32x4 o[4];
#pragma unroll
    for (int vt = 0; vt < 4; ++vt) o[vt] = (f32x4){0.f, 0.f, 0.f, 0.f};
#pragma unroll
    for (int p = 0; p < 2; ++p) {
        if (2 * p <= i4) {
            const bf16x8 pf = pack8(at[2 * p][0], at[2 * p][1], at[2 * p][2], at[2 * p][3], at[2 * p + 1][0], at[2 * p + 1][1], at[2 * p + 1][2], at[2 * p + 1][3]);
#pragma unroll
            for (int vt = 0; vt < 4; ++vt) {
                const LAS unsigned char* vrow = Vt + (64 * vh + 16 * vt + fr) * HG_STR;
                const u32x2 lo = *(const LAS u32x2*)(vrow + (32 * p + 4 * hh) * 2), hi2 = *(const LAS u32x2*)(vrow + (32 * p + 16 + 4 * hh) * 2);
                u32x4 w; w.x = lo.x; w.y = lo.y; w.z = hi2.x; w.w = hi2.y;
                o[vt] = __builtin_amdgcn_mfma_f32_16x16x32_bf16(__builtin_bit_cast(bf16x8, w), pf, o[vt], 0, 0, 0);
            }
        }
    }
    {
        const bf16_t* sb = SB + (size_t)unit * 16384;
#pragma unroll
        for (int vt = 0; vt < 4; ++vt)
#pragma unroll
            for (int ks = 0; ks < 4; ++ks) {
                const bf16x8 sf = *(const bf16x8*)(sb + (64 * vh + 16 * vt + fr) * 128 + 32 * ks + 8 * hh);
                o[vt] = __builtin_amdgcn_mfma_f32_16x16x32_bf16(sf, qtil[ks], o[vt], 0, 0, 0);
            }
    }
    float ss = 0.f;
#pragma unroll
    for (int vt = 0; vt < 4; ++vt) ss += (o[vt][0] * o[vt][0] + o[vt][1] * o[vt][1]) + (o[vt][2] * o[vt][2] + o[vt][3] * o[vt][3]);
    ss += shx(ss, lane, 16); ss += shx(ss, lane, 32);
    if (hh == 0) osq[vh * 64 + tq] = ss;
    __syncthreads();
    const float rn = rsqrtf((osq[tq] + osq[64 + tq]) * (1.0f / 128.0f) + EPS);
#pragma unroll
    for (int vt = 0; vt < 4; ++vt) {
        const int v = 64 * vh + 16 * vt + 4 * hh;
        const u32x2 gw = *(const u32x2*)(HG + (row0 + tq) * 1024 + h * 128 + v);
        u32x2 w; w.x = cvt_pk_bf16(o[vt][0] * rn * bflo(gw.x), o[vt][1] * rn * bfhi(gw.x)); w.y = cvt_pk_bf16(o[vt][2] * rn * bflo(gw.y), o[vt][3] * rn * bfhi(gw.y));
        *(u32x2*)(QH + (row0 + tq) * 2048 + 1024 + h * 128 + v) = w;
    }
    __syncthreads();
}


#define XB_TMO      128
#define XB_XCNT(j)  (256  + 64 * (j))
#define XB_XSUB(j)  (1280 + 64 * (j))
#define XB_XGEN(j)  (2304 + 64 * (j))
#define XB_TOP      3328
#define XB_TOPGEN   3392
#define XCD_BAR_WORDS 3456
#define XB_SPIN_CAP (1u << 22)
__device__ __forceinline__ unsigned xb_ld(unsigned* p)              { return __hip_atomic_load(p, __ATOMIC_RELAXED, __HIP_MEMORY_SCOPE_AGENT); }
__device__ __forceinline__ unsigned xb_add(unsigned* p, unsigned v) { return __hip_atomic_fetch_add(p, v, __ATOMIC_RELAXED, __HIP_MEMORY_SCOPE_AGENT); }
__device__ __forceinline__ unsigned xb_xcc_id() { return (unsigned)__builtin_amdgcn_s_getreg((3 << 11) | 20) & 0xFu; }
#define XB_SPIN(cond, bar) do { unsigned _sp = 0; while (cond) { __builtin_amdgcn_s_sleep(1); \
    if ((++_sp & 255u) == 0u) { if (xb_ld(&(bar)[XB_TMO])) break; if (_sp > XB_SPIN_CAP) { atomicAdd(&(bar)[XB_TMO], 1u); break; } } } } while (0)
struct XcdBarrier { unsigned* bar; unsigned x; volatile LAS unsigned* st; };
__device__ __forceinline__ XcdBarrier xcd_barrier_post(unsigned* bar, volatile LAS unsigned* st) {
    XcdBarrier b; b.bar = bar; b.x = xb_xcc_id(); b.st = st;
    if (threadIdx.x == 0) (void)xb_add(&bar[XB_XCNT(b.x)], 1u);
    return b;
}
__device__ __forceinline__ void xcd_barrier_complete(unsigned* bar, unsigned x, unsigned& nloc, unsigned& nx) {
    const unsigned G = gridDim.x * gridDim.y * gridDim.z;
    unsigned sum, cnt, mine, sp = 0u;
    for (;;) {
        sum = 0u; cnt = 0u; mine = 0u;
#pragma unroll
        for (unsigned j = 0; j < 16; ++j) { const unsigned c = xb_ld(&bar[XB_XCNT(j)]); sum += c; cnt += (c > 0u) ? 1u : 0u; mine = (j == x) ? c : mine; }
        if (sum == G) break;
        __builtin_amdgcn_s_sleep(1);
        if ((++sp & 255u) == 0u) { if (xb_ld(&bar[XB_TMO])) break; if (sp > XB_SPIN_CAP) { atomicAdd(&bar[XB_TMO], 1u); break; } }
    }
    nloc = mine > 0u ? mine : 1u; nx = cnt > 0u ? cnt : 1u;
}
__device__ __forceinline__ void xcd_barrier(const XcdBarrier& b) {
    asm volatile("s_waitcnt vmcnt(0)" ::: "memory");
    __syncthreads();
    if (threadIdx.x == 0) {
        unsigned* bar = b.bar;
        __builtin_amdgcn_s_waitcnt(0);
        unsigned nloc = b.st[0], nx = b.st[1];
        if (nloc == 0u) { xcd_barrier_complete(bar, b.x, nloc, nx); b.st[0] = nloc; b.st[1] = nx; }
        const unsigned old = xb_add(&bar[XB_XSUB(b.x)], 1u);
        const unsigned gen = old / nloc;
        if (old + 1u == (gen + 1u) * nloc) {
            __builtin_amdgcn_fence(__ATOMIC_RELEASE, "agent");
            asm volatile("s_waitcnt vmcnt(0)" ::: "memory");
            const unsigned og = xb_add(&bar[XB_TOP], 1u);
            const unsigned tg = og / nx;
            if (og + 1u == (tg + 1u) * nx) xb_add(&bar[XB_TOPGEN], 1u);
            else XB_SPIN(xb_ld(&bar[XB_TOPGEN]) == tg, bar);
            __builtin_amdgcn_fence(__ATOMIC_ACQUIRE, "agent");
            xb_add(&bar[XB_XGEN(b.x)], 1u);
            asm volatile("s_waitcnt vmcnt(0)" ::: "memory");
        } else {
            XB_SPIN(xb_ld(&bar[XB_XGEN(b.x)]) == gen, bar);
            __builtin_amdgcn_fence(__ATOMIC_ACQUIRE, "agent");
            asm volatile("s_waitcnt vmcnt(0)" ::: "memory");
        }
    }
    __syncthreads();
}

__global__ void __launch_bounds__(NTHR, 2) fwd_megakernel(Args args) {
    extern __shared__ __attribute__((aligned(16))) unsigned char lds_raw[];
    LAS unsigned char* lds = (LAS unsigned char*)lds_raw;
    cg::grid_group grid = cg::this_grid();
    const int G = gridDim.x, bx = blockIdx.x, ngw = G * NWAVES, nthr = G * NTHR;
    const int wave = __builtin_amdgcn_readfirstlane((int)threadIdx.x >> 6);
#define PHASE_IDS() int lane_; asm volatile("v_mbcnt_lo_u32_b32 %0, -1, 0\n\tv_mbcnt_hi_u32_b32 %0, -1, %0" : "=v"(lane_)); const int lane = lane_, tid = wave * 64 + lane, gw = bx * NWAVES + wave, gtid = bx * NTHR + tid; (void)gw; (void)gtid
    unsigned char* ws = args.ws;
    const float* x_in = (const float*)args.in[0]; const float* p_in = (const float*)args.in[1]; const int* pos = (const int*)args.in[2];
    const float* w_in = (const float*)args.in[3]; const float* sinks = (const float*)args.in[4]; const float* lb_logits = (const float*)args.in[5];
    const float* attn_gain = (const float*)args.in[6]; const float* hgrn_gain = (const float*)args.in[7]; const float* w_out = (const float*)args.in[8];
    const float* pre_mix = (const float*)args.in[9]; const float* post_mix = (const float*)args.in[10]; const float* pre_ffn = (const float*)args.in[11]; const float* post_ffn = (const float*)args.in[12];
    const float* w_gate = (const float*)args.in[13]; const float* w_up = (const float*)args.in[14]; const float* w_down = (const float*)args.in[15];
    const float* ple_gain = (const float*)args.in[16]; const float* w_pg = (const float*)args.in[17]; const float* w_pp = (const float*)args.in[18];
    float* out = args.out;
    float* stat = (float*)(ws + WS_STAT); float* lbt = (float*)(ws + WS_LBT); float* cs = (float*)(ws + WS_CS);
    bf16_t* PBF = (bf16_t*)(ws + WS_PBF); bf16_t* HA = (bf16_t*)(ws + WS_HA); float* tmpO = (float*)(ws + WS_HA);
    bf16_t* QH = (bf16_t*)(ws + WS_QH); bf16_t* Kb = (bf16_t*)(ws + WS_K); bf16_t* Vb = (bf16_t*)(ws + WS_V); float* Gb = (float*)(ws + WS_G);
    bf16_t* KIN = (bf16_t*)(ws + WS_KIN); bf16_t* HI = (bf16_t*)(ws + WS_HI); bf16_t* HG = (bf16_t*)(ws + WS_HG);
    bf16_t* SBuf = (bf16_t*)(ws + WS_HA); float* DEC = (float*)(ws + WS_DEC);
    bf16_t* Mb = (bf16_t*)(ws + WS_M); bf16_t* ACT = (bf16_t*)(ws + WS_ACT); bf16_t* Fb = (bf16_t*)(ws + WS_F); bf16_t* PP = (bf16_t*)(ws + WS_PP);

    volatile LAS unsigned* xst = (volatile LAS unsigned*)(lds + 131072 + 64);
    unsigned* barw = (unsigned*)(ws + WS_BAR);
    if (threadIdx.x < 2) xst[threadIdx.x] = 0u;
    if (bx == 0) for (int i = threadIdx.x; i < 3456; i += NTHR) barw[i] = 0u;
    __syncthreads();
    {
        PHASE_IDS();
        LAS float* scr = (LAS float*)(lds + wave * 16384);
        constexpr int I_IN = 32 * 176, I_OUT = 32 * 64, I_G = 32 * 176, I_D = 88 * 64, I_PG = 32 * 64, I_PP = 4 * 64;
        constexpr int I_L = I_IN + I_OUT + 2 * I_G + I_D + I_PG + I_PP;
        for (int it = gw; it < DEPTH * I_L; it += ngw) {
            const int l = it / I_L; int r = it % I_L;
            unsigned char* wl = ws + WS_W + (size_t)l * WL_SIZE;
            if (r < I_IN) {
                const int kb = r / 176, nb = r % 176, n0 = nb * 32, pn = n0 >> 8; int prow0 = n0;
                if (pn <= 4) { const int lc = n0 & 255; prow0 = (pn << 8) + 128 * ((lc >> 5) & 1) + 32 * ((lc >> 6) & 3); }
                tr_item(w_in + (size_t)l * DM * DIN, DIN, DM, kb * 64, n0, (bf16_t*)(wl + WL_IN), prow0, pre_mix + l * DM, scr, lane); continue; }
            r -= I_IN;
            if (r < I_OUT) {
                const int kb = r / 64, nb = r % 64; const int k0 = kb * 64;
                const float* gp = (k0 < 1024) ? (attn_gain + l * 1024) : (hgrn_gain + l * 1024 - 1024);
                tr_item(w_out + (size_t)l * DM * DM, DM, DM, k0, nb * 32, (bf16_t*)(wl + WL_OUT), nb * 32, gp, scr, lane); continue; }
            r -= I_OUT;
            if (r < 2 * I_G) {
                const int up = r >= I_G; if (up) r -= I_G;
                const int kb = r / 176, nb = r % 176, n0 = nb * 32; const int prow0 = 256 * (n0 >> 7) + (n0 & 127) + (up ? 128 : 0);
                tr_item((up ? w_up : w_gate) + (size_t)l * DM * DFF, DFF, DM, kb * 64, n0, (bf16_t*)(wl + WL_GU), prow0, pre_ffn + l * DM, scr, lane); continue; }
            r -= 2 * I_G;
            if (r < I_D) { const int kb = r / 64, nb = r % 64;
                tr_item(w_down + (size_t)l * DFF * DM, DM, DFF, kb * 64, nb * 32, (bf16_t*)(wl + WL_DOWN), nb * 32, nullptr, scr, lane); continue; }
            r -= I_D;
            if (r < I_PG) { const int kb = r / 64, nb = r % 64;
                tr_item(w_pg + (size_t)l * DM * DM, DM, DM, kb * 64, nb * 32, (bf16_t*)(wl + WL_PG), nb * 32, ple_gain + l * DM, scr, lane); continue; }
            r -= I_PG;
            { const int kb = r / 64, nb = r % 64;
                tr_item(w_pp + (size_t)l * DPLE * DM, DM, DPLE, kb * 64, nb * 32, (bf16_t*)(wl + WL_PP), nb * 32, nullptr, scr, lane); }
        }
        for (int i = gtid; i < 11 * T; i += nthr) stat[T + i] = 0.f;
        for (int i = gtid; i < 1024; i += nthr) {
            const float l0 = lb_logits[i], l1 = lb_logits[1024 + i];
            lbt[i] = 0.f; lbt[1024 + i] = 1.0f / (1.0f + expf(l0 - l1));
        }
        for (int i = gtid; i < T * 32; i += nthr) {
            const int row = i >> 5, d = i & 31;
            const double rev = (double)pos[row] * c_invf[d] * 0.15915494309189535;
            const float fr = (float)(rev - rint(rev));
            cs[(size_t)row * 64 + d] = __builtin_amdgcn_cosf(fr); cs[(size_t)row * 64 + 32 + d] = __builtin_amdgcn_sinf(fr);
        }
        for (int i = gtid; i < DEPTH * T * DPLE / 8; i += nthr) {
            const f32x4 a = *(const f32x4*)(p_in + (size_t)i * 8), b = *(const f32x4*)(p_in + (size_t)i * 8 + 4);
            u32x4 w; w.x = pk2(a[0], a[1]); w.y = pk2(a[2], a[3]); w.z = pk2(b[0], b[1]); w.w = pk2(b[2], b[3]);
            *(u32x4*)(PBF + (size_t)i * 8) = w;
        }
    }
    { PHASE_IDS();
    for (int row = gw; row < T; row += ngw) {
        float ss = 0.f;
#pragma unroll
        for (int j = 0; j < 4; ++j) {
            const int c = j * 512 + lane * 8; const size_t off = (size_t)row * 2048 + c;
            const f32x4 x0 = *(const f32x4*)(x_in + off), x1 = *(const f32x4*)(x_in + off + 4);
            u32x4 w; w.x = pk2(x0[0], x0[1]); w.y = pk2(x0[2], x0[3]); w.z = pk2(x1[0], x1[1]); w.w = pk2(x1[2], x1[3]);
            *(u32x4*)(HA + off) = w;
            ss += (x0[0] * x0[0] + x0[1] * x0[1]) + (x0[2] * x0[2] + x0[3] * x0[3]) + (x1[0] * x1[0] + x1[1] * x1[1]) + (x1[2] * x1[2] + x1[3] * x1[3]);
        }
        ss = wave_sum(ss, lane);
        if (lane == 0) stat[(SQ_X + 0) * T + row] = ss;
    } }
    grid.sync();
    const XcdBarrier xbar = xcd_barrier_post(barw, xst);
#define GSYNC() xcd_barrier(xbar)

    for (int l = 0; l < DEPTH; ++l) {
        unsigned char* wl = ws + WS_W + (size_t)l * WL_SIZE;
        float* ssqX = stat + (SQ_X + l) * T; float* ssqA = stat + (SQ_A + l) * T; float* ssqM = stat + (SQ_M + l) * T;
        float* ssq2 = stat + (SQ_2 + l) * T; float* ssqF = stat + (SQ_F + l) * T; float* ssq3 = stat + (SQ_3 + l) * T;
        {
            PHASE_IDS(); pg8::Gemm g{l == 0 ? HA : (const bf16_t*)(ws + WS_W + (size_t)(l - 1) * WL_SIZE), (const bf16_t*)(wl + WL_IN), T, DIN, DM}; pg8::StaticOrder S; S.init(T, DIN, G, bx);
            EpiIn E{0, ssqX, cs, lbt + l * 1024, QH, Kb, Vb, Gb, KIN, HI, HG};
            if (PH & 1) pg8::gemm_phase<EpiIn, pg8::StaticOrder, true, true>(lds, g, S, E, tid);
        }
        GSYNC();
#if !NAIVE_MIX
        { PHASE_IDS();
          for (int u = bx; u < 512; u += G) attn_unit(lds, QH, Kb, Vb, sinks + l * 16, ssqA, u, tid, lane, wave);
          for (int u = bx; u < 2048; u += G) hgrn_h1_unit(lds, KIN, Gb, HI, SBuf, DEC, u, tid, lane, wave); }
        GSYNC();
        { PHASE_IDS(); hgrn_scan(SBuf, DEC, gtid, nthr); }
        GSYNC();
        { PHASE_IDS();
          for (int u = bx; u < 2048; u += G) hgrn_h3_unit(lds, QH, KIN, Gb, HI, HG, SBuf, u, tid, lane, wave); }
        GSYNC();
#else
        { PHASE_IDS();
        if (bx < 64 && wave == 0) hgrn_naive(QH, KIN, Gb, HI, tmpO, bx, lane);
        attn_naive(QH, Kb, Vb, sinks + l * 16, ssqA, gtid, nthr); }
        GSYNC();
        { PHASE_IDS(); hgrn_norm_naive(tmpO, HG, QH, gw, ngw, lane); }
        GSYNC();
#endif
        {
            PHASE_IDS(); pg8::Gemm g{QH, (const bf16_t*)(wl + WL_OUT), T, DM, DM}; pg8::StaticOrder S; S.init(T, DM, G, bx);
            EpiRowSsq<true> E{16, Mb, ssqM, ssqA};
            if (PH & 2) pg8::gemm_phase<EpiRowSsq<true>, pg8::StaticOrder, true, true>(lds, g, S, E, tid);
        }
        GSYNC();
        { PHASE_IDS(); row_phase(l == 0 ? x_in : out, out, Mb, ssqM, post_mix + l * DM, HA, ssq2, gw, ngw, lane); }
        GSYNC();
        {
            PHASE_IDS(); pg8::Gemm g{HA, (const bf16_t*)(wl + WL_GU), T, 2 * DFF, DM}; pg8::StaticOrder S; S.init(T, 2 * DFF, G, bx);
            EpiGU E{0, ssq2, ACT};
            if (PH & 4) pg8::gemm_phase<EpiGU, pg8::StaticOrder, true, true>(lds, g, S, E, tid);
        }
        GSYNC();
        {
            PHASE_IDS(); pg8::Gemm g{ACT, (const bf16_t*)(wl + WL_DOWN), T, DM, DFF}; pg8::StaticOrder S; S.init(T, DM, G, bx);
            EpiRowSsq<false> E{0, Fb, ssqF, nullptr};
            if (PH & 8) pg8::gemm_phase<EpiRowSsq<false>, pg8::StaticOrder, true, true>(lds, g, S, E, tid);
        }
        GSYNC();
        { PHASE_IDS(); row_phase(out, out, Fb, ssqF, post_ffn + l * DM, HA, ssq3, gw, ngw, lane); }
        GSYNC();
        {
            PHASE_IDS(); int kpp = DPLE; asm volatile("" : "+s"(kpp)); pg8::Gemm g{PBF + (size_t)l * T * DPLE, (const bf16_t*)(wl + WL_PP), T, DM, kpp}; pg8::StaticOrder S; S.init(T, DM, G, bx);
            EpiPlain E{0, PP};
            if (PH & 16) pg8::gemm_phase<EpiPlain, pg8::StaticOrder, true, true>(lds, g, S, E, tid);
        }
        {
            PHASE_IDS(); pg8::Gemm g{HA, (const bf16_t*)(wl + WL_PG), T, DM, DM}; pg8::StaticOrder S; S.init(T, DM, G, bx);
            EpiPle E{0, ssq3, PP, out, (bf16_t*)wl, stat + (SQ_X + (l + 1 < DEPTH ? l + 1 : 0)) * T, l + 1 < DEPTH ? 1 : 0};
            if (PH & 32) pg8::gemm_phase<EpiPle, pg8::StaticOrder, true, true>(lds, g, S, E, tid);
        }
        if (l + 1 < DEPTH) GSYNC();
    }
}

extern "C" void kernel_launch(void* const* d_in, const int* in_sizes, int n_in, void* d_out, int out_size, void* d_ws, size_t ws_size, hipStream_t stream) {
    static int grid = 0;
    if (grid == 0) {
        if (n_in != 19 || out_size != T * DM || ws_size < WS_END) { fprintf(stderr, "kernel_launch: unexpected shapes (n_in %d out %d ws %zu need %zu)\n", n_in, out_size, ws_size, (size_t)WS_END); grid = -1; return; }
        int dev = 0, cus = 0, per_cu = 0;
        hipGetDevice(&dev);
        hipDeviceGetAttribute(&cus, hipDeviceAttributeMultiprocessorCount, dev);
        if (hipFuncSetAttribute((const void*)fwd_megakernel, hipFuncAttributeMaxDynamicSharedMemorySize, LDS_BYTES) != hipSuccess) { fprintf(stderr, "kernel_launch: hipFuncSetAttribute failed\n"); grid = -1; return; }
        if (hipOccupancyMaxActiveBlocksPerMultiprocessor(&per_cu, (const void*)fwd_megakernel, NTHR, LDS_BYTES) != hipSuccess || per_cu < 1) { fprintf(stderr, "kernel_launch: occupancy query gave %d\n", per_cu); per_cu = 1; }
        (void)hipGetLastError();
        grid = cus * per_cu;
    }
    if (grid < 0) return;
    Args a{};
    for (int i = 0; i < 19; ++i) a.in[i] = d_in[i];
    a.out = (float*)d_out; a.ws = (unsigned char*)d_ws;
    void* kargs[] = {&a};
    hipError_t e = hipLaunchCooperativeKernel((const void*)fwd_megakernel, dim3(grid), dim3(NTHR), kargs, LDS_BYTES, stream);
    if (e != hipSuccess) fprintf(stderr, "cooperative launch failed: %s (grid %d)\n", hipGetErrorString(e), grid);
}
```

```cpp
#include <hip/hip_runtime.h>
#include <hip/hip_cooperative_groups.h>
#include <cstdio>
#include <cstdint>
namespace cg = cooperative_groups;

#ifndef PH
#define PH 63
#endif
#ifndef NAIVE_MIX
#define NAIVE_MIX 0
#endif

namespace pg8 {
#define PG8_LAS __attribute__((address_space(3)))
typedef unsigned short bf16_t;
typedef short bf16x8 __attribute__((ext_vector_type(8)));
typedef float f32x4 __attribute__((ext_vector_type(4)));
typedef unsigned u32x4 __attribute__((ext_vector_type(4)));
constexpr int BM = 256, BK = 64, HALF = 128, HTB = HALF * BK * 2, STAGE_BYTES = 8 * HTB, NXCD = 8, WGM = 8;

__host__ __device__ __forceinline__ int lds_byte(int r, int c) { const int st = (r >> 4) * 2 + (c >> 5), rr = r & 15, cc = c & 31, ob = rr * 64 + cc * 2; return st * 1024 + (ob ^ (((ob >> 9) & 1) << 5)); }
__host__ __device__ __forceinline__ void stage_rc(int b, int& R, int& C) { const int st = b / 1024, sb = b % 1024, swz = sb ^ (((sb >> 9) & 1) << 5); R = (st >> 1) * 16 + swz / 64; C = (st & 1) * 32 + (swz % 64) / 2; }
__host__ __device__ __forceinline__ int perm32(int rho) { const int n = rho >> 4, i = rho & 15; return 8 * (i >> 2) + 4 * n + (i & 3); }

struct Unit { int pm, pn; };
struct Gemm { const bf16_t* A; const bf16_t* Bt; int M, N, K; };

struct StaticOrder {
    int nM, nN, nwg, G, c;
    __host__ __device__ void init(int M, int N, int G_, int c_) { nM = M / BM; nN = N / BM; nwg = nM * nN; G = G_; c = c_; }
    __host__ __device__ bool next(int i, Unit& u) const {
        const long L = (long)i * G + c; if (L >= nwg) return false;
        int wgid = (int)L; { const int q = nwg / NXCD, r = nwg % NXCD, xcd = wgid % NXCD, off = wgid / NXCD; wgid = (xcd < r ? xcd * (q + 1) : r * (q + 1) + (xcd - r) * q) + off; }
        const int nig = WGM * nN, gid = wgid / nig, fm = gid * WGM, gsz = (nM - fm) < WGM ? (nM - fm) : WGM;
        u.pm = fm + ((wgid % nig) % gsz); u.pn = (wgid % nig) / gsz; return true;
    }
    __device__ __forceinline__ void a_ready(const Unit&) const {}
    __device__ __forceinline__ void done(const Unit&) const {}
};

__device__ __forceinline__ unsigned cvt_pk_bf16(float lo, float hi) { unsigned r; asm volatile("v_cvt_pk_bf16_f32 %0, %1, %2" : "=v"(r) : "v"(lo), "v"(hi)); return r; }

template <class Epi, class Sched, bool ALIGN_EPI = false, bool SP2 = false>
__device__ __forceinline__ void gemm_phase(PG8_LAS unsigned char* lds, const Gemm g, const Sched& S, const Epi& E, int tid_in) {
    int tid_ = tid_in; asm volatile("" : "+v"(tid_));
    const int tid = tid_, wid = __builtin_amdgcn_readfirstlane(tid >> 6), lane = tid & 63, wr = wid >> 2, wc = wid & 3, fr = lane & 15, fq = lane >> 4;
    const int K = g.K, nt = K / BK;
    unsigned voffA[2], voffB[2];
#pragma unroll
    for (int i = 0; i < 2; ++i) { int R, C; stage_rc(tid * 16 + i * 8192, R, C); const int Rb = Epi::PERM ? ((R & ~31) + perm32(R & 31)) : R;
        voffA[i] = (unsigned)(R * K + C) * 2u; voffB[i] = (unsigned)(Rb * K + C) * 2u; }
    const size_t kstep = (size_t)(BK * 2);
    const size_t hstep = (size_t)HALF * K * 2;
    const size_t tstep = 2 * hstep;
    const unsigned ldsw = (unsigned)wid * 1024u;
    const int aoff = lds_byte(wr * 64 + fr, fq * 8), boff = lds_byte(wc * 32 + fr, fq * 8);
#define PG8_SA(b, h) (((b) * 2 + (h)) * HTB)
#define PG8_SB(b, h) ((4 + (b) * 2 + (h)) * HTB)
#define PG8_STAGE(bufoff, gbase, voff) do { _Pragma("unroll") for (int _i = 0; _i < 2; ++_i) \
        __builtin_amdgcn_global_load_lds((const unsigned*)((const char*)(gbase) + (voff)[_i]), (PG8_LAS unsigned*)(lds + (bufoff) + ldsw + _i * 8192), 16, 0, 0); } while (0)
#define PG8_LDA(dst, b, h) do { _Pragma("unroll") for (int m = 0; m < 4; ++m) _Pragma("unroll") for (int k = 0; k < 2; ++k) dst[m][k] = *(const PG8_LAS bf16x8*)(lds + PG8_SA(b, h) + aoff + m * 2048 + k * 1024); } while (0)
#define PG8_LDB(dst, b, h) do { _Pragma("unroll") for (int n = 0; n < 2; ++n) _Pragma("unroll") for (int k = 0; k < 2; ++k) dst[n][k] = *(const PG8_LAS bf16x8*)(lds + PG8_SB(b, h) + boff + n * 2048 + k * 1024); } while (0)
#define PG8_MMA(ai, bj, At, Bt) do { __builtin_amdgcn_s_setprio(1); _Pragma("unroll") for (int m = 0; m < 4; ++m) _Pragma("unroll") for (int n = 0; n < 2; ++n) _Pragma("unroll") for (int k = 0; k < 2; ++k) \
        acc[ai][bj][m][n] = __builtin_amdgcn_mfma_f32_16x16x32_bf16(Bt[n][k], At[m][k], acc[ai][bj][m][n], 0, 0, 0); __builtin_amdgcn_s_setprio(0); } while (0)
#define PG8_WAIT_V(n) asm volatile("s_waitcnt vmcnt(" #n ")" ::: "memory")
#define PG8_WAIT_L(n) asm volatile("s_waitcnt lgkmcnt(" #n ")" ::: "memory")
#define PG8_BAR __builtin_amdgcn_s_barrier()
#define PG8_SCHED __builtin_amdgcn_sched_barrier(0)
    Unit cur, nxt; int ui = 0;
    if (!S.next(0, cur)) return;
    f32x4 acc[2][2][4][2];
#pragma unroll
    for (int a = 0; a < 2; ++a)
#pragma unroll
        for (int b = 0; b < 2; ++b)
#pragma unroll
            for (int m = 0; m < 4; ++m)
#pragma unroll
                for (int n = 0; n < 2; ++n) acc[a][b][m][n] = (f32x4){0.f, 0.f, 0.f, 0.f};
    bf16x8 At[4][2], B0[2][2], B1[2][2];
    const char* cA = (const char*)g.A + (size_t)cur.pm * tstep; const char* cB = (const char*)g.Bt + (size_t)cur.pn * tstep;
    S.a_ready(cur);
    if constexpr (SP2) {
        PG8_STAGE(PG8_SB(0, 0), cB, voffB); PG8_STAGE(PG8_SB(0, 1), cB + hstep, voffB); PG8_STAGE(PG8_SA(0, 0), cA, voffA); PG8_STAGE(PG8_SA(0, 1), cA + hstep, voffA);
        if (wr == 1) PG8_BAR;
        PG8_WAIT_V(2); PG8_BAR;
        PG8_STAGE(PG8_SB(1, 0), cB + kstep, voffB); PG8_STAGE(PG8_SA(1, 0), cA + kstep, voffA); PG8_STAGE(PG8_SB(1, 1), cB + hstep + kstep, voffB);
        PG8_WAIT_V(6); PG8_BAR;
    } else {
        PG8_STAGE(PG8_SB(0, 0), cB, voffB); PG8_STAGE(PG8_SA(0, 0), cA, voffA); PG8_STAGE(PG8_SB(0, 1), cB + hstep, voffB); PG8_STAGE(PG8_SA(0, 1), cA + hstep, voffA);
        if (wr == 1) PG8_BAR;
        PG8_WAIT_V(4); PG8_BAR;
        PG8_STAGE(PG8_SB(1, 0), cB + kstep, voffB); PG8_STAGE(PG8_SA(1, 0), cA + kstep, voffA); PG8_STAGE(PG8_SB(1, 1), cB + hstep + kstep, voffB);
        PG8_WAIT_V(6); PG8_BAR;
    }
    for (;;) {
        const bool has_next = S.next(ui + 1, nxt);
        const char* nA = has_next ? (const char*)g.A + (size_t)nxt.pm * tstep : cA; const char* nB = has_next ? (const char*)g.Bt + (size_t)nxt.pn * tstep : cB;
        for (int t = 0; t < nt; t += 2) {
            const bool last = (t == nt - 2);
            const char* a1 = cA + (size_t)(t + 1) * kstep;
            const char* a2 = last ? nA : cA + (size_t)(t + 2) * kstep; const char* b2 = last ? nB : cB + (size_t)(t + 2) * kstep;
            const char* a3 = a2 + kstep; const char* b3 = b2 + kstep;
            if (last && has_next) S.a_ready(nxt);
            if constexpr (Epi::MID) { if (t == E.kmid) { int l2 = lane; asm volatile("" : "+v"(l2)); E.mid(acc, cur, wr, wc, l2 & 15, l2 >> 4); } }
            if constexpr (SP2) {
            PG8_LDB(B0, 0, 0); PG8_LDB(B1, 0, 1); PG8_SCHED; PG8_LDA(At, 0, 0); PG8_STAGE(PG8_SA(1, 1), a1 + hstep, voffA);
            PG8_WAIT_V(8); PG8_WAIT_L(0); PG8_BAR; PG8_MMA(0, 0, At, B0); PG8_MMA(0, 1, At, B1); PG8_BAR; PG8_SCHED;
            PG8_LDA(At, 0, 1); PG8_STAGE(PG8_SB(0, 0), b2, voffB); PG8_STAGE(PG8_SB(0, 1), b2 + hstep, voffB); PG8_STAGE(PG8_SA(0, 0), a2, voffA);
            PG8_WAIT_V(8); PG8_WAIT_L(0); PG8_BAR; PG8_MMA(1, 0, At, B0); PG8_MMA(1, 1, At, B1); PG8_BAR; PG8_SCHED;
            PG8_LDB(B0, 1, 0); PG8_LDB(B1, 1, 1); PG8_SCHED; PG8_LDA(At, 1, 0); PG8_STAGE(PG8_SA(0, 1), a2 + hstep, voffA);
            PG8_WAIT_V(8); PG8_WAIT_L(0); PG8_BAR; PG8_MMA(0, 0, At, B0); PG8_MMA(0, 1, At, B1); PG8_BAR; PG8_SCHED;
            PG8_LDA(At, 1, 1); PG8_STAGE(PG8_SB(1, 0), b3, voffB); PG8_STAGE(PG8_SB(1, 1), b3 + hstep, voffB); PG8_STAGE(PG8_SA(1, 0), a3, voffA);
            PG8_WAIT_V(8); PG8_WAIT_L(0); PG8_BAR; PG8_MMA(1, 0, At, B0); PG8_MMA(1, 1, At, B1); PG8_BAR; PG8_SCHED;
            } else {
            PG8_LDB(B0, 0, 0); PG8_SCHED; PG8_LDA(At, 0, 0); PG8_STAGE(PG8_SA(1, 1), a1 + hstep, voffA);
            PG8_WAIT_L(8); PG8_BAR; PG8_WAIT_L(0); PG8_MMA(0, 0, At, B0); PG8_BAR; PG8_SCHED;
            PG8_LDB(B1, 0, 1); PG8_STAGE(PG8_SB(0, 0), b2, voffB);
            PG8_BAR; PG8_WAIT_L(0); PG8_MMA(0, 1, At, B1); PG8_BAR;
            PG8_LDA(At, 0, 1); PG8_STAGE(PG8_SA(0, 0), a2, voffA);
            PG8_BAR; PG8_WAIT_L(0); PG8_MMA(1, 0, At, B0); PG8_BAR; PG8_SCHED;
            PG8_STAGE(PG8_SB(0, 1), b2 + hstep, voffB);
            PG8_WAIT_V(6); PG8_BAR; PG8_MMA(1, 1, At, B1); PG8_BAR;
            PG8_LDB(B0, 1, 0); PG8_SCHED; PG8_LDA(At, 1, 0); PG8_STAGE(PG8_SA(0, 1), a2 + hstep, voffA);
            PG8_WAIT_L(8); PG8_BAR; PG8_WAIT_L(0); PG8_MMA(0, 0, At, B0); PG8_BAR; PG8_SCHED;
            PG8_LDB(B1, 1, 1); PG8_STAGE(PG8_SB(1, 0), b3, voffB);
            PG8_BAR; PG8_WAIT_L(0); PG8_MMA(0, 1, At, B1); PG8_BAR;
            PG8_LDA(At, 1, 1); PG8_STAGE(PG8_SA(1, 0), a3, voffA);
            PG8_BAR; PG8_WAIT_L(0); PG8_MMA(1, 0, At, B0); PG8_BAR; PG8_SCHED;
            PG8_STAGE(PG8_SB(1, 1), b3 + hstep, voffB);
            PG8_WAIT_V(6); PG8_BAR; PG8_MMA(1, 1, At, B1); PG8_BAR;
            }
        }
        if constexpr (ALIGN_EPI) { if (wr == 0) PG8_BAR; }
        { int l2 = lane; asm volatile("" : "+v"(l2)); E(acc, cur, wr, wc, l2 & 15, l2 >> 4); }
        if (!has_next) break;
#pragma unroll
        for (int a = 0; a < 2; ++a)
#pragma unroll
            for (int b = 0; b < 2; ++b)
#pragma unroll
                for (int m = 0; m < 4; ++m)
#pragma unroll
                    for (int n = 0; n < 2; ++n) acc[a][b][m][n] = (f32x4){0.f, 0.f, 0.f, 0.f};
        cur = nxt; cA = nA; cB = nB; ++ui;
        if constexpr (ALIGN_EPI) { if (wr == 1) PG8_BAR; }
    }
    PG8_WAIT_V(0);
    if constexpr (!ALIGN_EPI) { if (wr == 0) PG8_BAR; }
    PG8_BAR;
#undef PG8_SA
#undef PG8_SB
#undef PG8_STAGE
#undef PG8_LDA
#undef PG8_LDB
#undef PG8_MMA
#undef PG8_WAIT_V
#undef PG8_WAIT_L
#undef PG8_BAR
#undef PG8_SCHED
}
}

using pg8::bf16_t; using pg8::f32x4; using pg8::u32x4; using pg8::Unit; using pg8::cvt_pk_bf16;
#define LAS __attribute__((address_space(3)))
constexpr int NB = 4, SEQ = 4096, T = NB * SEQ, DM = 2048, DIN = 5632, DFF = 5632, DPLE = 256, DEPTH = 2;
constexpr float EPS = 1e-6f;
constexpr float LOG2E = 1.4426950408889634f;
constexpr float QSCALE = 0.125f * LOG2E;
constexpr int NWAVES = 8, NTHR = 512;
constexpr int LDS_BYTES = 147456;

constexpr size_t MiB = 1u << 20;
constexpr size_t WS_STAT = 0;
constexpr size_t WS_LBT = 1536 * 1024;
constexpr size_t WS_BAR = 1600 * 1024;
constexpr size_t WS_CS = 2 * MiB;
constexpr size_t WS_W = 6 * MiB;
constexpr size_t WL_IN = 0, WL_OUT = 22 * MiB, WL_GU = 30 * MiB, WL_DOWN = 74 * MiB, WL_PG = 96 * MiB, WL_PP = 104 * MiB, WL_SIZE = 105 * MiB;
constexpr size_t WS_PBF = 216 * MiB;
constexpr size_t WS_HA = 232 * MiB;
constexpr size_t WS_R = 296 * MiB;
constexpr size_t WS_QH = WS_R, WS_K = WS_R + 64 * MiB, WS_V = WS_R + 72 * MiB, WS_G = WS_R + 80 * MiB, WS_KIN = WS_R + 144 * MiB, WS_HI = WS_R + 176 * MiB, WS_HG = WS_R + 208 * MiB;
constexpr size_t WS_M = WS_G, WS_ACT = WS_R, WS_F = WS_R + 176 * MiB, WS_PP = WS_R;
constexpr size_t WS_DEC = WS_R + 240 * MiB;
constexpr size_t WS_END = WS_DEC + 1 * MiB;
enum { SQ_X = 0, SQ_A = 2, SQ_M = 4, SQ_2 = 6, SQ_F = 8, SQ_3 = 10 };

__constant__ double c_invf[32] = {1.0, 0.7498942093324559, 0.5623413251903491, 0.4216965034285822, 0.31622776601683794, 0.23713737056616552, 0.1778279410038923, 0.1333521432163324, 0.09999999999999999, 0.07498942093324558, 0.056234132519034905, 0.042169650342858224, 0.03162277660168379, 0.023713737056616554, 0.01778279410038923, 0.013335214321633239, 0.01, 0.007498942093324559, 0.005623413251903491, 0.004216965034285822, 0.0031622776601683794, 0.002371373705661655, 0.0017782794100389228, 0.0013335214321633238, 0.001, 0.0007498942093324559, 0.000562341325190349, 0.00042169650342858224, 0.00031622776601683794, 0.00023713737056616554, 0.0001778279410038923, 0.0001333521432163324};

__device__ __forceinline__ float bf2f(unsigned h) { return __uint_as_float(h << 16); }
__device__ __forceinline__ float bflo(unsigned w) { return __uint_as_float(w << 16); }
__device__ __forceinline__ float bfhi(unsigned w) { return __uint_as_float(w & 0xffff0000u); }
__device__ __forceinline__ unsigned f2bf(float f) { unsigned u = __float_as_uint(f); return (u + 0x7fffu + ((u >> 16) & 1u)) >> 16; }
__device__ __forceinline__ unsigned pk2(float lo, float hi) { return f2bf(lo) | (f2bf(hi) << 16); }
__device__ __forceinline__ float shx(float v, int lane, int m) { return __int_as_float(__builtin_amdgcn_ds_bpermute((lane ^ m) << 2, __float_as_int(v))); }
__device__ __forceinline__ float wave_sum(float v, int lane) {
#pragma unroll
    for (int o = 1; o < 64; o <<= 1) v += shx(v, lane, o);
    return v;
}
typedef unsigned long long u64;
__device__ __forceinline__ u64 fx_enc(float q) { return (u64)__float2ll_rn(q * 16777216.0f); }
__device__ __forceinline__ float fx_dec(u64 v) { return __ll2float_rn((long long)v) * (1.0f / 16777216.0f); }
__device__ __forceinline__ void fx_add(u64* p, float q) { atomicAdd(p, fx_enc(q)); }
__device__ __forceinline__ float sigmoidf_(float z) { return 1.0f / (1.0f + __expf(-z)); }
__device__ __forceinline__ float siluf_(float z) { return z / (1.0f + __expf(-z)); }

struct EpiIn {
    static constexpr bool PERM = true, MID = false;
    int kmid;
    const u64* ssqX; const float* cs; const float* lb;
    bf16_t* QH; bf16_t* Kb; bf16_t* Vb; float* G; bf16_t* KIN; bf16_t* HI; bf16_t* HG;
    __device__ __forceinline__ void mid(f32x4 (&acc)[2][2][4][2], const Unit& u, int wr, int wc, int fr, int fq) const {}
    __device__ __forceinline__ void operator()(const f32x4 (&acc)[2][2][4][2], const Unit& u, int wr, int wc, int fr, int fq) const {
        const int pn = u.pn;
#pragma unroll
        for (int ai = 0; ai < 2; ++ai)
#pragma unroll
            for (int m = 0; m < 4; ++m) {
                const int row = u.pm * 256 + ai * 128 + wr * 64 + m * 16 + fr;
                const float rs = rsqrtf(fx_dec(ssqX[row]) * (1.0f / DM) + EPS);
                if (pn <= 4) {
                    const int d0 = 8 * fq;
                    const f32x4 c0 = *(const f32x4*)(cs + (size_t)row * 64 + d0), c1 = *(const f32x4*)(cs + (size_t)row * 64 + d0 + 4);
                    const f32x4 s0 = *(const f32x4*)(cs + (size_t)row * 64 + 32 + d0), s1 = *(const f32x4*)(cs + (size_t)row * 64 + 32 + d0 + 4);
                    const float sc = (pn < 4) ? rs * QSCALE : rs;
                    const f32x4 a0 = acc[ai][0][m][0] * sc, a1 = acc[ai][0][m][1] * sc, b0 = acc[ai][1][m][0] * sc, b1 = acc[ai][1][m][1] * sc;
                    const f32x4 o10 = a0 * c0 - b0 * s0, o11 = a1 * c1 - b1 * s1, o20 = b0 * c0 + a0 * s0, o21 = b1 * c1 + a1 * s1;
                    u32x4 w1, w2;
                    w1.x = cvt_pk_bf16(o10[0], o10[1]); w1.y = cvt_pk_bf16(o10[2], o10[3]); w1.z = cvt_pk_bf16(o11[0], o11[1]); w1.w = cvt_pk_bf16(o11[2], o11[3]);
                    w2.x = cvt_pk_bf16(o20[0], o20[1]); w2.y = cvt_pk_bf16(o20[2], o20[3]); w2.z = cvt_pk_bf16(o21[0], o21[1]); w2.w = cvt_pk_bf16(o21[2], o21[3]);
                    bf16_t* dst = (pn < 4) ? (QH + (size_t)row * 2048 + (pn * 4 + wc) * 64 + d0) : (Kb + (size_t)row * 256 + wc * 64 + d0);
                    *(u32x4*)dst = w1; *(u32x4*)(dst + 32) = w2;
                } else {
#pragma unroll
                    for (int bj = 0; bj < 2; ++bj) {
                        const int cl = bj * 128 + wc * 32 + 8 * fq;
                        f32x4 v0 = acc[ai][bj][m][0] * rs, v1 = acc[ai][bj][m][1] * rs;
                        if (pn == 5) {
                            u32x4 w; w.x = cvt_pk_bf16(v0[0], v0[1]); w.y = cvt_pk_bf16(v0[2], v0[3]); w.z = cvt_pk_bf16(v1[0], v1[1]); w.w = cvt_pk_bf16(v1[2], v1[3]);
                            *(u32x4*)(Vb + (size_t)row * 256 + cl) = w;
                        } else if (pn < 10) {
                            const int c = (pn - 6) * 256 + cl;
#pragma unroll
                            for (int j = 0; j < 4; ++j) { v0[j] = siluf_(v0[j]); v1[j] = siluf_(v1[j]); }
                            u32x4 w; w.x = cvt_pk_bf16(v0[0], v0[1]); w.y = cvt_pk_bf16(v0[2], v0[3]); w.z = cvt_pk_bf16(v1[0], v1[1]); w.w = cvt_pk_bf16(v1[2], v1[3]);
                            *(u32x4*)(QH + (size_t)row * 2048 + 1024 + c) = w;
                        } else if (pn < 14) {
                            const int c = (pn - 10) * 256 + cl;
                            const f32x4 l0 = *(const f32x4*)(lb + c), l1 = *(const f32x4*)(lb + c + 4);
                            f32x4 g0, g1, k0, k1;
#pragma unroll
                            for (int j = 0; j < 4; ++j) {
                                { const float z = fminf(fmaxf(v0[j], -30.f), 30.f), e = __expf(-z), sg = 1.0f / (1.0f + e), om = 1.0f - l0[j]; g0[j] = __logf(l0[j] + om * sg); k0[j] = om * e * sg; }
                                { const float z = fminf(fmaxf(v1[j], -30.f), 30.f), e = __expf(-z), sg = 1.0f / (1.0f + e), om = 1.0f - l1[j]; g1[j] = __logf(l1[j] + om * sg); k1[j] = om * e * sg; }
                            }
                            *(f32x4*)(G + (size_t)row * 1024 + c) = g0; *(f32x4*)(G + (size_t)row * 1024 + c + 4) = g1;
                            u32x4 w; w.x = cvt_pk_bf16(k0[0], k0[1]); w.y = cvt_pk_bf16(k0[2], k0[3]); w.z = cvt_pk_bf16(k1[0], k1[1]); w.w = cvt_pk_bf16(k1[2], k1[3]);
                            *(u32x4*)(KIN + (size_t)row * 1024 + c) = w;
                        } else if (pn < 18) {
                            const int c = (pn - 14) * 256 + cl;
                            u32x4 w; w.x = cvt_pk_bf16(v0[0], v0[1]); w.y = cvt_pk_bf16(v0[2], v0[3]); w.z = cvt_pk_bf16(v1[0], v1[1]); w.w = cvt_pk_bf16(v1[2], v1[3]);
                            *(u32x4*)(HI + (size_t)row * 1024 + c) = w;
                        } else {
                            const int c = (pn - 18) * 256 + cl;
#pragma unroll
                            for (int j = 0; j < 4; ++j) { v0[j] = siluf_(v0[j]); v1[j] = siluf_(v1[j]); }
                            u32x4 w; w.x = cvt_pk_bf16(v0[0], v0[1]); w.y = cvt_pk_bf16(v0[2], v0[3]); w.z = cvt_pk_bf16(v1[0], v1[1]); w.w = cvt_pk_bf16(v1[2], v1[3]);
                            *(u32x4*)(HG + (size_t)row * 1024 + c) = w;
                        }
                    }
                }
                asm volatile("" ::: "memory");
            }
    }
};

template <bool MIDS> struct EpiRowSsq {
    static constexpr bool PERM = true, MID = MIDS;
    int kmid;
    bf16_t* O; u64* ssq; const u64* ssqA;
    __device__ __forceinline__ void mid(f32x4 (&acc)[2][2][4][2], const Unit& u, int wr, int wc, int fr, int fq) const {
#pragma unroll
        for (int ai = 0; ai < 2; ++ai)
#pragma unroll
            for (int m = 0; m < 4; ++m) {
                const int row = u.pm * 256 + ai * 128 + wr * 64 + m * 16 + fr;
                const float s = rsqrtf(fx_dec(ssqA[row]) * (1.0f / 1024.0f) + EPS);
#pragma unroll
                for (int bj = 0; bj < 2; ++bj)
#pragma unroll
                    for (int n = 0; n < 2; ++n) acc[ai][bj][m][n] = acc[ai][bj][m][n] * s;
            }
    }
    __device__ __forceinline__ void operator()(const f32x4 (&acc)[2][2][4][2], const Unit& u, int wr, int wc, int fr, int fq) const {
#pragma unroll
        for (int ai = 0; ai < 2; ++ai)
#pragma unroll
            for (int m = 0; m < 4; ++m) {
                const int row = u.pm * 256 + ai * 128 + wr * 64 + m * 16 + fr;
                float q = 0.f;
#pragma unroll
                for (int bj = 0; bj < 2; ++bj) {
                    const f32x4 v0 = acc[ai][bj][m][0], v1 = acc[ai][bj][m][1];
                    q += (v0[0] * v0[0] + v0[1] * v0[1]) + (v0[2] * v0[2] + v0[3] * v0[3]) + (v1[0] * v1[0] + v1[1] * v1[1]) + (v1[2] * v1[2] + v1[3] * v1[3]);
                    u32x4 w; w.x = cvt_pk_bf16(v0[0], v0[1]); w.y = cvt_pk_bf16(v0[2], v0[3]); w.z = cvt_pk_bf16(v1[0], v1[1]); w.w = cvt_pk_bf16(v1[2], v1[3]);
                    *(u32x4*)(O + (size_t)row * 2048 + u.pn * 256 + bj * 128 + wc * 32 + 8 * fq) = w;
                }
                q += shx(q, fq * 16 + fr, 16); q += shx(q, fq * 16 + fr, 32);
                if (fq == 0) fx_add(ssq + row, q);
                asm volatile("" ::: "memory");
            }
    }
};

struct EpiGU {
    static constexpr bool PERM = true, MID = false;
    int kmid;
    const u64* ssq2; bf16_t* ACT;
    __device__ __forceinline__ void mid(f32x4 (&acc)[2][2][4][2], const Unit& u, int wr, int wc, int fr, int fq) const {}
    __device__ __forceinline__ void operator()(const f32x4 (&acc)[2][2][4][2], const Unit& u, int wr, int wc, int fr, int fq) const {
#pragma unroll
        for (int ai = 0; ai < 2; ++ai)
#pragma unroll
            for (int m = 0; m < 4; ++m) {
                const int row = u.pm * 256 + ai * 128 + wr * 64 + m * 16 + fr;
                const float rs = rsqrtf(fx_dec(ssq2[row]) * (1.0f / DM) + EPS);
                f32x4 o0, o1;
#pragma unroll
                for (int j = 0; j < 4; ++j) {
                    const float g0 = acc[ai][0][m][0][j] * rs, u0 = acc[ai][1][m][0][j] * rs, g1 = acc[ai][0][m][1][j] * rs, u1 = acc[ai][1][m][1][j] * rs;
                    o0[j] = siluf_(g0) * u0; o1[j] = siluf_(g1) * u1;
                }
                u32x4 w; w.x = cvt_pk_bf16(o0[0], o0[1]); w.y = cvt_pk_bf16(o0[2], o0[3]); w.z = cvt_pk_bf16(o1[0], o1[1]); w.w = cvt_pk_bf16(o1[2], o1[3]);
                *(u32x4*)(ACT + (size_t)row * DFF + u.pn * 128 + wc * 32 + 8 * fq) = w;
                asm volatile("" ::: "memory");
            }
    }
};

struct EpiPlain {
    static constexpr bool PERM = true, MID = false;
    int kmid;
    bf16_t* O;
    __device__ __forceinline__ void mid(f32x4 (&acc)[2][2][4][2], const Unit& u, int wr, int wc, int fr, int fq) const {}
    __device__ __forceinline__ void operator()(const f32x4 (&acc)[2][2][4][2], const Unit& u, int wr, int wc, int fr, int fq) const {
#pragma unroll
        for (int ai = 0; ai < 2; ++ai)
#pragma unroll
            for (int m = 0; m < 4; ++m) {
                const int row = u.pm * 256 + ai * 128 + wr * 64 + m * 16 + fr;
#pragma unroll
                for (int bj = 0; bj < 2; ++bj) {
                    const f32x4 v0 = acc[ai][bj][m][0], v1 = acc[ai][bj][m][1];
                    u32x4 w; w.x = cvt_pk_bf16(v0[0], v0[1]); w.y = cvt_pk_bf16(v0[2], v0[3]); w.z = cvt_pk_bf16(v1[0], v1[1]); w.w = cvt_pk_bf16(v1[2], v1[3]);
                    *(u32x4*)(O + (size_t)row * 2048 + u.pn * 256 + bj * 128 + wc * 32 + 8 * fq) = w;
                }
                asm volatile("" ::: "memory");
            }
    }
};

struct EpiPle {
    static constexpr bool PERM = true, MID = false;
    int kmid;
    const u64* ssq3; const bf16_t* PP; const bf16_t* XB; float* OUT; bf16_t* HAn; u64* ssqN; int has_next;
    __device__ __forceinline__ void mid(f32x4 (&acc)[2][2][4][2], const Unit& u, int wr, int wc, int fr, int fq) const {}
    __device__ __forceinline__ void operator()(const f32x4 (&acc)[2][2][4][2], const Unit& u, int wr, int wc, int fr, int fq) const {
#pragma unroll
        for (int ai = 0; ai < 2; ++ai)
#pragma unroll
            for (int m = 0; m < 4; ++m) {
                const int row = u.pm * 256 + ai * 128 + wr * 64 + m * 16 + fr;
                const float rs = rsqrtf(fx_dec(ssq3[row]) * (1.0f / DM) + EPS);
                float q = 0.f;
#pragma unroll
                for (int bj = 0; bj < 2; ++bj) {
                    const size_t off = (size_t)row * 2048 + u.pn * 256 + bj * 128 + wc * 32 + 8 * fq;
                    const u32x4 pw = *(const u32x4*)(PP + off); const u32x4 xv = *(const u32x4*)(XB + off);
                    f32x4 x0 = (f32x4){bflo(xv.x), bfhi(xv.x), bflo(xv.y), bfhi(xv.y)}, x1 = (f32x4){bflo(xv.z), bfhi(xv.z), bflo(xv.w), bfhi(xv.w)};
                    const f32x4 v0 = acc[ai][bj][m][0] * rs, v1 = acc[ai][bj][m][1] * rs;
                    x0[0] += bflo(pw.x) * sigmoidf_(v0[0]); x0[1] += bfhi(pw.x) * sigmoidf_(v0[1]); x0[2] += bflo(pw.y) * sigmoidf_(v0[2]); x0[3] += bfhi(pw.y) * sigmoidf_(v0[3]);
                    x1[0] += bflo(pw.z) * sigmoidf_(v1[0]); x1[1] += bfhi(pw.z) * sigmoidf_(v1[1]); x1[2] += bflo(pw.w) * sigmoidf_(v1[2]); x1[3] += bfhi(pw.w) * sigmoidf_(v1[3]);
                    if (has_next) {
                        q += (x0[0] * x0[0] + x0[1] * x0[1]) + (x0[2] * x0[2] + x0[3] * x0[3]) + (x1[0] * x1[0] + x1[1] * x1[1]) + (x1[2] * x1[2] + x1[3] * x1[3]);
                        u32x4 w; w.x = cvt_pk_bf16(x0[0], x0[1]); w.y = cvt_pk_bf16(x0[2], x0[3]); w.z = cvt_pk_bf16(x1[0], x1[1]); w.w = cvt_pk_bf16(x1[2], x1[3]);
                        *(u32x4*)(HAn + off) = w;
                    } else { *(f32x4*)(OUT + off) = x0; *(f32x4*)(OUT + off + 4) = x1; }
                }
                if (has_next) { q += shx(q, fq * 16 + fr, 16); q += shx(q, fq * 16 + fr, 32); if (fq == 0) fx_add(ssqN + row, q); }
                asm volatile("" ::: "memory");
            }
    }
};

__device__ __forceinline__ void tr_item(const float* W, int ldw, int K, int k0, int n0, bf16_t* WT, int prow0, const float* gain, LAS float* scr, int lane) {
#pragma unroll 8
    for (int i = 0; i < 32; ++i) { const int kk = 2 * i + (lane >> 5); float w = W[(size_t)(k0 + kk) * ldw + n0 + (lane & 31)]; if (gain) w *= gain[k0 + kk]; scr[kk * 33 + (lane & 31)] = w; }
    asm volatile("s_waitcnt lgkmcnt(0)" ::: "memory");
    const int c = lane & 7;
#pragma unroll
    for (int j = 0; j < 4; ++j) { const int n = (lane >> 3) + 8 * j; const LAS float* s = scr + (8 * c) * 33 + n;
        u32x4 o; o.x = pk2(s[0 * 33], s[1 * 33]); o.y = pk2(s[2 * 33], s[3 * 33]); o.z = pk2(s[4 * 33], s[5 * 33]); o.w = pk2(s[6 * 33], s[7 * 33]);
        *(u32x4*)(WT + (size_t)(prow0 + n) * K + k0 + 8 * c) = o; }
    asm volatile("s_waitcnt lgkmcnt(0)" ::: "memory");
}

struct Args { const void* in[19]; float* out; unsigned char* ws; };

template <bool SRC_F32>
__device__ __forceinline__ void row_phase(const float* xsrc32, const bf16_t* xsrc16, const bf16_t* Mb, const u64* ssqIn, const float* gain, bf16_t* XB, u64* ssqOut, int gw, int ngw, int lane) {
    for (int row = gw; row < T; row += ngw) {
        const float rm = rsqrtf(fx_dec(ssqIn[row]) * (1.0f / DM) + EPS);
        float ss = 0.f;
#pragma unroll
        for (int j = 0; j < 4; ++j) {
            const int c = j * 512 + lane * 8; const size_t off = (size_t)row * 2048 + c;
            const u32x4 mv = *(const u32x4*)(Mb + off);
            f32x4 x0, x1;
            if (SRC_F32) { x0 = *(const f32x4*)(xsrc32 + off); x1 = *(const f32x4*)(xsrc32 + off + 4); }
            else { const u32x4 xv = *(const u32x4*)(xsrc16 + off); x0 = (f32x4){bflo(xv.x), bfhi(xv.x), bflo(xv.y), bfhi(xv.y)}; x1 = (f32x4){bflo(xv.z), bfhi(xv.z), bflo(xv.w), bfhi(xv.w)}; }
            const f32x4 g0 = *(const f32x4*)(gain + c), g1 = *(const f32x4*)(gain + c + 4);
            x0[0] += bflo(mv.x) * rm * g0[0]; x0[1] += bfhi(mv.x) * rm * g0[1]; x0[2] += bflo(mv.y) * rm * g0[2]; x0[3] += bfhi(mv.y) * rm * g0[3];
            x1[0] += bflo(mv.z) * rm * g1[0]; x1[1] += bfhi(mv.z) * rm * g1[1]; x1[2] += bflo(mv.w) * rm * g1[2]; x1[3] += bfhi(mv.w) * rm * g1[3];
            u32x4 w; w.x = pk2(x0[0], x0[1]); w.y = pk2(x0[2], x0[3]); w.z = pk2(x1[0], x1[1]); w.w = pk2(x1[2], x1[3]);
            *(u32x4*)(XB + off) = w;
            ss += (x0[0] * x0[0] + x0[1] * x0[1]) + (x0[2] * x0[2] + x0[3] * x0[3]) + (x1[0] * x1[0] + x1[1] * x1[1]) + (x1[2] * x1[2] + x1[3] * x1[3]);
        }
        ss = wave_sum(ss, lane);
        if (lane == 0) ssqOut[row] = fx_enc(ss);
    }
}

__device__ __forceinline__ void attn_naive(bf16_t* QH, const bf16_t* Kb, const bf16_t* Vb, const float* sinks, u64* ssqA, int gtid, int nthr) {
    for (int item = gtid; item < T * 16; item += nthr) {
        const int head = item / T, row = item % T, b = row / SEQ, t = row % SEQ, hk = head >> 2;
        float q[64], acc[64];
        const u32x4* qp = (const u32x4*)(QH + (size_t)row * 2048 + head * 64);
#pragma unroll
        for (int c = 0; c < 8; ++c) { const u32x4 w = qp[c]; q[8 * c] = bflo(w.x); q[8 * c + 1] = bfhi(w.x); q[8 * c + 2] = bflo(w.y); q[8 * c + 3] = bfhi(w.y); q[8 * c + 4] = bflo(w.z); q[8 * c + 5] = bfhi(w.z); q[8 * c + 6] = bflo(w.w); q[8 * c + 7] = bfhi(w.w); }
#pragma unroll
        for (int d = 0; d < 64; ++d) acc[d] = 0.f;
        float mx = sinks[head] * LOG2E, l = 1.0f;
        const int j0 = t - 127 < 0 ? 0 : t - 127;
        for (int j = j0; j <= t; ++j) {
            const size_t kr = (size_t)(b * SEQ + j) * 256 + hk * 64;
            const u32x4* kp = (const u32x4*)(Kb + kr);
            float s = 0.f;
#pragma unroll
            for (int c = 0; c < 8; ++c) { const u32x4 w = kp[c]; s += q[8 * c] * bflo(w.x) + q[8 * c + 1] * bfhi(w.x) + q[8 * c + 2] * bflo(w.y) + q[8 * c + 3] * bfhi(w.y) + q[8 * c + 4] * bflo(w.z) + q[8 * c + 5] * bfhi(w.z) + q[8 * c + 6] * bflo(w.w) + q[8 * c + 7] * bfhi(w.w); }
            if (s > mx) { const float cf = exp2f(mx - s); l *= cf;
#pragma unroll
                for (int d = 0; d < 64; ++d) acc[d] *= cf;
                mx = s; }
            const float p = exp2f(s - mx); l += p;
            const u32x4* vp = (const u32x4*)(Vb + kr);
#pragma unroll
            for (int c = 0; c < 8; ++c) { const u32x4 w = vp[c]; acc[8 * c] += p * bflo(w.x); acc[8 * c + 1] += p * bfhi(w.x); acc[8 * c + 2] += p * bflo(w.y); acc[8 * c + 3] += p * bfhi(w.y); acc[8 * c + 4] += p * bflo(w.z); acc[8 * c + 5] += p * bfhi(w.z); acc[8 * c + 6] += p * bflo(w.w); acc[8 * c + 7] += p * bfhi(w.w); }
        }
        const float il = 1.0f / l; float ss = 0.f;
        u32x4* op = (u32x4*)(QH + (size_t)row * 2048 + head * 64);
#pragma unroll
        for (int c = 0; c < 8; ++c) {
            float o[8];
#pragma unroll
            for (int e = 0; e < 8; ++e) { o[e] = acc[8 * c + e] * il; ss += o[e] * o[e]; }
            u32x4 w; w.x = pk2(o[0], o[1]); w.y = pk2(o[2], o[3]); w.z = pk2(o[4], o[5]); w.w = pk2(o[6], o[7]); op[c] = w;
        }
        fx_add(ssqA + row, ss);
    }
}

__device__ __forceinline__ void hgrn_naive(const bf16_t* QH, const bf16_t* KIN, const float* G, const bf16_t* HI, float* tmpO, int item, int lane) {
    const int bh = item >> 1, b = bh >> 3, h = bh & 7, v = (item & 1) * 64 + lane;
    float S[128];
#pragma unroll
    for (int k = 0; k < 128; ++k) S[k] = 0.f;
    int z = 0; asm volatile("v_mov_b32 %0, 0" : "=v"(z));
    for (int t = 0; t < SEQ; ++t) {
        const size_t row = (size_t)b * SEQ + t;
        const float vv = bf2f(HI[row * 1024 + h * 128 + v]);
        const u32x4* qp = (const u32x4*)(QH + row * 2048 + 1024 + h * 128 + z);
        const u32x4* kp = (const u32x4*)(KIN + row * 1024 + h * 128 + z);
        const f32x4* gp = (const f32x4*)(G + row * 1024 + h * 128 + z);
        float o = 0.f;
#pragma unroll
        for (int c = 0; c < 16; ++c) {
            const u32x4 qw = qp[c], kw = kp[c]; const f32x4 g0 = gp[2 * c], g1 = gp[2 * c + 1];
            const float qq[8] = {bflo(qw.x), bfhi(qw.x), bflo(qw.y), bfhi(qw.y), bflo(qw.z), bfhi(qw.z), bflo(qw.w), bfhi(qw.w)};
            const float kk[8] = {bflo(kw.x), bfhi(kw.x), bflo(kw.y), bfhi(kw.y), bflo(kw.z), bfhi(kw.z), bflo(kw.w), bfhi(kw.w)};
            const float gg[8] = {g0[0], g0[1], g0[2], g0[3], g1[0], g1[1], g1[2], g1[3]};
#pragma unroll
            for (int e = 0; e < 8; ++e) { const float f = __expf(gg[e]); S[8 * c + e] = f * S[8 * c + e] + kk[e] * vv; o += S[8 * c + e] * qq[e]; }
        }
        tmpO[row * 1024 + h * 128 + v] = o;
    }
}
__device__ __forceinline__ void hgrn_norm_naive(const float* tmpO, const bf16_t* HG, bf16_t* QH, int gw, int ngw, int lane) {
    for (int row = gw; row < T; row += ngw) {
        const size_t off = (size_t)row * 1024 + lane * 16;
        f32x4 o[4]; float ss = 0.f;
#pragma unroll
        for (int j = 0; j < 4; ++j) { o[j] = *(const f32x4*)(tmpO + off + 4 * j); ss += (o[j][0] * o[j][0] + o[j][1] * o[j][1]) + (o[j][2] * o[j][2] + o[j][3] * o[j][3]); }
        ss += shx(ss, lane, 1); ss += shx(ss, lane, 2); ss += shx(ss, lane, 4);
        const float r = rsqrtf(ss * (1.0f / 128.0f) + EPS);
        const u32x4 g0 = *(const u32x4*)(HG + off), g1 = *(const u32x4*)(HG + off + 8);
        u32x4 w0, w1;
        w0.x = pk2(o[0][0] * r * bflo(g0.x), o[0][1] * r * bfhi(g0.x)); w0.y = pk2(o[0][2] * r * bflo(g0.y), o[0][3] * r * bfhi(g0.y));
        w0.z = pk2(o[1][0] * r * bflo(g0.z), o[1][1] * r * bfhi(g0.z)); w0.w = pk2(o[1][2] * r * bflo(g0.w), o[1][3] * r * bfhi(g0.w));
        w1.x = pk2(o[2][0] * r * bflo(g1.x), o[2][1] * r * bfhi(g1.x)); w1.y = pk2(o[2][2] * r * bflo(g1.y), o[2][3] * r * bfhi(g1.y));
        w1.z = pk2(o[3][0] * r * bflo(g1.z), o[3][1] * r * bfhi(g1.z)); w1.w = pk2(o[3][2] * r * bflo(g1.w), o[3][3] * r * bfhi(g1.w));
        bf16_t* dst = QH + (size_t)row * 2048 + 1024 + lane * 16;
        *(u32x4*)dst = w0; *(u32x4*)(dst + 8) = w1;
    }
}


typedef float f32x16 __attribute__((ext_vector_type(16)));
typedef short bf16x8 __attribute__((ext_vector_type(8)));
typedef unsigned u32x2 __attribute__((ext_vector_type(2)));
__device__ __forceinline__ int crow(int r, int hi) { return (r & 3) + 8 * (r >> 2) + 4 * hi; }
__device__ __forceinline__ bf16x8 pack8(float a0, float a1, float a2, float a3, float a4, float a5, float a6, float a7) {
    u32x4 w; w.x = cvt_pk_bf16(a0, a1); w.y = cvt_pk_bf16(a2, a3); w.z = cvt_pk_bf16(a4, a5); w.w = cvt_pk_bf16(a6, a7); return __builtin_bit_cast(bf16x8, w);
}
constexpr int AT_KSTR = 144, AT_VSTR = 528, AT_VOFF = 256 * AT_KSTR;

__device__ __forceinline__ void attn_unit(LAS unsigned char* lds, bf16_t* QH, const bf16_t* Kb, const bf16_t* Vb, const float* sinks, u64* ssqA, int unit, int tid, int lane, int wave) {
    const int hk = unit & 3, n = (unit >> 2) & 31, b = unit >> 7;
    const long rowbase = (long)b * SEQ + n * 128 - 128;
    LAS unsigned char* Ks = lds; LAS unsigned char* Vt = lds + AT_VOFF;
#pragma unroll
    for (int i = 0; i < 4; ++i) {
        const int row = (tid >> 3) + 64 * i; u32x4 v = (u32x4){0u, 0u, 0u, 0u};
        if (n > 0 || row >= 128) v = *(const u32x4*)(Kb + (rowbase + row) * 256 + hk * 64 + (tid & 7) * 8);
        *(LAS u32x4*)(Ks + row * AT_KSTR + (tid & 7) * 16) = v;
    }
#pragma unroll
    for (int i = 0; i < 4; ++i) {
        const int key = lane + 64 * i; u32x4 v = (u32x4){0u, 0u, 0u, 0u};
        if (n > 0 || key >= 128) v = *(const u32x4*)(Vb + (rowbase + key) * 256 + hk * 64 + wave * 8);
        LAS unsigned short* vp = (LAS unsigned short*)(Vt + (wave * 8) * AT_VSTR + key * 2);
        vp[0 * 264] = (unsigned short)(v.x & 0xffffu); vp[1 * 264] = (unsigned short)(v.x >> 16); vp[2 * 264] = (unsigned short)(v.y & 0xffffu); vp[3 * 264] = (unsigned short)(v.y >> 16);
        vp[4 * 264] = (unsigned short)(v.z & 0xffffu); vp[5 * 264] = (unsigned short)(v.z >> 16); vp[6 * 264] = (unsigned short)(v.w & 0xffffu); vp[7 * 264] = (unsigned short)(v.w >> 16);
    }
    __syncthreads();
    const int g = wave >> 1, qh = wave & 1, head = hk * 4 + g, r = lane & 31, h = lane >> 5;
    const float sink2 = sinks[head] * LOG2E;
    for (int qt = 0; qt < 2; ++qt) {
        const int t0 = 64 * qh + 32 * qt, t = t0 + r;
        const size_t qrow = (size_t)b * SEQ + n * 128 + t;
        bf16_t* qp = QH + qrow * 2048 + head * 64;
        bf16x8 qf[4];
#pragma unroll
        for (int s4 = 0; s4 < 4; ++s4) qf[s4] = *(const bf16x8*)(qp + 16 * s4 + 8 * h);
        f32x16 S[5];
#pragma unroll
        for (int jt = 0; jt < 5; ++jt) {
            const int kb = t0 + 32 * jt;
            f32x16 a = {};
#pragma unroll
            for (int s4 = 0; s4 < 4; ++s4) { const bf16x8 kf = *(const LAS bf16x8*)(Ks + (kb + r) * AT_KSTR + (16 * s4 + 8 * h) * 2); a = __builtin_amdgcn_mfma_f32_32x32x16_bf16(kf, qf[s4], a, 0, 0, 0); }
            S[jt] = a;
        }
        float mx = sink2;
#pragma unroll
        for (int jt = 0; jt < 5; ++jt)
#pragma unroll
            for (int rg = 0; rg < 16; ++rg) {
                const int ki = t0 + 32 * jt + crow(rg, h);
                const bool ok = (ki > t) && (ki <= t + 128) && (n > 0 || ki >= 128);
                const float v = ok ? S[jt][rg] : -1e30f; S[jt][rg] = v; mx = fmaxf(mx, v);
            }
        mx = fmaxf(mx, shx(mx, lane, 32));
        float l = 0.f;
#pragma unroll
        for (int jt = 0; jt < 5; ++jt)
#pragma unroll
            for (int rg = 0; rg < 16; ++rg) { const float p = __builtin_amdgcn_exp2f(S[jt][rg] - mx); S[jt][rg] = p; l += p; }
        l += shx(l, lane, 32);
        l += __builtin_amdgcn_exp2f(sink2 - mx);
        f32x16 O[2]; O[0] = (f32x16){}; O[1] = (f32x16){};
#pragma unroll
        for (int jt = 0; jt < 5; ++jt)
#pragma unroll
            for (int sp = 0; sp < 2; ++sp) {
                const bf16x8 pf = pack8(S[jt][8 * sp], S[jt][8 * sp + 1], S[jt][8 * sp + 2], S[jt][8 * sp + 3], S[jt][8 * sp + 4], S[jt][8 * sp + 5], S[jt][8 * sp + 6], S[jt][8 * sp + 7]);
                const int kk = t0 + 32 * jt + 16 * sp + 4 * h;
#pragma unroll
                for (int dt = 0; dt < 2; ++dt) {
                    const LAS unsigned char* vrow = Vt + (32 * dt + r) * AT_VSTR + kk * 2;
                    const u32x2 lo = *(const LAS u32x2*)vrow, hi2 = *(const LAS u32x2*)(vrow + 16);
                    u32x4 w; w.x = lo.x; w.y = lo.y; w.z = hi2.x; w.w = hi2.y;
                    O[dt] = __builtin_amdgcn_mfma_f32_32x32x16_bf16(__builtin_bit_cast(bf16x8, w), pf, O[dt], 0, 0, 0);
                }
            }
        const float il = 1.0f / l; float ss = 0.f;
#pragma unroll
        for (int dt = 0; dt < 2; ++dt)
#pragma unroll
            for (int gp = 0; gp < 4; ++gp) {
                const float o0 = O[dt][4 * gp] * il, o1 = O[dt][4 * gp + 1] * il, o2 = O[dt][4 * gp + 2] * il, o3 = O[dt][4 * gp + 3] * il;
                ss += (o0 * o0 + o1 * o1) + (o2 * o2 + o3 * o3);
                u32x2 w; w.x = cvt_pk_bf16(o0, o1); w.y = cvt_pk_bf16(o2, o3);
                *(u32x2*)(qp + 32 * dt + 8 * gp + 4 * h) = w;
            }
        ss += shx(ss, lane, 32);
        if (h == 0) fx_add(ssqA + qrow, ss);
    }
    __syncthreads();
}

constexpr int HG_STR = 144;
__device__ __forceinline__ void hgrn_h1_unit(LAS unsigned char* lds, const bf16_t* KIN, const float* G, const bf16_t* HI, bf16_t* SB, float* DEC, int unit, int tid, int lane, int wave) {
    const int c = unit & 63, bh = unit >> 6, b = bh >> 3, h = bh & 7;
    const size_t row0 = (size_t)b * SEQ + c * 64;
    LAS unsigned char* Kt = lds;
    LAS unsigned char* Vt = lds + 128 * HG_STR;
    LAS float* tot = (LAS float*)(lds + 2 * 128 * HG_STR);
    const int k = tid & 127, sg = tid >> 7;
    float bl[16]; float run = 0.f;
#pragma unroll
    for (int i = 0; i < 16; ++i) { run += G[(row0 + sg * 16 + i) * 1024 + h * 128 + k]; bl[i] = run; }
    tot[sg * 128 + k] = run;
    float kv[16], vv[16];
#pragma unroll
    for (int i = 0; i < 16; ++i) { kv[i] = bf2f(KIN[(row0 + sg * 16 + i) * 1024 + h * 128 + k]); vv[i] = bf2f(HI[(row0 + sg * 16 + i) * 1024 + h * 128 + k]); }
    __syncthreads();
    const float t0 = tot[k], t1 = tot[128 + k], t2 = tot[256 + k], t3 = tot[384 + k];
    const float blast = (t0 + t1) + (t2 + t3);
    const float off = (sg > 0 ? t0 : 0.f) + (sg > 1 ? t1 : 0.f) + (sg > 2 ? t2 : 0.f);
    if (sg == 0) DEC[(size_t)unit * 128 + k] = __expf(blast);
    float kt[16];
#pragma unroll
    for (int i = 0; i < 16; ++i) kt[i] = kv[i] * __expf(blast - (bl[i] + off));
    {
        u32x4 w0, w1;
        w0.x = pk2(kt[0], kt[1]); w0.y = pk2(kt[2], kt[3]); w0.z = pk2(kt[4], kt[5]); w0.w = pk2(kt[6], kt[7]);
        w1.x = pk2(kt[8], kt[9]); w1.y = pk2(kt[10], kt[11]); w1.z = pk2(kt[12], kt[13]); w1.w = pk2(kt[14], kt[15]);
        *(LAS u32x4*)(Kt + k * HG_STR + sg * 32) = w0; *(LAS u32x4*)(Kt + k * HG_STR + sg * 32 + 16) = w1;
        w0.x = pk2(vv[0], vv[1]); w0.y = pk2(vv[2], vv[3]); w0.z = pk2(vv[4], vv[5]); w0.w = pk2(vv[6], vv[7]);
        w1.x = pk2(vv[8], vv[9]); w1.y = pk2(vv[10], vv[11]); w1.z = pk2(vv[12], vv[13]); w1.w = pk2(vv[14], vv[15]);
        *(LAS u32x4*)(Vt + k * HG_STR + sg * 32) = w0; *(LAS u32x4*)(Vt + k * HG_STR + sg * 32 + 16) = w1;
    }
    __syncthreads();
    const int vt = wave >> 1, kt0 = (wave & 1) * 2, r = lane & 31, hh = lane >> 5;
    f32x16 acc0 = {}, acc1 = {};
#pragma unroll
    for (int st = 0; st < 4; ++st) {
        const bf16x8 af = *(const LAS bf16x8*)(Vt + (32 * vt + r) * HG_STR + (16 * st + 8 * hh) * 2);
        const bf16x8 b0 = *(const LAS bf16x8*)(Kt + (32 * kt0 + r) * HG_STR + (16 * st + 8 * hh) * 2);
        const bf16x8 b1 = *(const LAS bf16x8*)(Kt + (32 * (kt0 + 1) + r) * HG_STR + (16 * st + 8 * hh) * 2);
        acc0 = __builtin_amdgcn_mfma_f32_32x32x16_bf16(af, b0, acc0, 0, 0, 0);
        acc1 = __builtin_amdgcn_mfma_f32_32x32x16_bf16(af, b1, acc1, 0, 0, 0);
    }
    bf16_t* sb = SB + (size_t)unit * 16384;
#pragma unroll
    for (int rg = 0; rg < 16; ++rg) {
        const int v = 32 * vt + crow(rg, hh);
        sb[v * 128 + 32 * kt0 + r] = (bf16_t)f2bf(acc0[rg]);
        sb[v * 128 + 32 * (kt0 + 1) + r] = (bf16_t)f2bf(acc1[rg]);
    }
    __syncthreads();
}

__device__ __forceinline__ void hgrn_scan(bf16_t* SB, const float* DEC, int gtid, int nthr) {
    for (int item = gtid; item < 32 * 128 * 32; item += nthr) {
        const int kq = item & 31, v = (item >> 5) & 127, bh = item >> 12;
        f32x4 st = (f32x4){0.f, 0.f, 0.f, 0.f};
        u32x2* p = (u32x2*)(SB + ((size_t)bh * 64 * 128 + v) * 128 + kq * 4);
        const f32x4* dp = (const f32x4*)(DEC + (size_t)bh * 64 * 128 + kq * 4);
#pragma unroll 8
        for (int c = 0; c < 64; ++c) {
            const u32x2 d = p[(size_t)c * 16384 / 4]; const f32x4 dc = dp[c * 32];
            u32x2 o; o.x = cvt_pk_bf16(st[0], st[1]); o.y = cvt_pk_bf16(st[2], st[3]);
            p[(size_t)c * 16384 / 4] = o;
            st[0] = dc[0] * st[0] + bflo(d.x); st[1] = dc[1] * st[1] + bfhi(d.x); st[2] = dc[2] * st[2] + bflo(d.y); st[3] = dc[3] * st[3] + bfhi(d.y);
        }
    }
}

constexpr int H3_BSTR = 528, H3_QSTR = 272, H3_B_OFF = 0, H3_Q_OFF = 64 * H3_BSTR, H3_K_OFF = H3_Q_OFF + 64 * H3_QSTR, H3_V_OFF = H3_K_OFF + 64 * H3_QSTR, H3_T_OFF = H3_V_OFF + 128 * HG_STR, H3_O_OFF = H3_T_OFF + 2048;
__device__ __forceinline__ void hgrn_h3_unit(LAS unsigned char* lds, bf16_t* QH, const bf16_t* KIN, const float* G, const bf16_t* HI, const bf16_t* HG, const bf16_t* SB, int unit, int tid, int lane, int wave) {
    const int c = unit & 63, bh = unit >> 6, b = bh >> 3, h = bh & 7;
    const size_t row0 = (size_t)b * SEQ + c * 64;
    LAS unsigned char* Bl = lds + H3_B_OFF;
    LAS unsigned char* Qs = lds + H3_Q_OFF;
    LAS unsigned char* Ks = lds + H3_K_OFF;
    LAS unsigned char* Vt = lds + H3_V_OFF;
    LAS float* tot = (LAS float*)(lds + H3_T_OFF);
    LAS float* osq = (LAS float*)(lds + H3_O_OFF);
    {
        const int k = tid & 127, sg = tid >> 7;
        float bl[16]; float run = 0.f;
#pragma unroll
        for (int i = 0; i < 16; ++i) { run += G[(row0 + sg * 16 + i) * 1024 + h * 128 + k]; bl[i] = run; }
        tot[sg * 128 + k] = run;
        float vv[16];
#pragma unroll
        for (int i = 0; i < 16; ++i) vv[i] = bf2f(HI[(row0 + sg * 16 + i) * 1024 + h * 128 + k]);
        u32x4 w0, w1;
        w0.x = pk2(vv[0], vv[1]); w0.y = pk2(vv[2], vv[3]); w0.z = pk2(vv[4], vv[5]); w0.w = pk2(vv[6], vv[7]);
        w1.x = pk2(vv[8], vv[9]); w1.y = pk2(vv[10], vv[11]); w1.z = pk2(vv[12], vv[13]); w1.w = pk2(vv[14], vv[15]);
        *(LAS u32x4*)(Vt + k * HG_STR + sg * 32) = w0; *(LAS u32x4*)(Vt + k * HG_STR + sg * 32 + 16) = w1;
#pragma unroll
        for (int i = 0; i < 2; ++i) {
            const int idx = tid + 512 * i, rr = idx >> 4, ch = idx & 15;
            *(LAS u32x4*)(Qs + rr * H3_QSTR + ch * 16) = *(const u32x4*)(QH + (row0 + rr) * 2048 + 1024 + h * 128 + ch * 8);
            *(LAS u32x4*)(Ks + rr * H3_QSTR + ch * 16) = *(const u32x4*)(KIN + (row0 + rr) * 1024 + h * 128 + ch * 8);
        }
        __syncthreads();
        const float t0 = tot[k], t1 = tot[128 + k], t2 = tot[256 + k];
        const float off = (sg > 0 ? t0 : 0.f) + (sg > 1 ? t1 : 0.f) + (sg > 2 ? t2 : 0.f);
#pragma unroll
        for (int i = 0; i < 16; ++i) *(LAS float*)(Bl + (sg * 16 + i) * H3_BSTR + k * 4) = bl[i] + off;
        __syncthreads();
    }
    const int i4 = wave & 3, vh = wave >> 2, fr = lane & 15, hh = lane >> 4;
    const int tq = 16 * i4 + fr;
    bf16x8 qhat[4], qtil[4];
#pragma unroll
    for (int ks = 0; ks < 4; ++ks) {
        const int k0 = 32 * ks + 8 * hh;
        const u32x4 qw = *(const LAS u32x4*)(Qs + tq * H3_QSTR + k0 * 2);
        const f32x4 b0 = *(const LAS f32x4*)(Bl + tq * H3_BSTR + k0 * 4), b1 = *(const LAS f32x4*)(Bl + tq * H3_BSTR + k0 * 4 + 16);
        f32x4 r0 = (f32x4){0.f, 0.f, 0.f, 0.f}, r1 = r0;
        if (i4 > 0) { r0 = *(const LAS f32x4*)(Bl + (16 * i4 - 1) * H3_BSTR + k0 * 4); r1 = *(const LAS f32x4*)(Bl + (16 * i4 - 1) * H3_BSTR + k0 * 4 + 16); }
        const float q[8] = {bflo(qw.x), bfhi(qw.x), bflo(qw.y), bfhi(qw.y), bflo(qw.z), bfhi(qw.z), bflo(qw.w), bfhi(qw.w)};
        const float bb[8] = {b0[0], b0[1], b0[2], b0[3], b1[0], b1[1], b1[2], b1[3]};
        const float rf[8] = {r0[0], r0[1], r0[2], r0[3], r1[0], r1[1], r1[2], r1[3]};
        float a[8], t8[8];
#pragma unroll
        for (int e = 0; e < 8; ++e) { a[e] = q[e] * __expf(bb[e] - rf[e]); t8[e] = q[e] * __expf(bb[e]); }
        qhat[ks] = pack8(a[0], a[1], a[2], a[3], a[4], a[5], a[6], a[7]);
        qtil[ks] = pack8(t8[0], t8[1], t8[2], t8[3], t8[4], t8[5], t8[6], t8[7]);
    }
    f32x4 at[4];
#pragma unroll
    for (int j = 0; j < 4; ++j) {
        at[j] = (f32x4){0.f, 0.f, 0.f, 0.f};
        if (j <= i4) {
            const int sr = 16 * j + fr;
#pragma unroll
            for (int ks = 0; ks < 4; ++ks) {
                const int k0 = 32 * ks + 8 * hh;
                const u32x4 kw = *(const LAS u32x4*)(Ks + sr * H3_QSTR + k0 * 2);
                const f32x4 b0 = *(const LAS f32x4*)(Bl + sr * H3_BSTR + k0 * 4), b1 = *(const LAS f32x4*)(Bl + sr * H3_BSTR + k0 * 4 + 16);
                f32x4 r0 = (f32x4){0.f, 0.f, 0.f, 0.f}, r1 = r0;
                if (i4 > 0) { r0 = *(const LAS f32x4*)(Bl + (16 * i4 - 1) * H3_BSTR + k0 * 4); r1 = *(const LAS f32x4*)(Bl + (16 * i4 - 1) * H3_BSTR + k0 * 4 + 16); }
                const float kk[8] = {bflo(kw.x), bfhi(kw.x), bflo(kw.y), bfhi(kw.y), bflo(kw.z), bfhi(kw.z), bflo(kw.w), bfhi(kw.w)};
                const float bb[8] = {b0[0], b0[1], b0[2], b0[3], b1[0], b1[1], b1[2], b1[3]};
                const float rf[8] = {r0[0], r0[1], r0[2], r0[3], r1[0], r1[1], r1[2], r1[3]};
                float a[8];
#pragma unroll
                for (int e = 0; e < 8; ++e) a[e] = kk[e] * __expf(fminf(rf[e] - bb[e], 80.f));
                const bf16x8 kf = pack8(a[0], a[1], a[2], a[3], a[4], a[5], a[6], a[7]);
                at[j] = __builtin_amdgcn_mfma_f32_16x16x32_bf16(kf, qhat[ks], at[j], 0, 0, 0);
            }
            if (j == i4) {
#pragma unroll
                for (int rg = 0; rg < 4; ++rg) if (4 * hh + rg > fr) at[j][rg] = 0.f;
            }
        }
    }
    f32x4 o[4];
#pragma unroll
    for (int vt = 0; vt < 4; ++vt) o[vt] = (f32x4){0.f, 0.f, 0.f, 0.f};
#pragma unroll
    for (int p = 0; p < 2; ++p) {
        if (2 * p <= i4) {
            const bf16x8 pf = pack8(at[2 * p][0], at[2 * p][1], at[2 * p][2], at[2 * p][3], at[2 * p + 1][0], at[2 * p + 1][1], at[2 * p + 1][2], at[2 * p + 1][3]);
#pragma unroll
            for (int vt = 0; vt < 4; ++vt) {
                const LAS unsigned char* vrow = Vt + (64 * vh + 16 * vt + fr) * HG_STR;
                const u32x2 lo = *(const LAS u32x2*)(vrow + (32 * p + 4 * hh) * 2), hi2 = *(const LAS u32x2*)(vrow + (32 * p + 16 + 4 * hh) * 2);
                u32x4 w; w.x = lo.x; w.y = lo.y; w.z = hi2.x; w.w = hi2.y;
                o[vt] = __builtin_amdgcn_mfma_f32_16x16x32_bf16(__builtin_bit_cast(bf16x8, w), pf, o[vt], 0, 0, 0);
            }
        }
    }
    {
        const bf16_t* sb = SB + (size_t)unit * 16384;
#pragma unroll
        for (int vt = 0; vt < 4; ++vt)
#pragma unroll
            for (int ks = 0; ks < 4; ++ks) {
                const bf16x8 sf = *(const bf16x8*)(sb + (64 * vh + 16 * vt + fr) * 128 + 32 * ks + 8 * hh);
                o[vt] = __builtin_amdgcn_mfma_f32_16x16x32_bf16(sf, qtil[ks], o[vt], 0, 0, 0);
            }
    }
    float ss = 0.f;
#pragma unroll
    for (int vt = 0; vt < 4; ++vt) ss += (o[vt][0] * o[vt][0] + o[vt][1] * o[vt][1]) + (o[vt][2] * o[vt][2] + o[vt][3] * o[vt][3]);
    ss += shx(ss, lane, 16); ss += shx(ss, lane, 32);
    if (hh == 0) osq[vh * 64 + tq] = ss;
    __syncthreads();
    const float rn = rsqrtf((osq[tq] + osq[64 + tq]) * (1.0f / 128.0f) + EPS);
#pragma unroll
    for (int vt = 0; vt < 4; ++vt) {
        const int v = 64 * vh + 16 * vt + 4 * hh;
        const u32x2 gw = *(const u32x2*)(HG + (row0 + tq) * 1024 + h * 128 + v);
        u32x2 w; w.x = cvt_pk_bf16(o[vt][0] * rn * bflo(gw.x), o[vt][1] * rn * bfhi(gw.x)); w.y = cvt_pk_bf16(o[vt][2] * rn * bflo(gw.y), o[vt][3] * rn * bfhi(gw.y));
        *(u32x2*)(QH + (row0 + tq) * 2048 + 1024 + h * 128 + v) = w;
    }
    __syncthreads();
}


#define XB_TMO      128
#define XB_XCNT(j)  (256  + 64 * (j))
#define XB_XSUB(j)  (1280 + 64 * (j))
#define XB_XGEN(j)  (2304 + 64 * (j))
#define XB_TOP      3328
#define XB_TOPGEN   3392
#define XCD_BAR_WORDS 3456
#define XB_SPIN_CAP (1u << 22)
__device__ __forceinline__ unsigned xb_ld(unsigned* p)              { return __hip_atomic_load(p, __ATOMIC_RELAXED, __HIP_MEMORY_SCOPE_AGENT); }
__device__ __forceinline__ unsigned xb_add(unsigned* p, unsigned v) { return __hip_atomic_fetch_add(p, v, __ATOMIC_RELAXED, __HIP_MEMORY_SCOPE_AGENT); }
__device__ __forceinline__ unsigned xb_xcc_id() { return (unsigned)__builtin_amdgcn_s_getreg((3 << 11) | 20) & 0xFu; }
#define XB_SPIN(cond, bar) do { unsigned _sp = 0; while (cond) { __builtin_amdgcn_s_sleep(1); \
    if ((++_sp & 255u) == 0u) { if (xb_ld(&(bar)[XB_TMO])) break; if (_sp > XB_SPIN_CAP) { atomicAdd(&(bar)[XB_TMO], 1u); break; } } } } while (0)
struct XcdBarrier { unsigned* bar; unsigned x; volatile LAS unsigned* st; };
__device__ __forceinline__ XcdBarrier xcd_barrier_post(unsigned* bar, volatile LAS unsigned* st) {
    XcdBarrier b; b.bar = bar; b.x = xb_xcc_id(); b.st = st;
    if (threadIdx.x == 0) (void)xb_add(&bar[XB_XCNT(b.x)], 1u);
    return b;
}
__device__ __forceinline__ void xcd_barrier_complete(unsigned* bar, unsigned x, unsigned& nloc, unsigned& nx) {
    const unsigned G = gridDim.x * gridDim.y * gridDim.z;
    unsigned sum, cnt, mine, sp = 0u;
    for (;;) {
        sum = 0u; cnt = 0u; mine = 0u;
#pragma unroll
        for (unsigned j = 0; j < 16; ++j) { const unsigned c = xb_ld(&bar[XB_XCNT(j)]); sum += c; cnt += (c > 0u) ? 1u : 0u; mine = (j == x) ? c : mine; }
        if (sum == G) break;
        __builtin_amdgcn_s_sleep(1);
        if ((++sp & 255u) == 0u) { if (xb_ld(&bar[XB_TMO])) break; if (sp > XB_SPIN_CAP) { atomicAdd(&bar[XB_TMO], 1u); break; } }
    }
    nloc = mine > 0u ? mine : 1u; nx = cnt > 0u ? cnt : 1u;
}
__device__ __forceinline__ void xcd_barrier(const XcdBarrier& b) {
    asm volatile("s_waitcnt vmcnt(0)" ::: "memory");
    __syncthreads();
    if (threadIdx.x == 0) {
        unsigned* bar = b.bar;
        __builtin_amdgcn_s_waitcnt(0);
        unsigned nloc = b.st[0], nx = b.st[1];
        if (nloc == 0u) { xcd_barrier_complete(bar, b.x, nloc, nx); b.st[0] = nloc; b.st[1] = nx; }
        const unsigned old = xb_add(&bar[XB_XSUB(b.x)], 1u);
        const unsigned gen = old / nloc;
        if (old + 1u == (gen + 1u) * nloc) {
            __builtin_amdgcn_fence(__ATOMIC_RELEASE, "agent");
            asm volatile("s_waitcnt vmcnt(0)" ::: "memory");
            const unsigned og = xb_add(&bar[XB_TOP], 1u);
            const unsigned tg = og / nx;
            if (og + 1u == (tg + 1u) * nx) xb_add(&bar[XB_TOPGEN], 1u);
            else XB_SPIN(xb_ld(&bar[XB_TOPGEN]) == tg, bar);
            __builtin_amdgcn_fence(__ATOMIC_ACQUIRE, "agent");
            xb_add(&bar[XB_XGEN(b.x)], 1u);
            asm volatile("s_waitcnt vmcnt(0)" ::: "memory");
        } else {
            XB_SPIN(xb_ld(&bar[XB_XGEN(b.x)]) == gen, bar);
            __builtin_amdgcn_fence(__ATOMIC_ACQUIRE, "agent");
            asm volatile("s_waitcnt vmcnt(0)" ::: "memory");
        }
    }
    __syncthreads();
}

__global__ void __launch_bounds__(NTHR, 2) fwd_megakernel(Args args) {
    extern __shared__ __attribute__((aligned(16))) unsigned char lds_raw[];
    LAS unsigned char* lds = (LAS unsigned char*)lds_raw;
    cg::grid_group grid = cg::this_grid();
    const int G = gridDim.x, bx = blockIdx.x, ngw = G * NWAVES, nthr = G * NTHR;
    const int wave = __builtin_amdgcn_readfirstlane((int)threadIdx.x >> 6);
#define PHASE_IDS() int lane_; asm volatile("v_mbcnt_lo_u32_b32 %0, -1, 0\n\tv_mbcnt_hi_u32_b32 %0, -1, %0" : "=v"(lane_)); const int lane = lane_, tid = wave * 64 + lane, gw = bx * NWAVES + wave, gtid = bx * NTHR + tid; (void)gw; (void)gtid
    unsigned char* ws = args.ws;
    const float* x_in = (const float*)args.in[0]; const float* p_in = (const float*)args.in[1]; const int* pos = (const int*)args.in[2];
    const float* w_in = (const float*)args.in[3]; const float* sinks = (const float*)args.in[4]; const float* lb_logits = (const float*)args.in[5];
    const float* attn_gain = (const float*)args.in[6]; const float* hgrn_gain = (const float*)args.in[7]; const float* w_out = (const float*)args.in[8];
    const float* pre_mix = (const float*)args.in[9]; const float* post_mix = (const float*)args.in[10]; const float* pre_ffn = (const float*)args.in[11]; const float* post_ffn = (const float*)args.in[12];
    const float* w_gate = (const float*)args.in[13]; const float* w_up = (const float*)args.in[14]; const float* w_down = (const float*)args.in[15];
    const float* ple_gain = (const float*)args.in[16]; const float* w_pg = (const float*)args.in[17]; const float* w_pp = (const float*)args.in[18];
    float* out = args.out;
    u64* stat = (u64*)(ws + WS_STAT); float* lbt = (float*)(ws + WS_LBT); float* cs = (float*)(ws + WS_CS);
    bf16_t* PBF = (bf16_t*)(ws + WS_PBF); bf16_t* HA = (bf16_t*)(ws + WS_HA); float* tmpO = (float*)(ws + WS_HA);
    bf16_t* QH = (bf16_t*)(ws + WS_QH); bf16_t* Kb = (bf16_t*)(ws + WS_K); bf16_t* Vb = (bf16_t*)(ws + WS_V); float* Gb = (float*)(ws + WS_G);
    bf16_t* KIN = (bf16_t*)(ws + WS_KIN); bf16_t* HI = (bf16_t*)(ws + WS_HI); bf16_t* HG = (bf16_t*)(ws + WS_HG);
    bf16_t* SBuf = (bf16_t*)(ws + WS_HA); float* DEC = (float*)(ws + WS_DEC);
    bf16_t* Mb = (bf16_t*)(ws + WS_M); bf16_t* ACT = (bf16_t*)(ws + WS_ACT); bf16_t* Fb = (bf16_t*)(ws + WS_F); bf16_t* PP = (bf16_t*)(ws + WS_PP);

    volatile LAS unsigned* xst = (volatile LAS unsigned*)(lds + 131072 + 64);
    unsigned* barw = (unsigned*)(ws + WS_BAR);
    if (threadIdx.x < 2) xst[threadIdx.x] = 0u;
    if (bx == 0) for (int i = threadIdx.x; i < 3456; i += NTHR) barw[i] = 0u;
    __syncthreads();
    {
        PHASE_IDS();
        LAS float* scr = (LAS float*)(lds + wave * 16384);
        constexpr int I_IN = 32 * 176, I_OUT = 32 * 64, I_G = 32 * 176, I_D = 88 * 64, I_PG = 32 * 64, I_PP = 4 * 64;
        constexpr int I_L = I_IN + I_OUT + 2 * I_G + I_D + I_PG + I_PP;
        for (int it = gw; it < DEPTH * I_L; it += ngw) {
            const int l = it / I_L; int r = it % I_L;
            unsigned char* wl = ws + WS_W + (size_t)l * WL_SIZE;
            if (r < I_IN) {
                const int kb = r / 176, nb = r % 176, n0 = nb * 32, pn = n0 >> 8; int prow0 = n0;
                if (pn <= 4) { const int lc = n0 & 255; prow0 = (pn << 8) + 128 * ((lc >> 5) & 1) + 32 * ((lc >> 6) & 3); }
                tr_item(w_in + (size_t)l * DM * DIN, DIN, DM, kb * 64, n0, (bf16_t*)(wl + WL_IN), prow0, pre_mix + l * DM, scr, lane); continue; }
            r -= I_IN;
            if (r < I_OUT) {
                const int kb = r / 64, nb = r % 64; const int k0 = kb * 64;
                const float* gp = (k0 < 1024) ? (attn_gain + l * 1024) : (hgrn_gain + l * 1024 - 1024);
                tr_item(w_out + (size_t)l * DM * DM, DM, DM, k0, nb * 32, (bf16_t*)(wl + WL_OUT), nb * 32, gp, scr, lane); continue; }
            r -= I_OUT;
            if (r < 2 * I_G) {
                const int up = r >= I_G; if (up) r -= I_G;
                const int kb = r / 176, nb = r % 176, n0 = nb * 32; const int prow0 = 256 * (n0 >> 7) + (n0 & 127) + (up ? 128 : 0);
                tr_item((up ? w_up : w_gate) + (size_t)l * DM * DFF, DFF, DM, kb * 64, n0, (bf16_t*)(wl + WL_GU), prow0, pre_ffn + l * DM, scr, lane); continue; }
            r -= 2 * I_G;
            if (r < I_D) { const int kb = r / 64, nb = r % 64;
                tr_item(w_down + (size_t)l * DFF * DM, DM, DFF, kb * 64, nb * 32, (bf16_t*)(wl + WL_DOWN), nb * 32, nullptr, scr, lane); continue; }
            r -= I_D;
            if (r < I_PG) { const int kb = r / 64, nb = r % 64;
                tr_item(w_pg + (size_t)l * DM * DM, DM, DM, kb * 64, nb * 32, (bf16_t*)(wl + WL_PG), nb * 32, ple_gain + l * DM, scr, lane); continue; }
            r -= I_PG;
            { const int kb = r / 64, nb = r % 64;
                tr_item(w_pp + (size_t)l * DPLE * DM, DM, DPLE, kb * 64, nb * 32, (bf16_t*)(wl + WL_PP), nb * 32, nullptr, scr, lane); }
        }
        for (int i = gtid; i < 11 * T; i += nthr) stat[T + i] = 0ull;
        for (int i = gtid; i < 1024; i += nthr) {
            const float l0 = lb_logits[i], l1 = lb_logits[1024 + i];
            lbt[i] = 0.f; lbt[1024 + i] = 1.0f / (1.0f + expf(l0 - l1));
        }
        for (int i = gtid; i < T * 32; i += nthr) {
            const int row = i >> 5, d = i & 31;
            const double rev = (double)pos[row] * c_invf[d] * 0.15915494309189535;
            const float fr = (float)(rev - rint(rev));
            cs[(size_t)row * 64 + d] = __builtin_amdgcn_cosf(fr); cs[(size_t)row * 64 + 32 + d] = __builtin_amdgcn_sinf(fr);
        }
        for (int i = gtid; i < DEPTH * T * DPLE / 8; i += nthr) {
            const f32x4 a = *(const f32x4*)(p_in + (size_t)i * 8), b = *(const f32x4*)(p_in + (size_t)i * 8 + 4);
            u32x4 w; w.x = pk2(a[0], a[1]); w.y = pk2(a[2], a[3]); w.z = pk2(b[0], b[1]); w.w = pk2(b[2], b[3]);
            *(u32x4*)(PBF + (size_t)i * 8) = w;
        }
    }
    { PHASE_IDS();
    for (int row = gw; row < T; row += ngw) {
        float ss = 0.f;
#pragma unroll
        for (int j = 0; j < 4; ++j) {
            const int c = j * 512 + lane * 8; const size_t off = (size_t)row * 2048 + c;
            const f32x4 x0 = *(const f32x4*)(x_in + off), x1 = *(const f32x4*)(x_in + off + 4);
            u32x4 w; w.x = pk2(x0[0], x0[1]); w.y = pk2(x0[2], x0[3]); w.z = pk2(x1[0], x1[1]); w.w = pk2(x1[2], x1[3]);
            *(u32x4*)(HA + off) = w;
            ss += (x0[0] * x0[0] + x0[1] * x0[1]) + (x0[2] * x0[2] + x0[3] * x0[3]) + (x1[0] * x1[0] + x1[1] * x1[1]) + (x1[2] * x1[2] + x1[3] * x1[3]);
        }
        ss = wave_sum(ss, lane);
        if (lane == 0) stat[(SQ_X + 0) * T + row] = fx_enc(ss);
    } }
    grid.sync();
    const XcdBarrier xbar = xcd_barrier_post(barw, xst);
#define GSYNC() xcd_barrier(xbar)

    for (int l = 0; l < DEPTH; ++l) {
        unsigned char* wl = ws + WS_W + (size_t)l * WL_SIZE;
        u64* ssqX = stat + (SQ_X + l) * T; u64* ssqA = stat + (SQ_A + l) * T; u64* ssqM = stat + (SQ_M + l) * T;
        u64* ssq2 = stat + (SQ_2 + l) * T; u64* ssqF = stat + (SQ_F + l) * T; u64* ssq3 = stat + (SQ_3 + l) * T;
        {
            PHASE_IDS(); pg8::Gemm g{l == 0 ? HA : (const bf16_t*)(ws + WS_W + (size_t)(l - 1) * WL_SIZE), (const bf16_t*)(wl + WL_IN), T, DIN, DM}; pg8::StaticOrder S; S.init(T, DIN, G, bx);
            EpiIn E{0, ssqX, cs, lbt + l * 1024, QH, Kb, Vb, Gb, KIN, HI, HG};
            if (PH & 1) pg8::gemm_phase<EpiIn, pg8::StaticOrder, true, true>(lds, g, S, E, tid);
        }
        GSYNC();
#if !NAIVE_MIX
        { PHASE_IDS();
          for (int u = bx; u < 512; u += G) attn_unit(lds, QH, Kb, Vb, sinks + l * 16, ssqA, u, tid, lane, wave);
          for (int u = bx; u < 2048; u += G) hgrn_h1_unit(lds, KIN, Gb, HI, SBuf, DEC, u, tid, lane, wave); }
        GSYNC();
        { PHASE_IDS(); hgrn_scan(SBuf, DEC, gtid, nthr); }
        GSYNC();
        { PHASE_IDS();
          for (int u = bx; u < 2048; u += G) hgrn_h3_unit(lds, QH, KIN, Gb, HI, HG, SBuf, u, tid, lane, wave); }
        GSYNC();
#else
        { PHASE_IDS();
        if (bx < 64 && wave == 0) hgrn_naive(QH, KIN, Gb, HI, tmpO, bx, lane);
        attn_naive(QH, Kb, Vb, sinks + l * 16, ssqA, gtid, nthr); }
        GSYNC();
        { PHASE_IDS(); hgrn_norm_naive(tmpO, HG, QH, gw, ngw, lane); }
        GSYNC();
#endif
        {
            PHASE_IDS(); pg8::Gemm g{QH, (const bf16_t*)(wl + WL_OUT), T, DM, DM}; pg8::StaticOrder S; S.init(T, DM, G, bx);
            EpiRowSsq<true> E{16, Mb, ssqM, ssqA};
            if (PH & 2) pg8::gemm_phase<EpiRowSsq<true>, pg8::StaticOrder, true, true>(lds, g, S, E, tid);
        }
        GSYNC();
        { PHASE_IDS();
          if (l == 0) row_phase<true>(x_in, nullptr, Mb, ssqM, post_mix + l * DM, HA, ssq2, gw, ngw, lane);
          else row_phase<false>(nullptr, (const bf16_t*)(ws + WS_W + (size_t)(l - 1) * WL_SIZE), Mb, ssqM, post_mix + l * DM, HA, ssq2, gw, ngw, lane); }
        GSYNC();
        {
            PHASE_IDS(); pg8::Gemm g{HA, (const bf16_t*)(wl + WL_GU), T, 2 * DFF, DM}; pg8::StaticOrder S; S.init(T, 2 * DFF, G, bx);
            EpiGU E{0, ssq2, ACT};
            if (PH & 4) pg8::gemm_phase<EpiGU, pg8::StaticOrder, true, true>(lds, g, S, E, tid);
        }
        GSYNC();
        {
            PHASE_IDS(); pg8::Gemm g{ACT, (const bf16_t*)(wl + WL_DOWN), T, DM, DFF}; pg8::StaticOrder S; S.init(T, DM, G, bx);
            EpiRowSsq<false> E{0, Fb, ssqF, nullptr};
            if (PH & 8) pg8::gemm_phase<EpiRowSsq<false>, pg8::StaticOrder, true, true>(lds, g, S, E, tid);
        }
        GSYNC();
        { PHASE_IDS(); row_phase<false>(nullptr, HA, Fb, ssqF, post_ffn + l * DM, HA, ssq3, gw, ngw, lane); }
        GSYNC();
        {
            PHASE_IDS(); int kpp = DPLE; asm volatile("" : "+s"(kpp)); pg8::Gemm g{PBF + (size_t)l * T * DPLE, (const bf16_t*)(wl + WL_PP), T, DM, kpp}; pg8::StaticOrder S; S.init(T, DM, G, bx);
            EpiPlain E{0, PP};
            if (PH & 16) pg8::gemm_phase<EpiPlain, pg8::StaticOrder, true, true>(lds, g, S, E, tid);
        }
        {
            PHASE_IDS(); pg8::Gemm g{HA, (const bf16_t*)(wl + WL_PG), T, DM, DM}; pg8::StaticOrder S; S.init(T, DM, G, bx);
            EpiPle E{0, ssq3, PP, HA, out, (bf16_t*)wl, stat + (SQ_X + (l + 1 < DEPTH ? l + 1 : 0)) * T, l + 1 < DEPTH ? 1 : 0};
            if (PH & 32) pg8::gemm_phase<EpiPle, pg8::StaticOrder, true, true>(lds, g, S, E, tid);
        }
        if (l + 1 < DEPTH) GSYNC();
    }
}

extern "C" void kernel_launch(void* const* d_in, const int* in_sizes, int n_in, void* d_out, int out_size, void* d_ws, size_t ws_size, hipStream_t stream) {
    static int grid = 0;
    if (grid == 0) {
        if (n_in != 19 || out_size != T * DM || ws_size < WS_END) { fprintf(stderr, "kernel_launch: unexpected shapes (n_in %d out %d ws %zu need %zu)\n", n_in, out_size, ws_size, (size_t)WS_END); grid = -1; return; }
        int dev = 0, cus = 0, per_cu = 0;
        hipGetDevice(&dev);
        hipDeviceGetAttribute(&cus, hipDeviceAttributeMultiprocessorCount, dev);
        if (hipFuncSetAttribute((const void*)fwd_megakernel, hipFuncAttributeMaxDynamicSharedMemorySize, LDS_BYTES) != hipSuccess) { fprintf(stderr, "kernel_launch: hipFuncSetAttribute failed\n"); grid = -1; return; }
        if (hipOccupancyMaxActiveBlocksPerMultiprocessor(&per_cu, (const void*)fwd_megakernel, NTHR, LDS_BYTES) != hipSuccess || per_cu < 1) { fprintf(stderr, "kernel_launch: occupancy query gave %d\n", per_cu); per_cu = 1; }
        (void)hipGetLastError();
        grid = cus * per_cu;
    }
    if (grid < 0) return;
    Args a{};
    for (int i = 0; i < 19; ++i) a.in[i] = d_in[i];
    a.out = (float*)d_out; a.ws = (unsigned char*)d_ws;
    void* kargs[] = {&a};
    hipError_t e = hipLaunchCooperativeKernel((const void*)fwd_megakernel, dim3(grid), dim3(NTHR), kargs, LDS_BYTES, stream);
    if (e != hipSuccess) fprintf(stderr, "cooperative launch failed: %s (grid %d)\n", hipGetErrorString(e), grid);
}
```

```cpp
#include <hip/hip_runtime.h>
#include <hip/hip_cooperative_groups.h>
#include <cstdio>
#include <cstdint>
namespace cg = cooperative_groups;

#ifndef PH
#define PH 63
#endif
#ifndef NAIVE_MIX
#define NAIVE_MIX 0
#endif

namespace pg8 {
#define PG8_LAS __attribute__((address_space(3)))
typedef unsigned short bf16_t;
typedef short bf16x8 __attribute__((ext_vector_type(8)));
typedef float f32x4 __attribute__((ext_vector_type(4)));
typedef unsigned u32x4 __attribute__((ext_vector_type(4)));
constexpr int BM = 256, BK = 64, HALF = 128, HTB = HALF * BK * 2, STAGE_BYTES = 8 * HTB, NXCD = 8, WGM = 8;

__host__ __device__ __forceinline__ int lds_byte(int r, int c) { const int st = (r >> 4) * 2 + (c >> 5), rr = r & 15, cc = c & 31, ob = rr * 64 + cc * 2; return st * 1024 + (ob ^ (((ob >> 9) & 1) << 5)); }
__host__ __device__ __forceinline__ void stage_rc(int b, int& R, int& C) { const int st = b / 1024, sb = b % 1024, swz = sb ^ (((sb >> 9) & 1) << 5); R = (st >> 1) * 16 + swz / 64; C = (st & 1) * 32 + (swz % 64) / 2; }
__host__ __device__ __forceinline__ int perm32(int rho) { const int n = rho >> 4, i = rho & 15; return 8 * (i >> 2) + 4 * n + (i & 3); }

struct Unit { int pm, pn; };
struct Gemm { const bf16_t* A; const bf16_t* Bt; int M, N, K; };

struct StaticOrder {
    int nM, nN, nwg, G, c;
    __host__ __device__ void init(int M, int N, int G_, int c_) { nM = M / BM; nN = N / BM; nwg = nM * nN; G = G_; c = c_; }
    __host__ __device__ bool next(int i, Unit& u) const {
        const long L = (long)i * G + c; if (L >= nwg) return false;
        int wgid = (int)L; { const int q = nwg / NXCD, r = nwg % NXCD, xcd = wgid % NXCD, off = wgid / NXCD; wgid = (xcd < r ? xcd * (q + 1) : r * (q + 1) + (xcd - r) * q) + off; }
        const int nig = WGM * nN, gid = wgid / nig, fm = gid * WGM, gsz = (nM - fm) < WGM ? (nM - fm) : WGM;
        u.pm = fm + ((wgid % nig) % gsz); u.pn = (wgid % nig) / gsz; return true;
    }
    __device__ __forceinline__ void a_ready(const Unit&) const {}
    __device__ __forceinline__ void done(const Unit&) const {}
};

__device__ __forceinline__ unsigned cvt_pk_bf16(float lo, float hi) { unsigned r; asm volatile("v_cvt_pk_bf16_f32 %0, %1, %2" : "=v"(r) : "v"(lo), "v"(hi)); return r; }

template <class Epi, class Sched, bool ALIGN_EPI = false, bool SP2 = false>
__device__ __forceinline__ void gemm_phase(PG8_LAS unsigned char* lds, const Gemm g, const Sched& S, const Epi& E, int tid_in) {
    int tid_ = tid_in; asm volatile("" : "+v"(tid_));
    const int tid = tid_, wid = __builtin_amdgcn_readfirstlane(tid >> 6), lane = tid & 63, wr = wid >> 2, wc = wid & 3, fr = lane & 15, fq = lane >> 4;
    const int K = g.K, nt = K / BK;
    unsigned voffA[2], voffB[2];
#pragma unroll
    for (int i = 0; i < 2; ++i) { int R, C; stage_rc(tid * 16 + i * 8192, R, C); const int Rb = Epi::PERM ? ((R & ~31) + perm32(R & 31)) : R;
        voffA[i] = (unsigned)(R * K + C) * 2u; voffB[i] = (unsigned)(Rb * K + C) * 2u; }
    const size_t kstep = (size_t)(BK * 2);
    const size_t hstep = (size_t)HALF * K * 2;
    const size_t tstep = 2 * hstep;
    const unsigned ldsw = (unsigned)wid * 1024u;
    const int aoff = lds_byte(wr * 64 + fr, fq * 8), boff = lds_byte(wc * 32 + fr, fq * 8);
#define PG8_SA(b, h) (((b) * 2 + (h)) * HTB)
#define PG8_SB(b, h) ((4 + (b) * 2 + (h)) * HTB)
#define PG8_STAGE(bufoff, gbase, voff) do { _Pragma("unroll") for (int _i = 0; _i < 2; ++_i) \
        __builtin_amdgcn_global_load_lds((const unsigned*)((const char*)(gbase) + (voff)[_i]), (PG8_LAS unsigned*)(lds + (bufoff) + ldsw + _i * 8192), 16, 0, 0); } while (0)
#define PG8_LDA(dst, b, h) do { _Pragma("unroll") for (int m = 0; m < 4; ++m) _Pragma("unroll") for (int k = 0; k < 2; ++k) dst[m][k] = *(const PG8_LAS bf16x8*)(lds + PG8_SA(b, h) + aoff + m * 2048 + k * 1024); } while (0)
#define PG8_LDB(dst, b, h) do { _Pragma("unroll") for (int n = 0; n < 2; ++n) _Pragma("unroll") for (int k = 0; k < 2; ++k) dst[n][k] = *(const PG8_LAS bf16x8*)(lds + PG8_SB(b, h) + boff + n * 2048 + k * 1024); } while (0)
#define PG8_MMA(ai, bj, At, Bt) do { __builtin_amdgcn_s_setprio(1); _Pragma("unroll") for (int m = 0; m < 4; ++m) _Pragma("unroll") for (int n = 0; n < 2; ++n) _Pragma("unroll") for (int k = 0; k < 2; ++k) \
        acc[ai][bj][m][n] = __builtin_amdgcn_mfma_f32_16x16x32_bf16(Bt[n][k], At[m][k], acc[ai][bj][m][n], 0, 0, 0); __builtin_amdgcn_s_setprio(0); } while (0)
#define PG8_WAIT_V(n) asm volatile("s_waitcnt vmcnt(" #n ")" ::: "memory")
#define PG8_WAIT_L(n) asm volatile("s_waitcnt lgkmcnt(" #n ")" ::: "memory")
#define PG8_BAR __builtin_amdgcn_s_barrier()
#define PG8_SCHED __builtin_amdgcn_sched_barrier(0)
    Unit cur, nxt; int ui = 0;
    if (!S.next(0, cur)) return;
    f32x4 acc[2][2][4][2];
#pragma unroll
    for (int a = 0; a < 2; ++a)
#pragma unroll
        for (int b = 0; b < 2; ++b)
#pragma unroll
            for (int m = 0; m < 4; ++m)
#pragma unroll
                for (int n = 0; n < 2; ++n) acc[a][b][m][n] = (f32x4){0.f, 0.f, 0.f, 0.f};
    bf16x8 At[4][2], B0[2][2], B1[2][2];
    const char* cA = (const char*)g.A + (size_t)cur.pm * tstep; const char* cB = (const char*)g.Bt + (size_t)cur.pn * tstep;
    S.a_ready(cur);
    if constexpr (SP2) {
        PG8_STAGE(PG8_SB(0, 0), cB, voffB); PG8_STAGE(PG8_SB(0, 1), cB + hstep, voffB); PG8_STAGE(PG8_SA(0, 0), cA, voffA); PG8_STAGE(PG8_SA(0, 1), cA + hstep, voffA);
        if (wr == 1) PG8_BAR;
        PG8_WAIT_V(2); PG8_BAR;
        PG8_STAGE(PG8_SB(1, 0), cB + kstep, voffB); PG8_STAGE(PG8_SA(1, 0), cA + kstep, voffA); PG8_STAGE(PG8_SB(1, 1), cB + hstep + kstep, voffB);
        PG8_WAIT_V(6); PG8_BAR;
    } else {
        PG8_STAGE(PG8_SB(0, 0), cB, voffB); PG8_STAGE(PG8_SA(0, 0), cA, voffA); PG8_STAGE(PG8_SB(0, 1), cB + hstep, voffB); PG8_STAGE(PG8_SA(0, 1), cA + hstep, voffA);
        if (wr == 1) PG8_BAR;
        PG8_WAIT_V(4); PG8_BAR;
        PG8_STAGE(PG8_SB(1, 0), cB + kstep, voffB); PG8_STAGE(PG8_SA(1, 0), cA + kstep, voffA); PG8_STAGE(PG8_SB(1, 1), cB + hstep + kstep, voffB);
        PG8_WAIT_V(6); PG8_BAR;
    }
    for (;;) {
        const bool has_next = S.next(ui + 1, nxt);
        const char* nA = has_next ? (const char*)g.A + (size_t)nxt.pm * tstep : cA; const char* nB = has_next ? (const char*)g.Bt + (size_t)nxt.pn * tstep : cB;
        for (int t = 0; t < nt; t += 2) {
            const bool last = (t == nt - 2);
            const char* a1 = cA + (size_t)(t + 1) * kstep;
            const char* a2 = last ? nA : cA + (size_t)(t + 2) * kstep; const char* b2 = last ? nB : cB + (size_t)(t + 2) * kstep;
            const char* a3 = a2 + kstep; const char* b3 = b2 + kstep;
            if (last && has_next) S.a_ready(nxt);
            if constexpr (Epi::MID) { if (t == E.kmid) { int l2 = lane; asm volatile("" : "+v"(l2)); E.mid(acc, cur, wr, wc, l2 & 15, l2 >> 4); } }
            if constexpr (SP2) {
            PG8_LDB(B0, 0, 0); PG8_LDB(B1, 0, 1); PG8_SCHED; PG8_LDA(At, 0, 0); PG8_STAGE(PG8_SA(1, 1), a1 + hstep, voffA);
            PG8_WAIT_V(8); PG8_WAIT_L(0); PG8_BAR; PG8_MMA(0, 0, At, B0); PG8_MMA(0, 1, At, B1); PG8_BAR; PG8_SCHED;
            PG8_LDA(At, 0, 1); PG8_STAGE(PG8_SB(0, 0), b2, voffB); PG8_STAGE(PG8_SB(0, 1), b2 + hstep, voffB); PG8_STAGE(PG8_SA(0, 0), a2, voffA);
            PG8_WAIT_V(8); PG8_WAIT_L(0); PG8_BAR; PG8_MMA(1, 0, At, B0); PG8_MMA(1, 1, At, B1); PG8_BAR; PG8_SCHED;
            PG8_LDB(B0, 1, 0); PG8_LDB(B1, 1, 1); PG8_SCHED; PG8_LDA(At, 1, 0); PG8_STAGE(PG8_SA(0, 1), a2 + hstep, voffA);
            PG8_WAIT_V(8); PG8_WAIT_L(0); PG8_BAR; PG8_MMA(0, 0, At, B0); PG8_MMA(0, 1, At, B1); PG8_BAR; PG8_SCHED;
            PG8_LDA(At, 1, 1); PG8_STAGE(PG8_SB(1, 0), b3, voffB); PG8_STAGE(PG8_SB(1, 1), b3 + hstep, voffB); PG8_STAGE(PG8_SA(1, 0), a3, voffA);
            PG8_WAIT_V(8); PG8_WAIT_L(0); PG8_BAR; PG8_MMA(1, 0, At, B0); PG8_MMA(1, 1, At, B1); PG8_BAR; PG8_SCHED;
            } else {
            PG8_LDB(B0, 0, 0); PG8_SCHED; PG8_LDA(At, 0, 0); PG8_STAGE(PG8_SA(1, 1), a1 + hstep, voffA);
            PG8_WAIT_L(8); PG8_BAR; PG8_WAIT_L(0); PG8_MMA(0, 0, At, B0); PG8_BAR; PG8_SCHED;
            PG8_LDB(B1, 0, 1); PG8_STAGE(PG8_SB(0, 0), b2, voffB);
            PG8_BAR; PG8_WAIT_L(0); PG8_MMA(0, 1, At, B1); PG8_BAR;
            PG8_LDA(At, 0, 1); PG8_STAGE(PG8_SA(0, 0), a2, voffA);
            PG8_BAR; PG8_WAIT_L(0); PG8_MMA(1, 0, At, B0); PG8_BAR; PG8_SCHED;
            PG8_STAGE(PG8_SB(0, 1), b2 + hstep, voffB);
            PG8_WAIT_V(6); PG8_BAR; PG8_MMA(1, 1, At, B1); PG8_BAR;
            PG8_LDB(B0, 1, 0); PG8_SCHED; PG8_LDA(At, 1, 0); PG8_STAGE(PG8_SA(0, 1), a2 + hstep, voffA);
            PG8_WAIT_L(8); PG8_BAR; PG8_WAIT_L(0); PG8_MMA(0, 0, At, B0); PG8_BAR; PG8_SCHED;
            PG8_LDB(B1, 1, 1); PG8_STAGE(PG8_SB(1, 0), b3, voffB);
            PG8_BAR; PG8_WAIT_L(0); PG8_MMA(0, 1, At, B1); PG8_BAR;
            PG8_LDA(At, 1, 1); PG8_STAGE(PG8_SA(1, 0), a3, voffA);
            PG8_BAR; PG8_WAIT_L(0); PG8_MMA(1, 0, At, B0); PG8_BAR; PG8_SCHED;
            PG8_STAGE(PG8_SB(1, 1), b3 + hstep, voffB);
            PG8_WAIT_V(6); PG8_BAR; PG8_MMA(1, 1, At, B1); PG8_BAR;
            }
        }
        if constexpr (ALIGN_EPI) { if (wr == 0) PG8_BAR; }
        { int l2 = lane; asm volatile("" : "+v"(l2)); E(acc, cur, wr, wc, l2 & 15, l2 >> 4); }
        if (!has_next) break;
#pragma unroll
        for (int a = 0; a < 2; ++a)
#pragma unroll
            for (int b = 0; b < 2; ++b)
#pragma unroll
                for (int m = 0; m < 4; ++m)
#pragma unroll
                    for (int n = 0; n < 2; ++n) acc[a][b][m][n] = (f32x4){0.f, 0.f, 0.f, 0.f};
        cur = nxt; cA = nA; cB = nB; ++ui;
        if constexpr (ALIGN_EPI) { if (wr == 1) PG8_BAR; }
    }
    PG8_WAIT_V(0);
    if constexpr (!ALIGN_EPI) { if (wr == 0) PG8_BAR; }
    PG8_BAR;
#undef PG8_SA
#undef PG8_SB
#undef PG8_STAGE
#undef PG8_LDA
#undef PG8_LDB
#undef PG8_MMA
#undef PG8_WAIT_V
#undef PG8_WAIT_L
#undef PG8_BAR
#undef PG8_SCHED
}
}

using pg8::bf16_t; using pg8::f32x4; using pg8::u32x4; using pg8::Unit; using pg8::cvt_pk_bf16;
#define LAS __attribute__((address_space(3)))
constexpr int NB = 4, SEQ = 4096, T = NB * SEQ, DM = 2048, DIN = 5632, DFF = 5632, DPLE = 256, DEPTH = 2;
constexpr float EPS = 1e-6f;
constexpr float LOG2E = 1.4426950408889634f;
constexpr float QSCALE = 0.125f * LOG2E;
constexpr int NWAVES = 8, NTHR = 512;
constexpr int LDS_BYTES = 147456;

constexpr size_t MiB = 1u << 20;
constexpr size_t WS_STAT = 0;
constexpr size_t WS_LBT = 1536 * 1024;
constexpr size_t WS_BAR = 1600 * 1024;
constexpr size_t WS_CS = 2 * MiB;
constexpr size_t WS_W = 6 * MiB;
constexpr size_t WL_IN = 0, WL_OUT = 22 * MiB, WL_GU = 30 * MiB, WL_DOWN = 74 * MiB, WL_PG = 96 * MiB, WL_PP = 104 * MiB, WL_SIZE = 105 * MiB;
constexpr size_t WS_PBF = 216 * MiB;
constexpr size_t WS_HA = 232 * MiB;
constexpr size_t WS_R = 296 * MiB;
constexpr size_t WS_QH = WS_R, WS_K = WS_R + 64 * MiB, WS_V = WS_R + 72 * MiB, WS_G = WS_R + 80 * MiB, WS_KIN = WS_R + 144 * MiB, WS_HI = WS_R + 176 * MiB, WS_HG = WS_R + 208 * MiB;
constexpr size_t WS_M = WS_G, WS_ACT = WS_R, WS_F = WS_R + 176 * MiB, WS_PP = WS_R;
constexpr size_t WS_DEC = WS_R + 240 * MiB;
constexpr size_t WS_END = WS_DEC + 1 * MiB;
enum { SQ_X = 0, SQ_A = 2, SQ_M = 4, SQ_2 = 6, SQ_F = 8, SQ_3 = 10 };

__constant__ double c_invf[32] = {1.0, 0.7498942093324559, 0.5623413251903491, 0.4216965034285822, 0.31622776601683794, 0.23713737056616552, 0.1778279410038923, 0.1333521432163324, 0.09999999999999999, 0.07498942093324558, 0.056234132519034905, 0.042169650342858224, 0.03162277660168379, 0.023713737056616554, 0.01778279410038923, 0.013335214321633239, 0.01, 0.007498942093324559, 0.005623413251903491, 0.004216965034285822, 0.0031622776601683794, 0.002371373705661655, 0.0017782794100389228, 0.0013335214321633238, 0.001, 0.0007498942093324559, 0.000562341325190349, 0.00042169650342858224, 0.00031622776601683794, 0.00023713737056616554, 0.0001778279410038923, 0.0001333521432163324};

__device__ __forceinline__ float bf2f(unsigned h) { return __uint_as_float(h << 16); }
__device__ __forceinline__ float bflo(unsigned w) { return __uint_as_float(w << 16); }
__device__ __forceinline__ float bfhi(unsigned w) { return __uint_as_float(w & 0xffff0000u); }
__device__ __forceinline__ unsigned f2bf(float f) { unsigned u = __float_as_uint(f); return (u + 0x7fffu + ((u >> 16) & 1u)) >> 16; }
__device__ __forceinline__ unsigned pk2(float lo, float hi) { return f2bf(lo) | (f2bf(hi) << 16); }
__device__ __forceinline__ float shx(float v, int lane, int m) { return __int_as_float(__builtin_amdgcn_ds_bpermute((lane ^ m) << 2, __float_as_int(v))); }
__device__ __forceinline__ float wave_sum(float v, int lane) {
#pragma unroll
    for (int o = 1; o < 64; o <<= 1) v += shx(v, lane, o);
    return v;
}
typedef unsigned long long u64;
__device__ __forceinline__ u64 fx_enc(float q) { return (u64)__float2ll_rn(q * 16777216.0f); }
__device__ __forceinline__ float fx_dec(u64 v) { return __ll2float_rn((long long)v) * (1.0f / 16777216.0f); }
__device__ __forceinline__ void fx_add(u64* p, float q) { atomicAdd(p, fx_enc(q)); }
__device__ __forceinline__ float sigmoidf_(float z) { return 1.0f / (1.0f + __expf(-z)); }
__device__ __forceinline__ float siluf_(float z) { return z / (1.0f + __expf(-z)); }

struct EpiIn {
    static constexpr bool PERM = true, MID = false;
    int kmid;
    const u64* ssqX; const float* cs; const float* lb;
    bf16_t* QH; bf16_t* Kb; bf16_t* Vb; float* G; bf16_t* KIN; bf16_t* HI; bf16_t* HG;
    __device__ __forceinline__ void mid(f32x4 (&acc)[2][2][4][2], const Unit& u, int wr, int wc, int fr, int fq) const {}
    __device__ __forceinline__ void operator()(const f32x4 (&acc)[2][2][4][2], const Unit& u, int wr, int wc, int fr, int fq) const {
        const int pn = u.pn;
#pragma unroll
        for (int ai = 0; ai < 2; ++ai)
#pragma unroll
            for (int m = 0; m < 4; ++m) {
                const int row = u.pm * 256 + ai * 128 + wr * 64 + m * 16 + fr;
                const float rs = rsqrtf(fx_dec(ssqX[row]) * (1.0f / DM) + EPS);
                if (pn <= 4) {
                    const int d0 = 8 * fq;
                    const f32x4 c0 = *(const f32x4*)(cs + (size_t)row * 64 + d0), c1 = *(const f32x4*)(cs + (size_t)row * 64 + d0 + 4);
                    const f32x4 s0 = *(const f32x4*)(cs + (size_t)row * 64 + 32 + d0), s1 = *(const f32x4*)(cs + (size_t)row * 64 + 32 + d0 + 4);
                    const float sc = (pn < 4) ? rs * QSCALE : rs;
                    const f32x4 a0 = acc[ai][0][m][0] * sc, a1 = acc[ai][0][m][1] * sc, b0 = acc[ai][1][m][0] * sc, b1 = acc[ai][1][m][1] * sc;
                    const f32x4 o10 = a0 * c0 - b0 * s0, o11 = a1 * c1 - b1 * s1, o20 = b0 * c0 + a0 * s0, o21 = b1 * c1 + a1 * s1;
                    u32x4 w1, w2;
                    w1.x = cvt_pk_bf16(o10[0], o10[1]); w1.y = cvt_pk_bf16(o10[2], o10[3]); w1.z = cvt_pk_bf16(o11[0], o11[1]); w1.w = cvt_pk_bf16(o11[2], o11[3]);
                    w2.x = cvt_pk_bf16(o20[0], o20[1]); w2.y = cvt_pk_bf16(o20[2], o20[3]); w2.z = cvt_pk_bf16(o21[0], o21[1]); w2.w = cvt_pk_bf16(o21[2], o21[3]);
                    bf16_t* dst = (pn < 4) ? (QH + (size_t)row * 2048 + (pn * 4 + wc) * 64 + d0) : (Kb + (size_t)row * 256 + wc * 64 + d0);
                    *(u32x4*)dst = w1; *(u32x4*)(dst + 32) = w2;
                } else {
#pragma unroll
                    for (int bj = 0; bj < 2; ++bj) {
                        const int cl = bj * 128 + wc * 32 + 8 * fq;
                        f32x4 v0 = acc[ai][bj][m][0] * rs, v1 = acc[ai][bj][m][1] * rs;
                        if (pn == 5) {
                            u32x4 w; w.x = cvt_pk_bf16(v0[0], v0[1]); w.y = cvt_pk_bf16(v0[2], v0[3]); w.z = cvt_pk_bf16(v1[0], v1[1]); w.w = cvt_pk_bf16(v1[2], v1[3]);
                            *(u32x4*)(Vb + (size_t)row * 256 + cl) = w;
                        } else if (pn < 10) {
                            const int c = (pn - 6) * 256 + cl;
#pragma unroll
                            for (int j = 0; j < 4; ++j) { v0[j] = siluf_(v0[j]); v1[j] = siluf_(v1[j]); }
                            u32x4 w; w.x = cvt_pk_bf16(v0[0], v0[1]); w.y = cvt_pk_bf16(v0[2], v0[3]); w.z = cvt_pk_bf16(v1[0], v1[1]); w.w = cvt_pk_bf16(v1[2], v1[3]);
                            *(u32x4*)(QH + (size_t)row * 2048 + 1024 + c) = w;
                        } else if (pn < 14) {
                            const int c = (pn - 10) * 256 + cl;
                            const f32x4 l0 = *(const f32x4*)(lb + c), l1 = *(const f32x4*)(lb + c + 4);
                            f32x4 g0, g1, k0, k1;
#pragma unroll
                            for (int j = 0; j < 4; ++j) {
                                { const float z = fminf(fmaxf(v0[j], -30.f), 30.f), e = __expf(-z), sg = 1.0f / (1.0f + e), om = 1.0f - l0[j]; g0[j] = __logf(l0[j] + om * sg); k0[j] = om * e * sg; }
                                { const float z = fminf(fmaxf(v1[j], -30.f), 30.f), e = __expf(-z), sg = 1.0f / (1.0f + e), om = 1.0f - l1[j]; g1[j] = __logf(l1[j] + om * sg); k1[j] = om * e * sg; }
                            }
                            *(f32x4*)(G + (size_t)row * 1024 + c) = g0; *(f32x4*)(G + (size_t)row * 1024 + c + 4) = g1;
                            u32x4 w; w.x = cvt_pk_bf16(k0[0], k0[1]); w.y = cvt_pk_bf16(k0[2], k0[3]); w.z = cvt_pk_bf16(k1[0], k1[1]); w.w = cvt_pk_bf16(k1[2], k1[3]);
                            *(u32x4*)(KIN + (size_t)row * 1024 + c) = w;
                        } else if (pn < 18) {
                            const int c = (pn - 14) * 256 + cl;
                            u32x4 w; w.x = cvt_pk_bf16(v0[0], v0[1]); w.y = cvt_pk_bf16(v0[2], v0[3]); w.z = cvt_pk_bf16(v1[0], v1[1]); w.w = cvt_pk_bf16(v1[2], v1[3]);
                            *(u32x4*)(HI + (size_t)row * 1024 + c) = w;
                        } else {
                            const int c = (pn - 18) * 256 + cl;
#pragma unroll
                            for (int j = 0; j < 4; ++j) { v0[j] = siluf_(v0[j]); v1[j] = siluf_(v1[j]); }
                            u32x4 w; w.x = cvt_pk_bf16(v0[0], v0[1]); w.y = cvt_pk_bf16(v0[2], v0[3]); w.z = cvt_pk_bf16(v1[0], v1[1]); w.w = cvt_pk_bf16(v1[2], v1[3]);
                            *(u32x4*)(HG + (size_t)row * 1024 + c) = w;
                        }
                    }
                }
                asm volatile("" ::: "memory");
            }
    }
};

template <bool MIDS> struct EpiRowSsq {
    static constexpr bool PERM = true, MID = MIDS;
    int kmid;
    bf16_t* O; u64* ssq; const u64* ssqA;
    __device__ __forceinline__ void mid(f32x4 (&acc)[2][2][4][2], const Unit& u, int wr, int wc, int fr, int fq) const {
#pragma unroll
        for (int ai = 0; ai < 2; ++ai)
#pragma unroll
            for (int m = 0; m < 4; ++m) {
                const int row = u.pm * 256 + ai * 128 + wr * 64 + m * 16 + fr;
                const float s = rsqrtf(fx_dec(ssqA[row]) * (1.0f / 1024.0f) + EPS);
#pragma unroll
                for (int bj = 0; bj < 2; ++bj)
#pragma unroll
                    for (int n = 0; n < 2; ++n) acc[ai][bj][m][n] = acc[ai][bj][m][n] * s;
            }
    }
    __device__ __forceinline__ void operator()(const f32x4 (&acc)[2][2][4][2], const Unit& u, int wr, int wc, int fr, int fq) const {
#pragma unroll
        for (int ai = 0; ai < 2; ++ai)
#pragma unroll
            for (int m = 0; m < 4; ++m) {
                const int row = u.pm * 256 + ai * 128 + wr * 64 + m * 16 + fr;
                float q = 0.f;
#pragma unroll
                for (int bj = 0; bj < 2; ++bj) {
                    const f32x4 v0 = acc[ai][bj][m][0], v1 = acc[ai][bj][m][1];
                    q += (v0[0] * v0[0] + v0[1] * v0[1]) + (v0[2] * v0[2] + v0[3] * v0[3]) + (v1[0] * v1[0] + v1[1] * v1[1]) + (v1[2] * v1[2] + v1[3] * v1[3]);
                    u32x4 w; w.x = cvt_pk_bf16(v0[0], v0[1]); w.y = cvt_pk_bf16(v0[2], v0[3]); w.z = cvt_pk_bf16(v1[0], v1[1]); w.w = cvt_pk_bf16(v1[2], v1[3]);
                    *(u32x4*)(O + (size_t)row * 2048 + u.pn * 256 + bj * 128 + wc * 32 + 8 * fq) = w;
                }
                q += shx(q, fq * 16 + fr, 16); q += shx(q, fq * 16 + fr, 32);
                if (fq == 0) fx_add(ssq + row, q);
                asm volatile("" ::: "memory");
            }
    }
};

struct EpiGU {
    static constexpr bool PERM = true, MID = false;
    int kmid;
    const u64* ssq2; bf16_t* ACT;
    __device__ __forceinline__ void mid(f32x4 (&acc)[2][2][4][2], const Unit& u, int wr, int wc, int fr, int fq) const {}
    __device__ __forceinline__ void operator()(const f32x4 (&acc)[2][2][4][2], const Unit& u, int wr, int wc, int fr, int fq) const {
#pragma unroll
        for (int ai = 0; ai < 2; ++ai)
#pragma unroll
            for (int m = 0; m < 4; ++m) {
                const int row = u.pm * 256 + ai * 128 + wr * 64 + m * 16 + fr;
                const float rs = rsqrtf(fx_dec(ssq2[row]) * (1.0f / DM) + EPS);
                f32x4 o0, o1;
#pragma unroll
                for (int j = 0; j < 4; ++j) {
                    const float g0 = acc[ai][0][m][0][j] * rs, u0 = acc[ai][1][m][0][j] * rs, g1 = acc[ai][0][m][1][j] * rs, u1 = acc[ai][1][m][1][j] * rs;
                    o0[j] = siluf_(g0) * u0; o1[j] = siluf_(g1) * u1;
                }
                u32x4 w; w.x = cvt_pk_bf16(o0[0], o0[1]); w.y = cvt_pk_bf16(o0[2], o0[3]); w.z = cvt_pk_bf16(o1[0], o1[1]); w.w = cvt_pk_bf16(o1[2], o1[3]);
                *(u32x4*)(ACT + (size_t)row * DFF + u.pn * 128 + wc * 32 + 8 * fq) = w;
                asm volatile("" ::: "memory");
            }
    }
};

struct EpiPlain {
    static constexpr bool PERM = true, MID = false;
    int kmid;
    bf16_t* O;
    __device__ __forceinline__ void mid(f32x4 (&acc)[2][2][4][2], const Unit& u, int wr, int wc, int fr, int fq) const {}
    __device__ __forceinline__ void operator()(const f32x4 (&acc)[2][2][4][2], const Unit& u, int wr, int wc, int fr, int fq) const {
#pragma unroll
        for (int ai = 0; ai < 2; ++ai)
#pragma unroll
            for (int m = 0; m < 4; ++m) {
                const int row = u.pm * 256 + ai * 128 + wr * 64 + m * 16 + fr;
#pragma unroll
                for (int bj = 0; bj < 2; ++bj) {
                    const f32x4 v0 = acc[ai][bj][m][0], v1 = acc[ai][bj][m][1];
                    u32x4 w; w.x = cvt_pk_bf16(v0[0], v0[1]); w.y = cvt_pk_bf16(v0[2], v0[3]); w.z = cvt_pk_bf16(v1[0], v1[1]); w.w = cvt_pk_bf16(v1[2], v1[3]);
                    *(u32x4*)(O + (size_t)row * 2048 + u.pn * 256 + bj * 128 + wc * 32 + 8 * fq) = w;
                }
                asm volatile("" ::: "memory");
            }
    }
};

struct EpiPle {
    static constexpr bool PERM = true, MID = false;
    int kmid;
    const u64* ssq3; const bf16_t* PP; const bf16_t* XB; float* OUT; bf16_t* HAn; u64* ssqN; int has_next;
    __device__ __forceinline__ void mid(f32x4 (&acc)[2][2][4][2], const Unit& u, int wr, int wc, int fr, int fq) const {}
    __device__ __forceinline__ void operator()(const f32x4 (&acc)[2][2][4][2], const Unit& u, int wr, int wc, int fr, int fq) const {
#pragma unroll
        for (int ai = 0; ai < 2; ++ai)
#pragma unroll
            for (int m = 0; m < 4; ++m) {
                const int row = u.pm * 256 + ai * 128 + wr * 64 + m * 16 + fr;
                const float rs = rsqrtf(fx_dec(ssq3[row]) * (1.0f / DM) + EPS);
                float q = 0.f;
#pragma unroll
                for (int bj = 0; bj < 2; ++bj) {
                    const size_t off = (size_t)row * 2048 + u.pn * 256 + bj * 128 + wc * 32 + 8 * fq;
                    const u32x4 pw = *(const u32x4*)(PP + off); const u32x4 xv = *(const u32x4*)(XB + off);
                    f32x4 x0 = (f32x4){bflo(xv.x), bfhi(xv.x), bflo(xv.y), bfhi(xv.y)}, x1 = (f32x4){bflo(xv.z), bfhi(xv.z), bflo(xv.w), bfhi(xv.w)};
                    const f32x4 v0 = acc[ai][bj][m][0] * rs, v1 = acc[ai][bj][m][1] * rs;
                    x0[0] += bflo(pw.x) * sigmoidf_(v0[0]); x0[1] += bfhi(pw.x) * sigmoidf_(v0[1]); x0[2] += bflo(pw.y) * sigmoidf_(v0[2]); x0[3] += bfhi(pw.y) * sigmoidf_(v0[3]);
                    x1[0] += bflo(pw.z) * sigmoidf_(v1[0]); x1[1] += bfhi(pw.z) * sigmoidf_(v1[1]); x1[2] += bflo(pw.w) * sigmoidf_(v1[2]); x1[3] += bfhi(pw.w) * sigmoidf_(v1[3]);
                    if (has_next) {
                        q += (x0[0] * x0[0] + x0[1] * x0[1]) + (x0[2] * x0[2] + x0[3] * x0[3]) + (x1[0] * x1[0] + x1[1] * x1[1]) + (x1[2] * x1[2] + x1[3] * x1[3]);
                        u32x4 w; w.x = cvt_pk_bf16(x0[0], x0[1]); w.y = cvt_pk_bf16(x0[2], x0[3]); w.z = cvt_pk_bf16(x1[0], x1[1]); w.w = cvt_pk_bf16(x1[2], x1[3]);
                        *(u32x4*)(HAn + off) = w;
                    } else { *(f32x4*)(OUT + off) = x0; *(f32x4*)(OUT + off + 4) = x1; }
                }
                if (has_next) { q += shx(q, fq * 16 + fr, 16); q += shx(q, fq * 16 + fr, 32); if (fq == 0) fx_add(ssqN + row, q); }
                asm volatile("" ::: "memory");
            }
    }
};

__device__ __forceinline__ void tr_item(const float* W, int ldw, int K, int k0, int n0, bf16_t* WT, int prow0, const float* gain, LAS float* scr, int lane) {
    f32x4 v[8];
#pragma unroll
    for (int i = 0; i < 8; ++i) { const int kk = 8 * i + (lane >> 3); v[i] = *(const f32x4*)(W + (size_t)(k0 + kk) * ldw + n0 + 4 * (lane & 7)); }
#pragma unroll
    for (int i = 0; i < 8; ++i) { const int kk = 8 * i + (lane >> 3); const float gsc = gain ? gain[k0 + kk] : 1.0f; LAS float* d = scr + kk * 33 + 4 * (lane & 7);
        d[0] = v[i][0] * gsc; d[1] = v[i][1] * gsc; d[2] = v[i][2] * gsc; d[3] = v[i][3] * gsc; }
    asm volatile("s_waitcnt lgkmcnt(0)" ::: "memory");
    const int c = lane & 7;
#pragma unroll
    for (int j = 0; j < 4; ++j) { const int n = (lane >> 3) + 8 * j; const LAS float* s = scr + (8 * c) * 33 + n;
        u32x4 o; o.x = pk2(s[0 * 33], s[1 * 33]); o.y = pk2(s[2 * 33], s[3 * 33]); o.z = pk2(s[4 * 33], s[5 * 33]); o.w = pk2(s[6 * 33], s[7 * 33]);
        *(u32x4*)(WT + (size_t)(prow0 + n) * K + k0 + 8 * c) = o; }
    asm volatile("s_waitcnt lgkmcnt(0)" ::: "memory");
}

struct Args { const void* in[19]; float* out; unsigned char* ws; };

template <bool SRC_F32>
__device__ __forceinline__ void row_phase(const float* xsrc32, const bf16_t* xsrc16, const bf16_t* Mb, const u64* ssqIn, const float* gain, bf16_t* XB, u64* ssqOut, int gw, int ngw, int lane) {
    for (int row = gw; row < T; row += ngw) {
        const float rm = rsqrtf(fx_dec(ssqIn[row]) * (1.0f / DM) + EPS);
        float ss = 0.f;
#pragma unroll
        for (int j = 0; j < 4; ++j) {
            const int c = j * 512 + lane * 8; const size_t off = (size_t)row * 2048 + c;
            const u32x4 mv = *(const u32x4*)(Mb + off);
            f32x4 x0, x1;
            if (SRC_F32) { x0 = *(const f32x4*)(xsrc32 + off); x1 = *(const f32x4*)(xsrc32 + off + 4); }
            else { const u32x4 xv = *(const u32x4*)(xsrc16 + off); x0 = (f32x4){bflo(xv.x), bfhi(xv.x), bflo(xv.y), bfhi(xv.y)}; x1 = (f32x4){bflo(xv.z), bfhi(xv.z), bflo(xv.w), bfhi(xv.w)}; }
            const f32x4 g0 = *(const f32x4*)(gain + c), g1 = *(const f32x4*)(gain + c + 4);
            x0[0] += bflo(mv.x) * rm * g0[0]; x0[1] += bfhi(mv.x) * rm * g0[1]; x0[2] += bflo(mv.y) * rm * g0[2]; x0[3] += bfhi(mv.y) * rm * g0[3];
            x1[0] += bflo(mv.z) * rm * g1[0]; x1[1] += bfhi(mv.z) * rm * g1[1]; x1[2] += bflo(mv.w) * rm * g1[2]; x1[3] += bfhi(mv.w) * rm * g1[3];
            u32x4 w; w.x = pk2(x0[0], x0[1]); w.y = pk2(x0[2], x0[3]); w.z = pk2(x1[0], x1[1]); w.w = pk2(x1[2], x1[3]);
            *(u32x4*)(XB + off) = w;
            ss += (x0[0] * x0[0] + x0[1] * x0[1]) + (x0[2] * x0[2] + x0[3] * x0[3]) + (x1[0] * x1[0] + x1[1] * x1[1]) + (x1[2] * x1[2] + x1[3] * x1[3]);
        }
        ss = wave_sum(ss, lane);
        if (lane == 0) ssqOut[row] = fx_enc(ss);
    }
}

__device__ __forceinline__ void attn_naive(bf16_t* QH, const bf16_t* Kb, const bf16_t* Vb, const float* sinks, u64* ssqA, int gtid, int nthr) {
    for (int item = gtid; item < T * 16; item += nthr) {
        const int head = item / T, row = item % T, b = row / SEQ, t = row % SEQ, hk = head >> 2;
        float q[64], acc[64];
        const u32x4* qp = (const u32x4*)(QH + (size_t)row * 2048 + head * 64);
#pragma unroll
        for (int c = 0; c < 8; ++c) { const u32x4 w = qp[c]; q[8 * c] = bflo(w.x); q[8 * c + 1] = bfhi(w.x); q[8 * c + 2] = bflo(w.y); q[8 * c + 3] = bfhi(w.y); q[8 * c + 4] = bflo(w.z); q[8 * c + 5] = bfhi(w.z); q[8 * c + 6] = bflo(w.w); q[8 * c + 7] = bfhi(w.w); }
#pragma unroll
        for (int d = 0; d < 64; ++d) acc[d] = 0.f;
        float mx = sinks[head] * LOG2E, l = 1.0f;
        const int j0 = t - 127 < 0 ? 0 : t - 127;
        for (int j = j0; j <= t; ++j) {
            const size_t kr = (size_t)(b * SEQ + j) * 256 + hk * 64;
            const u32x4* kp = (const u32x4*)(Kb + kr);
            float s = 0.f;
#pragma unroll
            for (int c = 0; c < 8; ++c) { const u32x4 w = kp[c]; s += q[8 * c] * bflo(w.x) + q[8 * c + 1] * bfhi(w.x) + q[8 * c + 2] * bflo(w.y) + q[8 * c + 3] * bfhi(w.y) + q[8 * c + 4] * bflo(w.z) + q[8 * c + 5] * bfhi(w.z) + q[8 * c + 6] * bflo(w.w) + q[8 * c + 7] * bfhi(w.w); }
            if (s > mx) { const float cf = exp2f(mx - s); l *= cf;
#pragma unroll
                for (int d = 0; d < 64; ++d) acc[d] *= cf;
                mx = s; }
            const float p = exp2f(s - mx); l += p;
            const u32x4* vp = (const u32x4*)(Vb + kr);
#pragma unroll
            for (int c = 0; c < 8; ++c) { const u32x4 w = vp[c]; acc[8 * c] += p * bflo(w.x); acc[8 * c + 1] += p * bfhi(w.x); acc[8 * c + 2] += p * bflo(w.y); acc[8 * c + 3] += p * bfhi(w.y); acc[8 * c + 4] += p * bflo(w.z); acc[8 * c + 5] += p * bfhi(w.z); acc[8 * c + 6] += p * bflo(w.w); acc[8 * c + 7] += p * bfhi(w.w); }
        }
        const float il = 1.0f / l; float ss = 0.f;
        u32x4* op = (u32x4*)(QH + (size_t)row * 2048 + head * 64);
#pragma unroll
        for (int c = 0; c < 8; ++c) {
            float o[8];
#pragma unroll
            for (int e = 0; e < 8; ++e) { o[e] = acc[8 * c + e] * il; ss += o[e] * o[e]; }
            u32x4 w; w.x = pk2(o[0], o[1]); w.y = pk2(o[2], o[3]); w.z = pk2(o[4], o[5]); w.w = pk2(o[6], o[7]); op[c] = w;
        }
        fx_add(ssqA + row, ss);
    }
}

__device__ __forceinline__ void hgrn_naive(const bf16_t* QH, const bf16_t* KIN, const float* G, const bf16_t* HI, float* tmpO, int item, int lane) {
    const int bh = item >> 1, b = bh >> 3, h = bh & 7, v = (item & 1) * 64 + lane;
    float S[128];
#pragma unroll
    for (int k = 0; k < 128; ++k) S[k] = 0.f;
    int z = 0; asm volatile("v_mov_b32 %0, 0" : "=v"(z));
    for (int t = 0; t < SEQ; ++t) {
        const size_t row = (size_t)b * SEQ + t;
        const float vv = bf2f(HI[row * 1024 + h * 128 + v]);
        const u32x4* qp = (const u32x4*)(QH + row * 2048 + 1024 + h * 128 + z);
        const u32x4* kp = (const u32x4*)(KIN + row * 1024 + h * 128 + z);
        const f32x4* gp = (const f32x4*)(G + row * 1024 + h * 128 + z);
        float o = 0.f;
#pragma unroll
        for (int c = 0; c < 16; ++c) {
            const u32x4 qw = qp[c], kw = kp[c]; const f32x4 g0 = gp[2 * c], g1 = gp[2 * c + 1];
            const float qq[8] = {bflo(qw.x), bfhi(qw.x), bflo(qw.y), bfhi(qw.y), bflo(qw.z), bfhi(qw.z), bflo(qw.w), bfhi(qw.w)};
            const float kk[8] = {bflo(kw.x), bfhi(kw.x), bflo(kw.y), bfhi(kw.y), bflo(kw.z), bfhi(kw.z), bflo(kw.w), bfhi(kw.w)};
            const float gg[8] = {g0[0], g0[1], g0[2], g0[3], g1[0], g1[1], g1[2], g1[3]};
#pragma unroll
            for (int e = 0; e < 8; ++e) { const float f = __expf(gg[e]); S[8 * c + e] = f * S[8 * c + e] + kk[e] * vv; o += S[8 * c + e] * qq[e]; }
        }
        tmpO[row * 1024 + h * 128 + v] = o;
    }
}
__device__ __forceinline__ void hgrn_norm_naive(const float* tmpO, const bf16_t* HG, bf16_t* QH, int gw, int ngw, int lane) {
    for (int row = gw; row < T; row += ngw) {
        const size_t off = (size_t)row * 1024 + lane * 16;
        f32x4 o[4]; float ss = 0.f;
#pragma unroll
        for (int j = 0; j < 4; ++j) { o[j] = *(const f32x4*)(tmpO + off + 4 * j); ss += (o[j][0] * o[j][0] + o[j][1] * o[j][1]) + (o[j][2] * o[j][2] + o[j][3] * o[j][3]); }
        ss += shx(ss, lane, 1); ss += shx(ss, lane, 2); ss += shx(ss, lane, 4);
        const float r = rsqrtf(ss * (1.0f / 128.0f) + EPS);
        const u32x4 g0 = *(const u32x4*)(HG + off), g1 = *(const u32x4*)(HG + off + 8);
        u32x4 w0, w1;
        w0.x = pk2(o[0][0] * r * bflo(g0.x), o[0][1] * r * bfhi(g0.x)); w0.y = pk2(o[0][2] * r * bflo(g0.y), o[0][3] * r * bfhi(g0.y));
        w0.z = pk2(o[1][0] * r * bflo(g0.z), o[1][1] * r * bfhi(g0.z)); w0.w = pk2(o[1][2] * r * bflo(g0.w), o[1][3] * r * bfhi(g0.w));
        w1.x = pk2(o[2][0] * r * bflo(g1.x), o[2][1] * r * bfhi(g1.x)); w1.y = pk2(o[2][2] * r * bflo(g1.y), o[2][3] * r * bfhi(g1.y));
        w1.z = pk2(o[3][0] * r * bflo(g1.z), o[3][1] * r * bfhi(g1.z)); w1.w = pk2(o[3][2] * r * bflo(g1.w), o[3][3] * r * bfhi(g1.w));
        bf16_t* dst = QH + (size_t)row * 2048 + 1024 + lane * 16;
        *(u32x4*)dst = w0; *(u32x4*)(dst + 8) = w1;
    }
}


typedef float f32x16 __attribute__((ext_vector_type(16)));
typedef short bf16x8 __attribute__((ext_vector_type(8)));
typedef unsigned u32x2 __attribute__((ext_vector_type(2)));
__device__ __forceinline__ int crow(int r, int hi) { return (r & 3) + 8 * (r >> 2) + 4 * hi; }
__device__ __forceinline__ bf16x8 pack8(float a0, float a1, float a2, float a3, float a4, float a5, float a6, float a7) {
    u32x4 w; w.x = cvt_pk_bf16(a0, a1); w.y = cvt_pk_bf16(a2, a3); w.z = cvt_pk_bf16(a4, a5); w.w = cvt_pk_bf16(a6, a7); return __builtin_bit_cast(bf16x8, w);
}
constexpr int AT_KSTR = 144, AT_VSTR = 528, AT_VOFF = 256 * AT_KSTR;

__device__ __forceinline__ void attn_unit(LAS unsigned char* lds, bf16_t* QH, const bf16_t* Kb, const bf16_t* Vb, const float* sinks, u64* ssqA, int unit, int tid, int lane, int wave) {
    const int hk = unit & 3, n = (unit >> 2) & 31, b = unit >> 7;
    const long rowbase = (long)b * SEQ + n * 128 - 128;
    LAS unsigned char* Ks = lds; LAS unsigned char* Vt = lds + AT_VOFF;
#pragma unroll
    for (int i = 0; i < 4; ++i) {
        const int row = (tid >> 3) + 64 * i; u32x4 v = (u32x4){0u, 0u, 0u, 0u};
        if (n > 0 || row >= 128) v = *(const u32x4*)(Kb + (rowbase + row) * 256 + hk * 64 + (tid & 7) * 8);
        *(LAS u32x4*)(Ks + row * AT_KSTR + (tid & 7) * 16) = v;
    }
#pragma unroll
    for (int i = 0; i < 4; ++i) {
        const int key = lane + 64 * i; u32x4 v = (u32x4){0u, 0u, 0u, 0u};
        if (n > 0 || key >= 128) v = *(const u32x4*)(Vb + (rowbase + key) * 256 + hk * 64 + wave * 8);
        LAS unsigned short* vp = (LAS unsigned short*)(Vt + (wave * 8) * AT_VSTR + key * 2);
        vp[0 * 264] = (unsigned short)(v.x & 0xffffu); vp[1 * 264] = (unsigned short)(v.x >> 16); vp[2 * 264] = (unsigned short)(v.y & 0xffffu); vp[3 * 264] = (unsigned short)(v.y >> 16);
        vp[4 * 264] = (unsigned short)(v.z & 0xffffu); vp[5 * 264] = (unsigned short)(v.z >> 16); vp[6 * 264] = (unsigned short)(v.w & 0xffffu); vp[7 * 264] = (unsigned short)(v.w >> 16);
    }
    __syncthreads();
    const int g = wave >> 1, qh = wave & 1, head = hk * 4 + g, r = lane & 31, h = lane >> 5;
    const float sink2 = sinks[head] * LOG2E;
    for (int qt = 0; qt < 2; ++qt) {
        const int t0 = 64 * qh + 32 * qt, t = t0 + r;
        const size_t qrow = (size_t)b * SEQ + n * 128 + t;
        bf16_t* qp = QH + qrow * 2048 + head * 64;
        bf16x8 qf[4];
#pragma unroll
        for (int s4 = 0; s4 < 4; ++s4) qf[s4] = *(const bf16x8*)(qp + 16 * s4 + 8 * h);
        f32x16 S[5];
#pragma unroll
        for (int jt = 0; jt < 5; ++jt) {
            const int kb = t0 + 32 * jt;
            f32x16 a = {};
#pragma unroll
            for (int s4 = 0; s4 < 4; ++s4) { const bf16x8 kf = *(const LAS bf16x8*)(Ks + (kb + r) * AT_KSTR + (16 * s4 + 8 * h) * 2); a = __builtin_amdgcn_mfma_f32_32x32x16_bf16(kf, qf[s4], a, 0, 0, 0); }
            S[jt] = a;
        }
        float mx = sink2;
#pragma unroll
        for (int jt = 0; jt < 5; ++jt)
#pragma unroll
            for (int rg = 0; rg < 16; ++rg) {
                const int ki = t0 + 32 * jt + crow(rg, h);
                const bool ok = (ki > t) && (ki <= t + 128) && (n > 0 || ki >= 128);
                const float v = ok ? S[jt][rg] : -1e30f; S[jt][rg] = v; mx = fmaxf(mx, v);
            }
        mx = fmaxf(mx, shx(mx, lane, 32));
        float l = 0.f;
#pragma unroll
        for (int jt = 0; jt < 5; ++jt)
#pragma unroll
            for (int rg = 0; rg < 16; ++rg) { const float p = __builtin_amdgcn_exp2f(S[jt][rg] - mx); S[jt][rg] = p; l += p; }
        l += shx(l, lane, 32);
        l += __builtin_amdgcn_exp2f(sink2 - mx);
        f32x16 O[2]; O[0] = (f32x16){}; O[1] = (f32x16){};
#pragma unroll
        for (int jt = 0; jt < 5; ++jt)
#pragma unroll
            for (int sp = 0; sp < 2; ++sp) {
                const bf16x8 pf = pack8(S[jt][8 * sp], S[jt][8 * sp + 1], S[jt][8 * sp + 2], S[jt][8 * sp + 3], S[jt][8 * sp + 4], S[jt][8 * sp + 5], S[jt][8 * sp + 6], S[jt][8 * sp + 7]);
                const int kk = t0 + 32 * jt + 16 * sp + 4 * h;
#pragma unroll
                for (int dt = 0; dt < 2; ++dt) {
                    const LAS unsigned char* vrow = Vt + (32 * dt + r) * AT_VSTR + kk * 2;
                    const u32x2 lo = *(const LAS u32x2*)vrow, hi2 = *(const LAS u32x2*)(vrow + 16);
                    u32x4 w; w.x = lo.x; w.y = lo.y; w.z = hi2.x; w.w = hi2.y;
                    O[dt] = __builtin_amdgcn_mfma_f32_32x32x16_bf16(__builtin_bit_cast(bf16x8, w), pf, O[dt], 0, 0, 0);
                }
            }
        const float il = 1.0f / l; float ss = 0.f;
#pragma unroll
        for (int dt = 0; dt < 2; ++dt)
#pragma unroll
            for (int gp = 0; gp < 4; ++gp) {
                const float o0 = O[dt][4 * gp] * il, o1 = O[dt][4 * gp + 1] * il, o2 = O[dt][4 * gp + 2] * il, o3 = O[dt][4 * gp + 3] * il;
                ss += (o0 * o0 + o1 * o1) + (o2 * o2 + o3 * o3);
                u32x2 w; w.x = cvt_pk_bf16(o0, o1); w.y = cvt_pk_bf16(o2, o3);
                *(u32x2*)(qp + 32 * dt + 8 * gp + 4 * h) = w;
            }
        ss += shx(ss, lane, 32);
        if (h == 0) fx_add(ssqA + qrow, ss);
    }
    __syncthreads();
}

constexpr int HG_STR = 144;
__device__ __forceinline__ void hgrn_h1_unit(LAS unsigned char* lds, const bf16_t* KIN, const float* G, const bf16_t* HI, bf16_t* SB, float* DEC, int unit, int tid, int lane, int wave) {
    const int c = unit & 63, bh = unit >> 6, b = bh >> 3, h = bh & 7;
    const size_t row0 = (size_t)b * SEQ + c * 64;
    LAS unsigned char* Kt = lds;
    LAS unsigned char* Vt = lds + 128 * HG_STR;
    LAS float* tot = (LAS float*)(lds + 2 * 128 * HG_STR);
    const int k = tid & 127, sg = tid >> 7;
    float bl[16]; float run = 0.f;
#pragma unroll
    for (int i = 0; i < 16; ++i) { run += G[(row0 + sg * 16 + i) * 1024 + h * 128 + k]; bl[i] = run; }
    tot[sg * 128 + k] = run;
    float kv[16], vv[16];
#pragma unroll
    for (int i = 0; i < 16; ++i) { kv[i] = bf2f(KIN[(row0 + sg * 16 + i) * 1024 + h * 128 + k]); vv[i] = bf2f(HI[(row0 + sg * 16 + i) * 1024 + h * 128 + k]); }
    __syncthreads();
    const float t0 = tot[k], t1 = tot[128 + k], t2 = tot[256 + k], t3 = tot[384 + k];
    const float blast = (t0 + t1) + (t2 + t3);
    const float off = (sg > 0 ? t0 : 0.f) + (sg > 1 ? t1 : 0.f) + (sg > 2 ? t2 : 0.f);
    if (sg == 0) DEC[(size_t)unit * 128 + k] = __expf(blast);
    float kt[16];
#pragma unroll
    for (int i = 0; i < 16; ++i) kt[i] = kv[i] * __expf(blast - (bl[i] + off));
    {
        u32x4 w0, w1;
        w0.x = pk2(kt[0], kt[1]); w0.y = pk2(kt[2], kt[3]); w0.z = pk2(kt[4], kt[5]); w0.w = pk2(kt[6], kt[7]);
        w1.x = pk2(kt[8], kt[9]); w1.y = pk2(kt[10], kt[11]); w1.z = pk2(kt[12], kt[13]); w1.w = pk2(kt[14], kt[15]);
        *(LAS u32x4*)(Kt + k * HG_STR + sg * 32) = w0; *(LAS u32x4*)(Kt + k * HG_STR + sg * 32 + 16) = w1;
        w0.x = pk2(vv[0], vv[1]); w0.y = pk2(vv[2], vv[3]); w0.z = pk2(vv[4], vv[5]); w0.w = pk2(vv[6], vv[7]);
        w1.x = pk2(vv[8], vv[9]); w1.y = pk2(vv[10], vv[11]); w1.z = pk2(vv[12], vv[13]); w1.w = pk2(vv[14], vv[15]);
        *(LAS u32x4*)(Vt + k * HG_STR + sg * 32) = w0; *(LAS u32x4*)(Vt + k * HG_STR + sg * 32 + 16) = w1;
    }
    __syncthreads();
    const int vt = wave >> 1, kt0 = (wave & 1) * 2, r = lane & 31, hh = lane >> 5;
    f32x16 acc0 = {}, acc1 = {};
#pragma unroll
    for (int st = 0; st < 4; ++st) {
        const bf16x8 af = *(const LAS bf16x8*)(Vt + (32 * vt + r) * HG_STR + (16 * st + 8 * hh) * 2);
        const bf16x8 b0 = *(const LAS bf16x8*)(Kt + (32 * kt0 + r) * HG_STR + (16 * st + 8 * hh) * 2);
        const bf16x8 b1 = *(const LAS bf16x8*)(Kt + (32 * (kt0 + 1) + r) * HG_STR + (16 * st + 8 * hh) * 2);
        acc0 = __builtin_amdgcn_mfma_f32_32x32x16_bf16(af, b0, acc0, 0, 0, 0);
        acc1 = __builtin_amdgcn_mfma_f32_32x32x16_bf16(af, b1, acc1, 0, 0, 0);
    }
    bf16_t* sb = SB + (size_t)unit * 16384;
#pragma unroll
    for (int rg = 0; rg < 16; ++rg) {
        const int v = 32 * vt + crow(rg, hh);
        sb[v * 128 + 32 * kt0 + r] = (bf16_t)f2bf(acc0[rg]);
        sb[v * 128 + 32 * (kt0 + 1) + r] = (bf16_t)f2bf(acc1[rg]);
    }
    __syncthreads();
}

__device__ __forceinline__ void hgrn_scan(bf16_t* SB, const float* DEC, int gtid, int nthr) {
    for (int item = gtid; item < 32 * 128 * 32; item += nthr) {
        const int kq = item & 31, v = (item >> 5) & 127, bh = item >> 12;
        f32x4 st = (f32x4){0.f, 0.f, 0.f, 0.f};
        u32x2* p = (u32x2*)(SB + ((size_t)bh * 64 * 128 + v) * 128 + kq * 4);
        const f32x4* dp = (const f32x4*)(DEC + (size_t)bh * 64 * 128 + kq * 4);
#pragma unroll 8
        for (int c = 0; c < 64; ++c) {
            const u32x2 d = p[(size_t)c * 16384 / 4]; const f32x4 dc = dp[c * 32];
            u32x2 o; o.x = cvt_pk_bf16(st[0], st[1]); o.y = cvt_pk_bf16(st[2], st[3]);
            p[(size_t)c * 16384 / 4] = o;
            st[0] = dc[0] * st[0] + bflo(d.x); st[1] = dc[1] * st[1] + bfhi(d.x); st[2] = dc[2] * st[2] + bflo(d.y); st[3] = dc[3] * st[3] + bfhi(d.y);
        }
    }
}

constexpr int H3_BSTR = 528, H3_QSTR = 272, H3_B_OFF = 0, H3_Q_OFF = 64 * H3_BSTR, H3_K_OFF = H3_Q_OFF + 64 * H3_QSTR, H3_V_OFF = H3_K_OFF + 64 * H3_QSTR, H3_T_OFF = H3_V_OFF + 128 * HG_STR, H3_O_OFF = H3_T_OFF + 2048;
__device__ __forceinline__ void hgrn_h3_unit(LAS unsigned char* lds, bf16_t* QH, const bf16_t* KIN, const float* G, const bf16_t* HI, const bf16_t* HG, const bf16_t* SB, int unit, int tid, int lane, int wave) {
    const int c = unit & 63, bh = unit >> 6, b = bh >> 3, h = bh & 7;
    const size_t row0 = (size_t)b * SEQ + c * 64;
    LAS unsigned char* Bl = lds + H3_B_OFF;
    LAS unsigned char* Qs = lds + H3_Q_OFF;
    LAS unsigned char* Ks = lds + H3_K_OFF;
    LAS unsigned char* Vt = lds + H3_V_OFF;
    LAS float* tot = (LAS float*)(lds + H3_T_OFF);
    LAS float* osq = (LAS float*)(lds + H3_O_OFF);
    {
        const int k = tid & 127, sg = tid >> 7;
        float bl[16]; float run = 0.f;
#pragma unroll
        for (int i = 0; i < 16; ++i) { run += G[(row0 + sg * 16 + i) * 1024 + h * 128 + k]; bl[i] = run; }
        tot[sg * 128 + k] = run;
        float vv[16];
#pragma unroll
        for (int i = 0; i < 16; ++i) vv[i] = bf2f(HI[(row0 + sg * 16 + i) * 1024 + h * 128 + k]);
        u32x4 w0, w1;
        w0.x = pk2(vv[0], vv[1]); w0.y = pk2(vv[2], vv[3]); w0.z = pk2(vv[4], vv[5]); w0.w = pk2(vv[6], vv[7]);
        w1.x = pk2(vv[8], vv[9]); w1.y = pk2(vv[10], vv[11]); w1.z = pk2(vv[12], vv[13]); w1.w = pk2(vv[14], vv[15]);
        *(LAS u32x4*)(Vt + k * HG_STR + sg * 32) = w0; *(LAS u32x4*)(Vt + k * HG_STR + sg * 32 + 16) = w1;
#pragma unroll
        for (int i = 0; i < 2; ++i) {
            const int idx = tid + 512 * i, rr = idx >> 4, ch = idx & 15;
            *(LAS u32x4*)(Qs + rr * H3_QSTR + ch * 16) = *(const u32x4*)(QH + (row0 + rr) * 2048 + 1024 + h * 128 + ch * 8);
            *(LAS u32x4*)(Ks + rr * H3_QSTR + ch * 16) = *(const u32x4*)(KIN + (row0 + rr) * 1024 + h * 128 + ch * 8);
        }
        __syncthreads();
        const float t0 = tot[k], t1 = tot[128 + k], t2 = tot[256 + k];
        const float off = (sg > 0 ? t0 : 0.f) + (sg > 1 ? t1 : 0.f) + (sg > 2 ? t2 : 0.f);
#pragma unroll
        for (int i = 0; i < 16; ++i) *(LAS float*)(Bl + (sg * 16 + i) * H3_BSTR + k * 4) = bl[i] + off;
        __syncthreads();
    }
    const int i4 = wave & 3, vh = wave >> 2, fr = lane & 15, hh = lane >> 4;
    const int tq = 16 * i4 + fr;
    bf16x8 qhat[4], qtil[4];
#pragma unroll
    for (int ks = 0; ks < 4; ++ks) {
        const int k0 = 32 * ks + 8 * hh;
        const u32x4 qw = *(const LAS u32x4*)(Qs + tq * H3_QSTR + k0 * 2);
        const f32x4 b0 = *(const LAS f32x4*)(Bl + tq * H3_BSTR + k0 * 4), b1 = *(const LAS f32x4*)(Bl + tq * H3_BSTR + k0 * 4 + 16);
        f32x4 r0 = (f32x4){0.f, 0.f, 0.f, 0.f}, r1 = r0;
        if (i4 > 0) { r0 = *(const LAS f32x4*)(Bl + (16 * i4 - 1) * H3_BSTR + k0 * 4); r1 = *(const LAS f32x4*)(Bl + (16 * i4 - 1) * H3_BSTR + k0 * 4 + 16); }
        const float q[8] = {bflo(qw.x), bfhi(qw.x), bflo(qw.y), bfhi(qw.y), bflo(qw.z), bfhi(qw.z), bflo(qw.w), bfhi(qw.w)};
        const float bb[8] = {b0[0], b0[1], b0[2], b0[3], b1[0], b1[1], b1[2], b1[3]};
        const float rf[8] = {r0[0], r0[1], r0[2], r0[3], r1[0], r1[1], r1[2], r1[3]};
        float a[8], t8[8];
#pragma unroll
        for (int e = 0; e < 8; ++e) { a[e] = q[e] * __expf(bb[e] - rf[e]); t8[e] = q[e] * __expf(bb[e]); }
        qhat[ks] = pack8(a[0], a[1], a[2], a[3], a[4], a[5], a[6], a[7]);
        qtil[ks] = pack8(t8[0], t8[1], t8[2], t8[3], t8[4], t8[5], t8[6], t8[7]);
    }
    f32x4 at[4];
#pragma unroll
    for (int j = 0; j < 4; ++j) {
        at[j] = (f32x4){0.f, 0.f, 0.f, 0.f};
        if (j <= i4) {
            const int sr = 16 * j + fr;
#pragma unroll
            for (int ks = 0; ks < 4; ++ks) {
                const int k0 = 32 * ks + 8 * hh;
                const u32x4 kw = *(const LAS u32x4*)(Ks + sr * H3_QSTR + k0 * 2);
                const f32x4 b0 = *(const LAS f32x4*)(Bl + sr * H3_BSTR + k0 * 4), b1 = *(const LAS f32x4*)(Bl + sr * H3_BSTR + k0 * 4 + 16);
                f32x4 r0 = (f32x4){0.f, 0.f, 0.f, 0.f}, r1 = r0;
                if (i4 > 0) { r0 = *(const LAS f32x4*)(Bl + (16 * i4 - 1) * H3_BSTR + k0 * 4); r1 = *(const LAS f32x4*)(Bl + (16 * i4 - 1) * H3_BSTR + k0 * 4 + 16); }
                const float kk[8] = {bflo(kw.x), bfhi(kw.x), bflo(kw.y), bfhi(kw.y), bflo(kw.z), bfhi(kw.z), bflo(kw.w), bfhi(kw.w)};
                const float bb[8] = {b0[0], b0[1], b0[2], b0[3], b1[0], b1[1], b1[2], b1[3]};
                const float rf[8] = {r0[0], r0[1], r0[2], r0[3], r1[0], r1[1], r1[2], r1[3]};
                float a[8];
#pragma unroll
                for (int e = 0; e < 8; ++e) a[e] = kk[e] * __expf(fminf(rf[e] - bb[e], 80.f));
                const bf16x8 kf = pack8(a[0], a[1], a[2], a[3], a[4], a[5], a[6], a[7]);
                at[j] = __builtin_amdgcn_mfma_f32_16x16x32_bf16(kf, qhat[ks], at[j], 0, 0, 0);
            }
            if (j == i4) {
#pragma unroll
                for (int rg = 0; rg < 4; ++rg) if (4 * hh + rg > fr) at[j][rg] = 0.f;
            }
        }
    }
    f32x4 o[4];
#pragma unroll
    for (int vt = 0; vt < 4; ++vt) o[vt] = (f32x4){0.f, 0.f, 0.f, 0.f};
#pragma unroll
    for (int p = 0; p < 2; ++p) {
        if (2 * p <= i4) {
            const bf16x8 pf = pack8(at[2 * p][0], at[2 * p][1], at[2 * p][2], at[2 * p][3], at[2 * p + 1][0], at[2 * p + 1][1], at[2 * p + 1][2], at[2 * p + 1][3]);
#pragma unroll
            for (int vt = 0; vt < 4; ++vt) {
                const LAS unsigned char* vrow = Vt + (64 * vh + 16 * vt + fr) * HG_STR;
                const u32x2 lo = *(const LAS u32x2*)(vrow + (32 * p + 4 * hh) * 2), hi2 = *(const LAS u32x2*)(vrow + (32 * p + 16 + 4 * hh) * 2);
                u32x4 w; w.x = lo.x; w.y = lo.y; w.z = hi2.x; w.w = hi2.y;
                o[vt] = __builtin_amdgcn_mfma_f32_16x16x32_bf16(__builtin_bit_cast(bf16x8, w), pf, o[vt], 0, 0, 0);
            }
        }
    }
    {
        const bf16_t* sb = SB + (size_t)unit * 16384;
#pragma unroll
        for (int vt = 0; vt < 4; ++vt)
#pragma unroll
            for (int ks = 0; ks < 4; ++ks) {
                const bf16x8 sf = *(const bf16x8*)(sb + (64 * vh + 16 * vt + fr) * 128 + 32 * ks + 8 * hh);
                o[vt] = __builtin_amdgcn_mfma_f32_16x16x32_bf16(sf, qtil[ks], o[vt], 0, 0, 0);
            }
    }
    float ss = 0.f;
#pragma unroll
    for (int vt = 0; vt < 4; ++vt) ss += (o[vt][0] * o[vt][0] + o[vt][1] * o[vt][1]) + (o[vt][2] * o[vt][2] + o[vt][3] * o[vt][3]);
    ss += shx(ss, lane, 16); ss += shx(ss, lane, 32);
    if (hh == 0) osq[vh * 64 + tq] = ss;
    __syncthreads();
    const float rn = rsqrtf((osq[tq] + osq[64 + tq]) * (1.0f / 128.0f) + EPS);
#pragma unroll
    for (int vt = 0; vt < 4; ++vt) {
        const int v = 64 * vh + 16 * vt + 4 * hh;
        const u32x2 gw = *(const u32x2*)(HG + (row0 + tq) * 1024 + h * 128 + v);
        u32x2 w; w.x = cvt_pk_bf16(o[vt][0] * rn * bflo(gw.x), o[vt][1] * rn * bfhi(gw.x)); w.y = cvt_pk_bf16(o[vt][2] * rn * bflo(gw.y), o[vt][3] * rn * bfhi(gw.y));
        *(u32x2*)(QH + (row0 + tq) * 2048 + 1024 + h * 128 + v) = w;
    }
    __syncthreads();
}


#define XB_TMO      128
#define XB_XCNT(j)  (256  + 64 * (j))
#define XB_XSUB(j)  (1280 + 64 * (j))
#define XB_XGEN(j)  (2304 + 64 * (j))
#define XB_TOP      3328
#define XB_TOPGEN   3392
#define XCD_BAR_WORDS 3456
#define XB_SPIN_CAP (1u << 22)
__device__ __forceinline__ unsigned xb_ld(unsigned* p)              { return __hip_atomic_load(p, __ATOMIC_RELAXED, __HIP_MEMORY_SCOPE_AGENT); }
__device__ __forceinline__ unsigned xb_add(unsigned* p, unsigned v) { return __hip_atomic_fetch_add(p, v, __ATOMIC_RELAXED, __HIP_MEMORY_SCOPE_AGENT); }
__device__ __forceinline__ unsigned xb_xcc_id() { return (unsigned)__builtin_amdgcn_s_getreg((3 << 11) | 20) & 0xFu; }
#define XB_SPIN(cond, bar) do { unsigned _sp = 0; while (cond) { __builtin_amdgcn_s_sleep(1); \
    if ((++_sp & 255u) == 0u) { if (xb_ld(&(bar)[XB_TMO])) break; if (_sp > XB_SPIN_CAP) { atomicAdd(&(bar)[XB_TMO], 1u); break; } } } } while (0)
struct XcdBarrier { unsigned* bar; unsigned x; volatile LAS unsigned* st; };
__device__ __forceinline__ XcdBarrier xcd_barrier_post(unsigned* bar, volatile LAS unsigned* st) {
    XcdBarrier b; b.bar = bar; b.x = xb_xcc_id(); b.st = st;
    if (threadIdx.x == 0) (void)xb_add(&bar[XB_XCNT(b.x)], 1u);
    return b;
}
__device__ __forceinline__ void xcd_barrier_complete(unsigned* bar, unsigned x, unsigned& nloc, unsigned& nx) {
    const unsigned G = gridDim.x * gridDim.y * gridDim.z;
    unsigned sum, cnt, mine, sp = 0u;
    for (;;) {
        sum = 0u; cnt = 0u; mine = 0u;
#pragma unroll
        for (unsigned j = 0; j < 16; ++j) { const unsigned c = xb_ld(&bar[XB_XCNT(j)]); sum += c; cnt += (c > 0u) ? 1u : 0u; mine = (j == x) ? c : mine; }
        if (sum == G) break;
        __builtin_amdgcn_s_sleep(1);
        if ((++sp & 255u) == 0u) { if (xb_ld(&bar[XB_TMO])) break; if (sp > XB_SPIN_CAP) { atomicAdd(&bar[XB_TMO], 1u); break; } }
    }
    nloc = mine > 0u ? mine : 1u; nx = cnt > 0u ? cnt : 1u;
}
__device__ __forceinline__ void xcd_barrier(const XcdBarrier& b) {
    asm volatile("s_waitcnt vmcnt(0)" ::: "memory");
    __syncthreads();
    if (threadIdx.x == 0) {
        unsigned* bar = b.bar;
        __builtin_amdgcn_s_waitcnt(0);
        unsigned nloc = b.st[0], nx = b.st[1];
        if (nloc == 0u) { xcd_barrier_complete(bar, b.x, nloc, nx); b.st[0] = nloc; b.st[1] = nx; }
        const unsigned old = xb_add(&bar[XB_XSUB(b.x)], 1u);
        const unsigned gen = old / nloc;
        if (old + 1u == (gen + 1u) * nloc) {
            __builtin_amdgcn_fence(__ATOMIC_RELEASE, "agent");
            asm volatile("s_waitcnt vmcnt(0)" ::: "memory");
            const unsigned og = xb_add(&bar[XB_TOP], 1u);
            const unsigned tg = og / nx;
            if (og + 1u == (tg + 1u) * nx) xb_add(&bar[XB_TOPGEN], 1u);
            else XB_SPIN(xb_ld(&bar[XB_TOPGEN]) == tg, bar);
            __builtin_amdgcn_fence(__ATOMIC_ACQUIRE, "agent");
            xb_add(&bar[XB_XGEN(b.x)], 1u);
            asm volatile("s_waitcnt vmcnt(0)" ::: "memory");
        } else {
            XB_SPIN(xb_ld(&bar[XB_XGEN(b.x)]) == gen, bar);
            __builtin_amdgcn_fence(__ATOMIC_ACQUIRE, "agent");
            asm volatile("s_waitcnt vmcnt(0)" ::: "memory");
        }
    }
    __syncthreads();
}

__global__ void __launch_bounds__(NTHR, 2) fwd_megakernel(Args args) {
    extern __shared__ __attribute__((aligned(16))) unsigned char lds_raw[];
    LAS unsigned char* lds = (LAS unsigned char*)lds_raw;
    cg::grid_group grid = cg::this_grid();
    const int G = gridDim.x, bx = blockIdx.x, ngw = G * NWAVES, nthr = G * NTHR;
    const int wave = __builtin_amdgcn_readfirstlane((int)threadIdx.x >> 6);
#define PHASE_IDS() int lane_; asm volatile("v_mbcnt_lo_u32_b32 %0, -1, 0\n\tv_mbcnt_hi_u32_b32 %0, -1, %0" : "=v"(lane_)); const int lane = lane_, tid = wave * 64 + lane, gw = bx * NWAVES + wave, gtid = bx * NTHR + tid; (void)gw; (void)gtid
    unsigned char* ws = args.ws;
    const float* x_in = (const float*)args.in[0]; const float* p_in = (const float*)args.in[1]; const int* pos = (const int*)args.in[2];
    const float* w_in = (const float*)args.in[3]; const float* sinks = (const float*)args.in[4]; const float* lb_logits = (const float*)args.in[5];
    const float* attn_gain = (const float*)args.in[6]; const float* hgrn_gain = (const float*)args.in[7]; const float* w_out = (const float*)args.in[8];
    const float* pre_mix = (const float*)args.in[9]; const float* post_mix = (const float*)args.in[10]; const float* pre_ffn = (const float*)args.in[11]; const float* post_ffn = (const float*)args.in[12];
    const float* w_gate = (const float*)args.in[13]; const float* w_up = (const float*)args.in[14]; const float* w_down = (const float*)args.in[15];
    const float* ple_gain = (const float*)args.in[16]; const float* w_pg = (const float*)args.in[17]; const float* w_pp = (const float*)args.in[18];
    float* out = args.out;
    u64* stat = (u64*)(ws + WS_STAT); float* lbt = (float*)(ws + WS_LBT); float* cs = (float*)(ws + WS_CS);
    bf16_t* PBF = (bf16_t*)(ws + WS_PBF); bf16_t* HA = (bf16_t*)(ws + WS_HA); float* tmpO = (float*)(ws + WS_HA);
    bf16_t* QH = (bf16_t*)(ws + WS_QH); bf16_t* Kb = (bf16_t*)(ws + WS_K); bf16_t* Vb = (bf16_t*)(ws + WS_V); float* Gb = (float*)(ws + WS_G);
    bf16_t* KIN = (bf16_t*)(ws + WS_KIN); bf16_t* HI = (bf16_t*)(ws + WS_HI); bf16_t* HG = (bf16_t*)(ws + WS_HG);
    bf16_t* SBuf = (bf16_t*)(ws + WS_HA); float* DEC = (float*)(ws + WS_DEC);
    bf16_t* Mb = (bf16_t*)(ws + WS_M); bf16_t* ACT = (bf16_t*)(ws + WS_ACT); bf16_t* Fb = (bf16_t*)(ws + WS_F); bf16_t* PP = (bf16_t*)(ws + WS_PP);

    volatile LAS unsigned* xst = (volatile LAS unsigned*)(lds + 131072 + 64);
    unsigned* barw = (unsigned*)(ws + WS_BAR);
    if (threadIdx.x < 2) xst[threadIdx.x] = 0u;
    if (bx == 0) for (int i = threadIdx.x; i < 3456; i += NTHR) barw[i] = 0u;
    __syncthreads();
    {
        PHASE_IDS();
        LAS float* scr = (LAS float*)(lds + wave * 16384);
        constexpr int I_IN = 32 * 176, I_OUT = 32 * 64, I_G = 32 * 176, I_D = 88 * 64, I_PG = 32 * 64, I_PP = 4 * 64;
        constexpr int I_L = I_IN + I_OUT + 2 * I_G + I_D + I_PG + I_PP;
        for (int it = gw; it < DEPTH * I_L; it += ngw) {
            const int l = it / I_L; int r = it % I_L;
            unsigned char* wl = ws + WS_W + (size_t)l * WL_SIZE;
            if (r < I_IN) {
                const int kb = r / 176, nb = r % 176, n0 = nb * 32, pn = n0 >> 8; int prow0 = n0;
                if (pn <= 4) { const int lc = n0 & 255; prow0 = (pn << 8) + 128 * ((lc >> 5) & 1) + 32 * ((lc >> 6) & 3); }
                tr_item(w_in + (size_t)l * DM * DIN, DIN, DM, kb * 64, n0, (bf16_t*)(wl + WL_IN), prow0, pre_mix + l * DM, scr, lane); continue; }
            r -= I_IN;
            if (r < I_OUT) {
                const int kb = r / 64, nb = r % 64; const int k0 = kb * 64;
                const float* gp = (k0 < 1024) ? (attn_gain + l * 1024) : (hgrn_gain + l * 1024 - 1024);
                tr_item(w_out + (size_t)l * DM * DM, DM, DM, k0, nb * 32, (bf16_t*)(wl + WL_OUT), nb * 32, gp, scr, lane); continue; }
            r -= I_OUT;
            if (r < 2 * I_G) {
                const int up = r >= I_G; if (up) r -= I_G;
                const int kb = r / 176, nb = r % 176, n0 = nb * 32; const int prow0 = 256 * (n0 >> 7) + (n0 & 127) + (up ? 128 : 0);
                tr_item((up ? w_up : w_gate) + (size_t)l * DM * DFF, DFF, DM, kb * 64, n0, (bf16_t*)(wl + WL_GU), prow0, pre_ffn + l * DM, scr, lane); continue; }
            r -= 2 * I_G;
            if (r < I_D) { const int kb = r / 64, nb = r % 64;
                tr_item(w_down + (size_t)l * DFF * DM, DM, DFF, kb * 64, nb * 32, (bf16_t*)(wl + WL_DOWN), nb * 32, nullptr, scr, lane); continue; }
            r -= I_D;
            if (r < I_PG) { const int kb = r / 64, nb = r % 64;
                tr_item(w_pg + (size_t)l * DM * DM, DM, DM, kb * 64, nb * 32, (bf16_t*)(wl + WL_PG), nb * 32, ple_gain + l * DM, scr, lane); continue; }
            r -= I_PG;
            { const int kb = r / 64, nb = r % 64;
                tr_item(w_pp + (size_t)l * DPLE * DM, DM, DPLE, kb * 64, nb * 32, (bf16_t*)(wl + WL_PP), nb * 32, nullptr, scr, lane); }
        }
        for (int i = gtid; i < 11 * T; i += nthr) stat[T + i] = 0ull;
        for (int i = gtid; i < 1024; i += nthr) {
            const float l0 = lb_logits[i], l1 = lb_logits[1024 + i];
            lbt[i] = 0.f; lbt[1024 + i] = 1.0f / (1.0f + expf(l0 - l1));
        }
        for (int i = gtid; i < T * 32; i += nthr) {
            const int row = i >> 5, d = i & 31;
            const double rev = (double)pos[row] * c_invf[d] * 0.15915494309189535;
            const float fr = (float)(rev - rint(rev));
            cs[(size_t)row * 64 + d] = __builtin_amdgcn_cosf(fr); cs[(size_t)row * 64 + 32 + d] = __builtin_amdgcn_sinf(fr);
        }
        for (int i = gtid; i < DEPTH * T * DPLE / 8; i += nthr) {
            const f32x4 a = *(const f32x4*)(p_in + (size_t)i * 8), b = *(const f32x4*)(p_in + (size_t)i * 8 + 4);
            u32x4 w; w.x = pk2(a[0], a[1]); w.y = pk2(a[2], a[3]); w.z = pk2(b[0], b[1]); w.w = pk2(b[2], b[3]);
            *(u32x4*)(PBF + (size_t)i * 8) = w;
        }
    }
    { PHASE_IDS();
    for (int row = gw; row < T; row += ngw) {
        float ss = 0.f;
#pragma unroll
        for (int j = 0; j < 4; ++j) {
            const int c = j * 512 + lane * 8; const size_t off = (size_t)row * 2048 + c;
            const f32x4 x0 = *(const f32x4*)(x_in + off), x1 = *(const f32x4*)(x_in + off + 4);
            u32x4 w; w.x = pk2(x0[0], x0[1]); w.y = pk2(x0[2], x0[3]); w.z = pk2(x1[0], x1[1]); w.w = pk2(x1[2], x1[3]);
            *(u32x4*)(HA + off) = w;
            ss += (x0[0] * x0[0] + x0[1] * x0[1]) + (x0[2] * x0[2] + x0[3] * x0[3]) + (x1[0] * x1[0] + x1[1] * x1[1]) + (x1[2] * x1[2] + x1[3] * x1[3]);
        }
        ss = wave_sum(ss, lane);
        if (lane == 0) stat[(SQ_X + 0) * T + row] = fx_enc(ss);
    } }
    grid.sync();
    const XcdBarrier xbar = xcd_barrier_post(barw, xst);
#define GSYNC() xcd_barrier(xbar)

    for (int l = 0; l < DEPTH; ++l) {
        unsigned char* wl = ws + WS_W + (size_t)l * WL_SIZE;
        u64* ssqX = stat + (SQ_X + l) * T; u64* ssqA = stat + (SQ_A + l) * T; u64* ssqM = stat + (SQ_M + l) * T;
        u64* ssq2 = stat + (SQ_2 + l) * T; u64* ssqF = stat + (SQ_F + l) * T; u64* ssq3 = stat + (SQ_3 + l) * T;
        {
            PHASE_IDS(); pg8::Gemm g{l == 0 ? HA : (const bf16_t*)(ws + WS_W + (size_t)(l - 1) * WL_SIZE), (const bf16_t*)(wl + WL_IN), T, DIN, DM}; pg8::StaticOrder S; S.init(T, DIN, G, bx);
            EpiIn E{0, ssqX, cs, lbt + l * 1024, QH, Kb, Vb, Gb, KIN, HI, HG};
            if (PH & 1) pg8::gemm_phase<EpiIn, pg8::StaticOrder, true, true>(lds, g, S, E, tid);
        }
        GSYNC();
#if !NAIVE_MIX
        { PHASE_IDS();
          for (int u = bx; u < 512; u += G) attn_unit(lds, QH, Kb, Vb, sinks + l * 16, ssqA, u, tid, lane, wave);
          for (int u = bx; u < 2048; u += G) hgrn_h1_unit(lds, KIN, Gb, HI, SBuf, DEC, u, tid, lane, wave); }
        GSYNC();
        { PHASE_IDS(); hgrn_scan(SBuf, DEC, gtid, nthr); }
        GSYNC();
        { PHASE_IDS();
          for (int u = bx; u < 2048; u += G) hgrn_h3_unit(lds, QH, KIN, Gb, HI, HG, SBuf, u, tid, lane, wave); }
        GSYNC();
#else
        { PHASE_IDS();
        if (bx < 64 && wave == 0) hgrn_naive(QH, KIN, Gb, HI, tmpO, bx, lane);
        attn_naive(QH, Kb, Vb, sinks + l * 16, ssqA, gtid, nthr); }
        GSYNC();
        { PHASE_IDS(); hgrn_norm_naive(tmpO, HG, QH, gw, ngw, lane); }
        GSYNC();
#endif
        {
            PHASE_IDS(); pg8::Gemm g{QH, (const bf16_t*)(wl + WL_OUT), T, DM, DM}; pg8::StaticOrder S; S.init(T, DM, G, bx);
            EpiRowSsq<true> E{16, Mb, ssqM, ssqA};
            if (PH & 2) pg8::gemm_phase<EpiRowSsq<true>, pg8::StaticOrder, true, true>(lds, g, S, E, tid);
        }
        GSYNC();
        { PHASE_IDS();
          if (l == 0) row_phase<true>(x_in, nullptr, Mb, ssqM, post_mix + l * DM, HA, ssq2, gw, ngw, lane);
          else row_phase<false>(nullptr, (const bf16_t*)(ws + WS_W + (size_t)(l - 1) * WL_SIZE), Mb, ssqM, post_mix + l * DM, HA, ssq2, gw, ngw, lane); }
        GSYNC();
        {
            PHASE_IDS(); pg8::Gemm g{HA, (const bf16_t*)(wl + WL_GU), T, 2 * DFF, DM}; pg8::StaticOrder S; S.init(T, 2 * DFF, G, bx);
            EpiGU E{0, ssq2, ACT};
            if (PH & 4) pg8::gemm_phase<EpiGU, pg8::StaticOrder, true, true>(lds, g, S, E, tid);
        }
        GSYNC();
        {
            PHASE_IDS(); pg8::Gemm g{ACT, (const bf16_t*)(wl + WL_DOWN), T, DM, DFF}; pg8::StaticOrder S; S.init(T, DM, G, bx);
            EpiRowSsq<false> E{0, Fb, ssqF, nullptr};
            if (PH & 8) pg8::gemm_phase<EpiRowSsq<false>, pg8::StaticOrder, true, true>(lds, g, S, E, tid);
        }
        GSYNC();
        { PHASE_IDS(); row_phase<false>(nullptr, HA, Fb, ssqF, post_ffn + l * DM, HA, ssq3, gw, ngw, lane); }
        GSYNC();
        {
            PHASE_IDS(); int kpp = DPLE; asm volatile("" : "+s"(kpp)); pg8::Gemm g{PBF + (size_t)l * T * DPLE, (const bf16_t*)(wl + WL_PP), T, DM, kpp}; pg8::StaticOrder S; S.init(T, DM, G, bx);
            EpiPlain E{0, PP};
            if (PH & 16) pg8::gemm_phase<EpiPlain, pg8::StaticOrder, true, true>(lds, g, S, E, tid);
        }
        {
            PHASE_IDS(); pg8::Gemm g{HA, (const bf16_t*)(wl + WL_PG), T, DM, DM}; pg8::StaticOrder S; S.init(T, DM, G, bx);
            EpiPle E{0, ssq3, PP, HA, out, (bf16_t*)wl, stat + (SQ_X + (l + 1 < DEPTH ? l + 1 : 0)) * T, l + 1 < DEPTH ? 1 : 0};
            if (PH & 32) pg8::gemm_phase<EpiPle, pg8::StaticOrder, true, true>(lds, g, S, E, tid);
        }
        if (l + 1 < DEPTH) GSYNC();
    }
}

extern "C" void kernel_launch(void* const* d_in, const int* in_sizes, int n_in, void* d_out, int out_size, void* d_ws, size_t ws_size, hipStream_t stream) {
    static int grid = 0;
    if (grid == 0) {
        if (n_in != 19 || out_size != T * DM || ws_size < WS_END) { fprintf(stderr, "kernel_launch: unexpected shapes (n_in %d out %d ws %zu need %zu)\n", n_in, out_size, ws_size, (size_t)WS_END); grid = -1; return; }
        int dev = 0, cus = 0, per_cu = 0;
        hipGetDevice(&dev);
        hipDeviceGetAttribute(&cus, hipDeviceAttributeMultiprocessorCount, dev);
        if (hipFuncSetAttribute((const void*)fwd_megakernel, hipFuncAttributeMaxDynamicSharedMemorySize, LDS_BYTES) != hipSuccess) { fprintf(stderr, "kernel_launch: hipFuncSetAttribute failed\n"); grid = -1; return; }
        if (hipOccupancyMaxActiveBlocksPerMultiprocessor(&per_cu, (const void*)fwd_megakernel, NTHR, LDS_BYTES) != hipSuccess || per_cu < 1) { fprintf(stderr, "kernel_launch: occupancy query gave %d\n", per_cu); per_cu = 1; }
        (void)hipGetLastError();
        grid = cus * per_cu;
    }
    if (grid < 0) return;
    Args a{};
    for (int i = 0; i < 19; ++i) a.in[i] = d_in[i];
    a.out = (float*)d_out; a.ws = (unsigned char*)d_ws;
    void* kargs[] = {&a};
    hipError_t e = hipLaunchCooperativeKernel((const void*)fwd_megakernel, dim3(grid), dim3(NTHR), kargs, LDS_BYTES, stream);
    if (e != hipSuccess) fprintf(stderr, "cooperative launch failed: %s (grid %d)\n", hipGetErrorString(e), grid);
}
```

```cpp
#include <hip/hip_runtime.h>
#include <hip/hip_cooperative_groups.h>
#include <cstdio>
#include <cstdint>
namespace cg = cooperative_groups;

#ifndef PH
#define PH 63
#endif
#ifndef NAIVE_MIX
#define NAIVE_MIX 0
#endif

namespace pg8 {
#define PG8_LAS __attribute__((address_space(3)))
typedef unsigned short bf16_t;
typedef short bf16x8 __attribute__((ext_vector_type(8)));
typedef float f32x4 __attribute__((ext_vector_type(4)));
typedef unsigned u32x4 __attribute__((ext_vector_type(4)));
constexpr int BM = 256, BK = 64, HALF = 128, HTB = HALF * BK * 2, STAGE_BYTES = 8 * HTB, NXCD = 8, WGM = 8;

__host__ __device__ __forceinline__ int lds_byte(int r, int c) { const int st = (r >> 4) * 2 + (c >> 5), rr = r & 15, cc = c & 31, ob = rr * 64 + cc * 2; return st * 1024 + (ob ^ (((ob >> 9) & 1) << 5)); }
__host__ __device__ __forceinline__ void stage_rc(int b, int& R, int& C) { const int st = b / 1024, sb = b % 1024, swz = sb ^ (((sb >> 9) & 1) << 5); R = (st >> 1) * 16 + swz / 64; C = (st & 1) * 32 + (swz % 64) / 2; }
__host__ __device__ __forceinline__ int perm32(int rho) { const int n = rho >> 4, i = rho & 15; return 8 * (i >> 2) + 4 * n + (i & 3); }

struct Unit { int pm, pn; };
struct Gemm { const bf16_t* A; const bf16_t* Bt; int M, N, K; };

struct StaticOrder {
    int nM, nN, nwg, G, c;
    __host__ __device__ void init(int M, int N, int G_, int c_) { nM = M / BM; nN = N / BM; nwg = nM * nN; G = G_; c = c_; }
    __host__ __device__ bool next(int i, Unit& u) const {
        const long L = (long)i * G + c; if (L >= nwg) return false;
        int wgid = (int)L; { const int q = nwg / NXCD, r = nwg % NXCD, xcd = wgid % NXCD, off = wgid / NXCD; wgid = (xcd < r ? xcd * (q + 1) : r * (q + 1) + (xcd - r) * q) + off; }
        const int nig = WGM * nN, gid = wgid / nig, fm = gid * WGM, gsz = (nM - fm) < WGM ? (nM - fm) : WGM;
        u.pm = fm + ((wgid % nig) % gsz); u.pn = (wgid % nig) / gsz; return true;
    }
    __device__ __forceinline__ void a_ready(const Unit&) const {}
    __device__ __forceinline__ void done(const Unit&) const {}
};

__device__ __forceinline__ unsigned cvt_pk_bf16(float lo, float hi) { unsigned r; asm volatile("v_cvt_pk_bf16_f32 %0, %1, %2" : "=v"(r) : "v"(lo), "v"(hi)); return r; }

template <class Epi, class Sched, bool ALIGN_EPI = false, bool SP2 = false>
__device__ __forceinline__ void gemm_phase(PG8_LAS unsigned char* lds, const Gemm g, const Sched& S, const Epi& E, int tid_in) {
    int tid_ = tid_in; asm volatile("" : "+v"(tid_));
    const int tid = tid_, wid = __builtin_amdgcn_readfirstlane(tid >> 6), lane = tid & 63, wr = wid >> 2, wc = wid & 3, fr = lane & 15, fq = lane >> 4;
    const int K = g.K, nt = K / BK;
    unsigned voffA[2], voffB[2];
#pragma unroll
    for (int i = 0; i < 2; ++i) { int R, C; stage_rc(tid * 16 + i * 8192, R, C); const int Rb = Epi::PERM ? ((R & ~31) + perm32(R & 31)) : R;
        voffA[i] = (unsigned)(R * K + C) * 2u; voffB[i] = (unsigned)(Rb * K + C) * 2u; }
    const size_t kstep = (size_t)(BK * 2);
    const size_t hstep = (size_t)HALF * K * 2;
    const size_t tstep = 2 * hstep;
    const unsigned ldsw = (unsigned)wid * 1024u;
    const int aoff = lds_byte(wr * 64 + fr, fq * 8), boff = lds_byte(wc * 32 + fr, fq * 8);
#define PG8_SA(b, h) (((b) * 2 + (h)) * HTB)
#define PG8_SB(b, h) ((4 + (b) * 2 + (h)) * HTB)
#define PG8_STAGE(bufoff, gbase, voff) do { _Pragma("unroll") for (int _i = 0; _i < 2; ++_i) \
        __builtin_amdgcn_global_load_lds((const unsigned*)((const char*)(gbase) + (voff)[_i]), (PG8_LAS unsigned*)(lds + (bufoff) + ldsw + _i * 8192), 16, 0, 0); } while (0)
#define PG8_LDA(dst, b, h) do { _Pragma("unroll") for (int m = 0; m < 4; ++m) _Pragma("unroll") for (int k = 0; k < 2; ++k) dst[m][k] = *(const PG8_LAS bf16x8*)(lds + PG8_SA(b, h) + aoff + m * 2048 + k * 1024); } while (0)
#define PG8_LDB(dst, b, h) do { _Pragma("unroll") for (int n = 0; n < 2; ++n) _Pragma("unroll") for (int k = 0; k < 2; ++k) dst[n][k] = *(const PG8_LAS bf16x8*)(lds + PG8_SB(b, h) + boff + n * 2048 + k * 1024); } while (0)
#define PG8_MMA(ai, bj, At, Bt) do { __builtin_amdgcn_s_setprio(1); _Pragma("unroll") for (int m = 0; m < 4; ++m) _Pragma("unroll") for (int n = 0; n < 2; ++n) _Pragma("unroll") for (int k = 0; k < 2; ++k) \
        acc[ai][bj][m][n] = __builtin_amdgcn_mfma_f32_16x16x32_bf16(Bt[n][k], At[m][k], acc[ai][bj][m][n], 0, 0, 0); __builtin_amdgcn_s_setprio(0); } while (0)
#define PG8_WAIT_V(n) asm volatile("s_waitcnt vmcnt(" #n ")" ::: "memory")
#define PG8_WAIT_L(n) asm volatile("s_waitcnt lgkmcnt(" #n ")" ::: "memory")
#define PG8_BAR __builtin_amdgcn_s_barrier()
#define PG8_SCHED __builtin_amdgcn_sched_barrier(0)
    Unit cur, nxt; int ui = 0;
    if (!S.next(0, cur)) return;
    f32x4 acc[2][2][4][2];
#pragma unroll
    for (int a = 0; a < 2; ++a)
#pragma unroll
        for (int b = 0; b < 2; ++b)
#pragma unroll
            for (int m = 0; m < 4; ++m)
#pragma unroll
                for (int n = 0; n < 2; ++n) acc[a][b][m][n] = (f32x4){0.f, 0.f, 0.f, 0.f};
    bf16x8 At[4][2], B0[2][2], B1[2][2];
    const char* cA = (const char*)g.A + (size_t)cur.pm * tstep; const char* cB = (const char*)g.Bt + (size_t)cur.pn * tstep;
    S.a_ready(cur);
    if constexpr (SP2) {
        PG8_STAGE(PG8_SB(0, 0), cB, voffB); PG8_STAGE(PG8_SB(0, 1), cB + hstep, voffB); PG8_STAGE(PG8_SA(0, 0), cA, voffA); PG8_STAGE(PG8_SA(0, 1), cA + hstep, voffA);
        if (wr == 1) PG8_BAR;
        PG8_WAIT_V(2); PG8_BAR;
        PG8_STAGE(PG8_SB(1, 0), cB + kstep, voffB); PG8_STAGE(PG8_SA(1, 0), cA + kstep, voffA); PG8_STAGE(PG8_SB(1, 1), cB + hstep + kstep, voffB);
        PG8_WAIT_V(6); PG8_BAR;
    } else {
        PG8_STAGE(PG8_SB(0, 0), cB, voffB); PG8_STAGE(PG8_SA(0, 0), cA, voffA); PG8_STAGE(PG8_SB(0, 1), cB + hstep, voffB); PG8_STAGE(PG8_SA(0, 1), cA + hstep, voffA);
        if (wr == 1) PG8_BAR;
        PG8_WAIT_V(4); PG8_BAR;
        PG8_STAGE(PG8_SB(1, 0), cB + kstep, voffB); PG8_STAGE(PG8_SA(1, 0), cA + kstep, voffA); PG8_STAGE(PG8_SB(1, 1), cB + hstep + kstep, voffB);
        PG8_WAIT_V(6); PG8_BAR;
    }
    for (;;) {
        const bool has_next = S.next(ui + 1, nxt);
        const char* nA = has_next ? (const char*)g.A + (size_t)nxt.pm * tstep : cA; const char* nB = has_next ? (const char*)g.Bt + (size_t)nxt.pn * tstep : cB;
        for (int t = 0; t < nt; t += 2) {
            const bool last = (t == nt - 2);
            const char* a1 = cA + (size_t)(t + 1) * kstep;
            const char* a2 = last ? nA : cA + (size_t)(t + 2) * kstep; const char* b2 = last ? nB : cB + (size_t)(t + 2) * kstep;
            const char* a3 = a2 + kstep; const char* b3 = b2 + kstep;
            if (last && has_next) S.a_ready(nxt);
            if constexpr (Epi::MID) { if (t == E.kmid) { int l2 = lane; asm volatile("" : "+v"(l2)); E.mid(acc, cur, wr, wc, l2 & 15, l2 >> 4); } }
            if constexpr (SP2) {
            PG8_LDB(B0, 0, 0); PG8_LDB(B1, 0, 1); PG8_SCHED; PG8_LDA(At, 0, 0); PG8_STAGE(PG8_SA(1, 1), a1 + hstep, voffA);
            PG8_WAIT_V(8); PG8_WAIT_L(0); PG8_BAR; PG8_MMA(0, 0, At, B0); PG8_MMA(0, 1, At, B1); PG8_BAR; PG8_SCHED;
            PG8_LDA(At, 0, 1); PG8_STAGE(PG8_SB(0, 0), b2, voffB); PG8_STAGE(PG8_SB(0, 1), b2 + hstep, voffB); PG8_STAGE(PG8_SA(0, 0), a2, voffA);
            PG8_WAIT_V(8); PG8_WAIT_L(0); PG8_BAR; PG8_MMA(1, 0, At, B0); PG8_MMA(1, 1, At, B1); PG8_BAR; PG8_SCHED;
            PG8_LDB(B0, 1, 0); PG8_LDB(B1, 1, 1); PG8_SCHED; PG8_LDA(At, 1, 0); PG8_STAGE(PG8_SA(0, 1), a2 + hstep, voffA);
            PG8_WAIT_V(8); PG8_WAIT_L(0); PG8_BAR; PG8_MMA(0, 0, At, B0); PG8_MMA(0, 1, At, B1); PG8_BAR; PG8_SCHED;
            PG8_LDA(At, 1, 1); PG8_STAGE(PG8_SB(1, 0), b3, voffB); PG8_STAGE(PG8_SB(1, 1), b3 + hstep, voffB); PG8_STAGE(PG8_SA(1, 0), a3, voffA);
            PG8_WAIT_V(8); PG8_WAIT_L(0); PG8_BAR; PG8_MMA(1, 0, At, B0); PG8_MMA(1, 1, At, B1); PG8_BAR; PG8_SCHED;
            } else {
            PG8_LDB(B0, 0, 0); PG8_SCHED; PG8_LDA(At, 0, 0); PG8_STAGE(PG8_SA(1, 1), a1 + hstep, voffA);
            PG8_WAIT_L(8); PG8_BAR; PG8_WAIT_L(0); PG8_MMA(0, 0, At, B0); PG8_BAR; PG8_SCHED;
            PG8_LDB(B1, 0, 1); PG8_STAGE(PG8_SB(0, 0), b2, voffB);
            PG8_BAR; PG8_WAIT_L(0); PG8_MMA(0, 1, At, B1); PG8_BAR;
            PG8_LDA(At, 0, 1); PG8_STAGE(PG8_SA(0, 0), a2, voffA);
            PG8_BAR; PG8_WAIT_L(0); PG8_MMA(1, 0, At, B0); PG8_BAR; PG8_SCHED;
            PG8_STAGE(PG8_SB(0, 1), b2 + hstep, voffB);
            PG8_WAIT_V(6); PG8_BAR; PG8_MMA(1, 1, At, B1); PG8_BAR;
            PG8_LDB(B0, 1, 0); PG8_SCHED; PG8_LDA(At, 1, 0); PG8_STAGE(PG8_SA(0, 1), a2 + hstep, voffA);
            PG8_WAIT_L(8); PG8_BAR; PG8_WAIT_L(0); PG8_MMA(0, 0, At, B0); PG8_BAR; PG8_SCHED;
            PG8_LDB(B1, 1, 1); PG8_STAGE(PG8_SB(1, 0), b3, voffB);
            PG8_BAR; PG8_WAIT_L(0); PG8_MMA(0, 1, At, B1); PG8_BAR;
            PG8_LDA(At, 1, 1); PG8_STAGE(PG8_SA(1, 0), a3, voffA);
            PG8_BAR; PG8_WAIT_L(0); PG8_MMA(1, 0, At, B0); PG8_BAR; PG8_SCHED;
            PG8_STAGE(PG8_SB(1, 1), b3 + hstep, voffB);
            PG8_WAIT_V(6); PG8_BAR; PG8_MMA(1, 1, At, B1); PG8_BAR;
            }
        }
        if constexpr (ALIGN_EPI) { if (wr == 0) PG8_BAR; }
        { int l2 = lane; asm volatile("" : "+v"(l2)); E(acc, cur, wr, wc, l2 & 15, l2 >> 4); }
        if (!has_next) break;
#pragma unroll
        for (int a = 0; a < 2; ++a)
#pragma unroll
            for (int b = 0; b < 2; ++b)
#pragma unroll
                for (int m = 0; m < 4; ++m)
#pragma unroll
                    for (int n = 0; n < 2; ++n) acc[a][b][m][n] = (f32x4){0.f, 0.f, 0.f, 0.f};
        cur = nxt; cA = nA; cB = nB; ++ui;
        if constexpr (ALIGN_EPI) { if (wr == 1) PG8_BAR; }
    }
    PG8_WAIT_V(0);
    if constexpr (!ALIGN_EPI) { if (wr == 0) PG8_BAR; }
    PG8_BAR;
#undef PG8_SA
#undef PG8_SB
#undef PG8_STAGE
#undef PG8_LDA
#undef PG8_LDB
#undef PG8_MMA
#undef PG8_WAIT_V
#undef PG8_WAIT_L
#undef PG8_BAR
#undef PG8_SCHED
}
}

using pg8::bf16_t; using pg8::f32x4; using pg8::u32x4; using pg8::Unit; using pg8::cvt_pk_bf16;
#define LAS __attribute__((address_space(3)))
constexpr int NB = 4, SEQ = 4096, T = NB * SEQ, DM = 2048, DIN = 5632, DFF = 5632, DPLE = 256, DEPTH = 2;
constexpr float EPS = 1e-6f;
constexpr float LOG2E = 1.4426950408889634f;
constexpr float QSCALE = 0.125f * LOG2E;
constexpr int NWAVES = 8, NTHR = 512;
constexpr int LDS_BYTES = 147456;

constexpr size_t MiB = 1u << 20;
constexpr size_t WS_STAT = 0;
constexpr size_t WS_LBT = 1536 * 1024;
constexpr size_t WS_BAR = 1600 * 1024;
constexpr size_t WS_CS = 2 * MiB;
constexpr size_t WS_W = 6 * MiB;
constexpr size_t WL_IN = 0, WL_OUT = 22 * MiB, WL_GU = 30 * MiB, WL_DOWN = 74 * MiB, WL_PG = 96 * MiB, WL_PP = 104 * MiB, WL_SIZE = 105 * MiB;
constexpr size_t WS_PBF = 216 * MiB;
constexpr size_t WS_HA = 232 * MiB;
constexpr size_t WS_R = 296 * MiB;
constexpr size_t WS_QH = WS_R, WS_K = WS_R + 64 * MiB, WS_V = WS_R + 72 * MiB, WS_G = WS_R + 80 * MiB, WS_KIN = WS_R + 144 * MiB, WS_HI = WS_R + 176 * MiB, WS_HG = WS_R + 208 * MiB;
constexpr size_t WS_M = WS_G, WS_ACT = WS_R, WS_F = WS_R + 176 * MiB, WS_PP = WS_R;
constexpr size_t WS_DEC = WS_R + 240 * MiB;
constexpr size_t WS_END = WS_DEC + 1 * MiB;
enum { SQ_X = 0, SQ_A = 2, SQ_M = 4, SQ_2 = 6, SQ_F = 8, SQ_3 = 10 };

__constant__ double c_invf[32] = {1.0, 0.7498942093324559, 0.5623413251903491, 0.4216965034285822, 0.31622776601683794, 0.23713737056616552, 0.1778279410038923, 0.1333521432163324, 0.09999999999999999, 0.07498942093324558, 0.056234132519034905, 0.042169650342858224, 0.03162277660168379, 0.023713737056616554, 0.01778279410038923, 0.013335214321633239, 0.01, 0.007498942093324559, 0.005623413251903491, 0.004216965034285822, 0.0031622776601683794, 0.002371373705661655, 0.0017782794100389228, 0.0013335214321633238, 0.001, 0.0007498942093324559, 0.000562341325190349, 0.00042169650342858224, 0.00031622776601683794, 0.00023713737056616554, 0.0001778279410038923, 0.0001333521432163324};

__device__ __forceinline__ float bf2f(unsigned h) { return __uint_as_float(h << 16); }
__device__ __forceinline__ float bflo(unsigned w) { return __uint_as_float(w << 16); }
__device__ __forceinline__ float bfhi(unsigned w) { return __uint_as_float(w & 0xffff0000u); }
__device__ __forceinline__ unsigned f2bf(float f) { unsigned u = __float_as_uint(f); return (u + 0x7fffu + ((u >> 16) & 1u)) >> 16; }
__device__ __forceinline__ unsigned pk2(float lo, float hi) { return f2bf(lo) | (f2bf(hi) << 16); }
__device__ __forceinline__ float shx(float v, int lane, int m) { return __int_as_float(__builtin_amdgcn_ds_bpermute((lane ^ m) << 2, __float_as_int(v))); }
__device__ __forceinline__ float wave_sum(float v, int lane) {
#pragma unroll
    for (int o = 1; o < 64; o <<= 1) v += shx(v, lane, o);
    return v;
}
typedef unsigned long long u64;
__device__ __forceinline__ u64 fx_enc(float q) { return (u64)__float2ll_rn(q * 16777216.0f); }
__device__ __forceinline__ float fx_dec(u64 v) { return __ll2float_rn((long long)v) * (1.0f / 16777216.0f); }
__device__ __forceinline__ void fx_add(u64* p, float q) { atomicAdd(p, fx_enc(q)); }
__device__ __forceinline__ float sigmoidf_(float z) { return 1.0f / (1.0f + __expf(-z)); }
__device__ __forceinline__ float siluf_(float z) { return z / (1.0f + __expf(-z)); }

struct EpiIn {
    static constexpr bool PERM = true, MID = false;
    int kmid;
    const u64* ssqX; const float* cs; const float* lb;
    bf16_t* QH; bf16_t* Kb; bf16_t* Vb; float* G; bf16_t* KIN; bf16_t* HI; bf16_t* HG;
    __device__ __forceinline__ void mid(f32x4 (&acc)[2][2][4][2], const Unit& u, int wr, int wc, int fr, int fq) const {}
    __device__ __forceinline__ void operator()(const f32x4 (&acc)[2][2][4][2], const Unit& u, int wr, int wc, int fr, int fq) const {
        const int pn = u.pn;
#pragma unroll
        for (int ai = 0; ai < 2; ++ai)
#pragma unroll
            for (int m = 0; m < 4; ++m) {
                const int row = u.pm * 256 + ai * 128 + wr * 64 + m * 16 + fr;
                const float rs = rsqrtf(fx_dec(ssqX[row]) * (1.0f / DM) + EPS);
                if (pn <= 4) {
                    const int d0 = 8 * fq;
                    const f32x4 c0 = *(const f32x4*)(cs + (size_t)row * 64 + d0), c1 = *(const f32x4*)(cs + (size_t)row * 64 + d0 + 4);
                    const f32x4 s0 = *(const f32x4*)(cs + (size_t)row * 64 + 32 + d0), s1 = *(const f32x4*)(cs + (size_t)row * 64 + 32 + d0 + 4);
                    const float sc = (pn < 4) ? rs * QSCALE : rs;
                    const f32x4 a0 = acc[ai][0][m][0] * sc, a1 = acc[ai][0][m][1] * sc, b0 = acc[ai][1][m][0] * sc, b1 = acc[ai][1][m][1] * sc;
                    const f32x4 o10 = a0 * c0 - b0 * s0, o11 = a1 * c1 - b1 * s1, o20 = b0 * c0 + a0 * s0, o21 = b1 * c1 + a1 * s1;
                    u32x4 w1, w2;
                    w1.x = cvt_pk_bf16(o10[0], o10[1]); w1.y = cvt_pk_bf16(o10[2], o10[3]); w1.z = cvt_pk_bf16(o11[0], o11[1]); w1.w = cvt_pk_bf16(o11[2], o11[3]);
                    w2.x = cvt_pk_bf16(o20[0], o20[1]); w2.y = cvt_pk_bf16(o20[2], o20[3]); w2.z = cvt_pk_bf16(o21[0], o21[1]); w2.w = cvt_pk_bf16(o21[2], o21[3]);
                    bf16_t* dst = (pn < 4) ? (QH + (size_t)row * 2048 + (pn * 4 + wc) * 64 + d0) : (Kb + (size_t)row * 256 + wc * 64 + d0);
                    *(u32x4*)dst = w1; *(u32x4*)(dst + 32) = w2;
                } else {
#pragma unroll
                    for (int bj = 0; bj < 2; ++bj) {
                        const int cl = bj * 128 + wc * 32 + 8 * fq;
                        f32x4 v0 = acc[ai][bj][m][0] * rs, v1 = acc[ai][bj][m][1] * rs;
                        if (pn == 5) {
                            u32x4 w; w.x = cvt_pk_bf16(v0[0], v0[1]); w.y = cvt_pk_bf16(v0[2], v0[3]); w.z = cvt_pk_bf16(v1[0], v1[1]); w.w = cvt_pk_bf16(v1[2], v1[3]);
                            *(u32x4*)(Vb + (size_t)row * 256 + cl) = w;
                        } else if (pn < 10) {
                            const int c = (pn - 6) * 256 + cl;
#pragma unroll
                            for (int j = 0; j < 4; ++j) { v0[j] = siluf_(v0[j]); v1[j] = siluf_(v1[j]); }
                            u32x4 w; w.x = cvt_pk_bf16(v0[0], v0[1]); w.y = cvt_pk_bf16(v0[2], v0[3]); w.z = cvt_pk_bf16(v1[0], v1[1]); w.w = cvt_pk_bf16(v1[2], v1[3]);
                            *(u32x4*)(QH + (size_t)row * 2048 + 1024 + c) = w;
                        } else if (pn < 14) {
                            const int c = (pn - 10) * 256 + cl;
                            const f32x4 l0 = *(const f32x4*)(lb + c), l1 = *(const f32x4*)(lb + c + 4);
                            f32x4 g0, g1, k0, k1;
#pragma unroll
                            for (int j = 0; j < 4; ++j) {
                                { const float z = fminf(fmaxf(v0[j], -30.f), 30.f), e = __expf(-z), sg = 1.0f / (1.0f + e), om = 1.0f - l0[j]; g0[j] = __logf(l0[j] + om * sg); k0[j] = om * e * sg; }
                                { const float z = fminf(fmaxf(v1[j], -30.f), 30.f), e = __expf(-z), sg = 1.0f / (1.0f + e), om = 1.0f - l1[j]; g1[j] = __logf(l1[j] + om * sg); k1[j] = om * e * sg; }
                            }
                            *(f32x4*)(G + (size_t)row * 1024 + c) = g0; *(f32x4*)(G + (size_t)row * 1024 + c + 4) = g1;
                            u32x4 w; w.x = cvt_pk_bf16(k0[0], k0[1]); w.y = cvt_pk_bf16(k0[2], k0[3]); w.z = cvt_pk_bf16(k1[0], k1[1]); w.w = cvt_pk_bf16(k1[2], k1[3]);
                            *(u32x4*)(KIN + (size_t)row * 1024 + c) = w;
                        } else if (pn < 18) {
                            const int c = (pn - 14) * 256 + cl;
                            u32x4 w; w.x = cvt_pk_bf16(v0[0], v0[1]); w.y = cvt_pk_bf16(v0[2], v0[3]); w.z = cvt_pk_bf16(v1[0], v1[1]); w.w = cvt_pk_bf16(v1[2], v1[3]);
                            *(u32x4*)(HI + (size_t)row * 1024 + c) = w;
                        } else {
                            const int c = (pn - 18) * 256 + cl;
#pragma unroll
                            for (int j = 0; j < 4; ++j) { v0[j] = siluf_(v0[j]); v1[j] = siluf_(v1[j]); }
                            u32x4 w; w.x = cvt_pk_bf16(v0[0], v0[1]); w.y = cvt_pk_bf16(v0[2], v0[3]); w.z = cvt_pk_bf16(v1[0], v1[1]); w.w = cvt_pk_bf16(v1[2], v1[3]);
                            *(u32x4*)(HG + (size_t)row * 1024 + c) = w;
                        }
                    }
                }
                asm volatile("" ::: "memory");
            }
    }
};

template <bool MIDS> struct EpiRowSsq {
    static constexpr bool PERM = true, MID = MIDS;
    int kmid;
    bf16_t* O; u64* ssq; const u64* ssqA;
    __device__ __forceinline__ void mid(f32x4 (&acc)[2][2][4][2], const Unit& u, int wr, int wc, int fr, int fq) const {
#pragma unroll
        for (int ai = 0; ai < 2; ++ai)
#pragma unroll
            for (int m = 0; m < 4; ++m) {
                const int row = u.pm * 256 + ai * 128 + wr * 64 + m * 16 + fr;
                const float s = rsqrtf(fx_dec(ssqA[row]) * (1.0f / 1024.0f) + EPS);
#pragma unroll
                for (int bj = 0; bj < 2; ++bj)
#pragma unroll
                    for (int n = 0; n < 2; ++n) acc[ai][bj][m][n] = acc[ai][bj][m][n] * s;
            }
    }
    __device__ __forceinline__ void operator()(const f32x4 (&acc)[2][2][4][2], const Unit& u, int wr, int wc, int fr, int fq) const {
#pragma unroll
        for (int ai = 0; ai < 2; ++ai)
#pragma unroll
            for (int m = 0; m < 4; ++m) {
                const int row = u.pm * 256 + ai * 128 + wr * 64 + m * 16 + fr;
                float q = 0.f;
#pragma unroll
                for (int bj = 0; bj < 2; ++bj) {
                    const f32x4 v0 = acc[ai][bj][m][0], v1 = acc[ai][bj][m][1];
                    q += (v0[0] * v0[0] + v0[1] * v0[1]) + (v0[2] * v0[2] + v0[3] * v0[3]) + (v1[0] * v1[0] + v1[1] * v1[1]) + (v1[2] * v1[2] + v1[3] * v1[3]);
                    u32x4 w; w.x = cvt_pk_bf16(v0[0], v0[1]); w.y = cvt_pk_bf16(v0[2], v0[3]); w.z = cvt_pk_bf16(v1[0], v1[1]); w.w = cvt_pk_bf16(v1[2], v1[3]);
                    *(u32x4*)(O + (size_t)row * 2048 + u.pn * 256 + bj * 128 + wc * 32 + 8 * fq) = w;
                }
                q += shx(q, fq * 16 + fr, 16); q += shx(q, fq * 16 + fr, 32);
                if (fq == 0) fx_add(ssq + row, q);
                asm volatile("" ::: "memory");
            }
    }
};

struct EpiGU {
    static constexpr bool PERM = true, MID = false;
    int kmid;
    const u64* ssq2; bf16_t* ACT;
    __device__ __forceinline__ void mid(f32x4 (&acc)[2][2][4][2], const Unit& u, int wr, int wc, int fr, int fq) const {}
    __device__ __forceinline__ void operator()(const f32x4 (&acc)[2][2][4][2], const Unit& u, int wr, int wc, int fr, int fq) const {
#pragma unroll
        for (int ai = 0; ai < 2; ++ai)
#pragma unroll
            for (int m = 0; m < 4; ++m) {
                const int row = u.pm * 256 + ai * 128 + wr * 64 + m * 16 + fr;
                const float rs = rsqrtf(fx_dec(ssq2[row]) * (1.0f / DM) + EPS);
                f32x4 o0, o1;
#pragma unroll
                for (int j = 0; j < 4; ++j) {
                    const float g0 = acc[ai][0][m][0][j] * rs, u0 = acc[ai][1][m][0][j] * rs, g1 = acc[ai][0][m][1][j] * rs, u1 = acc[ai][1][m][1][j] * rs;
                    o0[j] = siluf_(g0) * u0; o1[j] = siluf_(g1) * u1;
                }
                u32x4 w; w.x = cvt_pk_bf16(o0[0], o0[1]); w.y = cvt_pk_bf16(o0[2], o0[3]); w.z = cvt_pk_bf16(o1[0], o1[1]); w.w = cvt_pk_bf16(o1[2], o1[3]);
                *(u32x4*)(ACT + (size_t)row * DFF + u.pn * 128 + wc * 32 + 8 * fq) = w;
                asm volatile("" ::: "memory");
            }
    }
};

struct EpiPlain {
    static constexpr bool PERM = true, MID = false;
    int kmid;
    bf16_t* O;
    __device__ __forceinline__ void mid(f32x4 (&acc)[2][2][4][2], const Unit& u, int wr, int wc, int fr, int fq) const {}
    __device__ __forceinline__ void operator()(const f32x4 (&acc)[2][2][4][2], const Unit& u, int wr, int wc, int fr, int fq) const {
#pragma unroll
        for (int ai = 0; ai < 2; ++ai)
#pragma unroll
            for (int m = 0; m < 4; ++m) {
                const int row = u.pm * 256 + ai * 128 + wr * 64 + m * 16 + fr;
#pragma unroll
                for (int bj = 0; bj < 2; ++bj) {
                    const f32x4 v0 = acc[ai][bj][m][0], v1 = acc[ai][bj][m][1];
                    u32x4 w; w.x = cvt_pk_bf16(v0[0], v0[1]); w.y = cvt_pk_bf16(v0[2], v0[3]); w.z = cvt_pk_bf16(v1[0], v1[1]); w.w = cvt_pk_bf16(v1[2], v1[3]);
                    *(u32x4*)(O + (size_t)row * 2048 + u.pn * 256 + bj * 128 + wc * 32 + 8 * fq) = w;
                }
                asm volatile("" ::: "memory");
            }
    }
};

struct EpiPle {
    static constexpr bool PERM = true, MID = false;
    int kmid;
    const u64* ssq3; const bf16_t* PP; const bf16_t* XB; float* OUT; bf16_t* HAn; u64* ssqN; int has_next;
    __device__ __forceinline__ void mid(f32x4 (&acc)[2][2][4][2], const Unit& u, int wr, int wc, int fr, int fq) const {}
    __device__ __forceinline__ void operator()(const f32x4 (&acc)[2][2][4][2], const Unit& u, int wr, int wc, int fr, int fq) const {
#pragma unroll
        for (int ai = 0; ai < 2; ++ai)
#pragma unroll
            for (int m = 0; m < 4; ++m) {
                const int row = u.pm * 256 + ai * 128 + wr * 64 + m * 16 + fr;
                const float rs = rsqrtf(fx_dec(ssq3[row]) * (1.0f / DM) + EPS);
                float q = 0.f;
#pragma unroll
                for (int bj = 0; bj < 2; ++bj) {
                    const size_t off = (size_t)row * 2048 + u.pn * 256 + bj * 128 + wc * 32 + 8 * fq;
                    const u32x4 pw = *(const u32x4*)(PP + off); const u32x4 xv = *(const u32x4*)(XB + off);
                    f32x4 x0 = (f32x4){bflo(xv.x), bfhi(xv.x), bflo(xv.y), bfhi(xv.y)}, x1 = (f32x4){bflo(xv.z), bfhi(xv.z), bflo(xv.w), bfhi(xv.w)};
                    const f32x4 v0 = acc[ai][bj][m][0] * rs, v1 = acc[ai][bj][m][1] * rs;
                    x0[0] += bflo(pw.x) * sigmoidf_(v0[0]); x0[1] += bfhi(pw.x) * sigmoidf_(v0[1]); x0[2] += bflo(pw.y) * sigmoidf_(v0[2]); x0[3] += bfhi(pw.y) * sigmoidf_(v0[3]);
                    x1[0] += bflo(pw.z) * sigmoidf_(v1[0]); x1[1] += bfhi(pw.z) * sigmoidf_(v1[1]); x1[2] += bflo(pw.w) * sigmoidf_(v1[2]); x1[3] += bfhi(pw.w) * sigmoidf_(v1[3]);
                    if (has_next) {
                        q += (x0[0] * x0[0] + x0[1] * x0[1]) + (x0[2] * x0[2] + x0[3] * x0[3]) + (x1[0] * x1[0] + x1[1] * x1[1]) + (x1[2] * x1[2] + x1[3] * x1[3]);
                        u32x4 w; w.x = cvt_pk_bf16(x0[0], x0[1]); w.y = cvt_pk_bf16(x0[2], x0[3]); w.z = cvt_pk_bf16(x1[0], x1[1]); w.w = cvt_pk_bf16(x1[2], x1[3]);
                        *(u32x4*)(HAn + off) = w;
                    } else { *(f32x4*)(OUT + off) = x0; *(f32x4*)(OUT + off + 4) = x1; }
                }
                if (has_next) { q += shx(q, fq * 16 + fr, 16); q += shx(q, fq * 16 + fr, 32); if (fq == 0) fx_add(ssqN + row, q); }
                asm volatile("" ::: "memory");
            }
    }
};

__device__ __forceinline__ void tr_item(const float* W, int ldw, int K, int k0, int n0, bf16_t* WT, int prow0, const float* gain, LAS float* scr, int lane) {
    f32x4 v[8];
#pragma unroll
    for (int i = 0; i < 8; ++i) { const int kk = 8 * i + (lane >> 3); v[i] = *(const f32x4*)(W + (size_t)(k0 + kk) * ldw + n0 + 4 * (lane & 7)); }
#pragma unroll
    for (int i = 0; i < 8; ++i) { const int kk = 8 * i + (lane >> 3); const float gsc = gain ? gain[k0 + kk] : 1.0f; LAS float* d = scr + kk * 33 + 4 * (lane & 7);
        d[0] = v[i][0] * gsc; d[1] = v[i][1] * gsc; d[2] = v[i][2] * gsc; d[3] = v[i][3] * gsc; }
    asm volatile("s_waitcnt lgkmcnt(0)" ::: "memory");
    const int c = lane & 7;
#pragma unroll
    for (int j = 0; j < 4; ++j) { const int n = (lane >> 3) + 8 * j; const LAS float* s = scr + (8 * c) * 33 + n;
        u32x4 o; o.x = pk2(s[0 * 33], s[1 * 33]); o.y = pk2(s[2 * 33], s[3 * 33]); o.z = pk2(s[4 * 33], s[5 * 33]); o.w = pk2(s[6 * 33], s[7 * 33]);
        *(u32x4*)(WT + (size_t)(prow0 + n) * K + k0 + 8 * c) = o; }
    asm volatile("s_waitcnt lgkmcnt(0)" ::: "memory");
}

struct Args { const void* in[19]; float* out; unsigned char* ws; };

template <bool SRC_F32>
__device__ __forceinline__ void row_phase(const float* xsrc32, const bf16_t* xsrc16, const bf16_t* Mb, const u64* ssqIn, const float* gain, bf16_t* XB, u64* ssqOut, int gw, int ngw, int lane) {
    for (int row = gw; row < T; row += ngw) {
        const float rm = rsqrtf(fx_dec(ssqIn[row]) * (1.0f / DM) + EPS);
        float ss = 0.f;
#pragma unroll
        for (int j = 0; j < 4; ++j) {
            const int c = j * 512 + lane * 8; const size_t off = (size_t)row * 2048 + c;
            const u32x4 mv = *(const u32x4*)(Mb + off);
            f32x4 x0, x1;
            if (SRC_F32) { x0 = *(const f32x4*)(xsrc32 + off); x1 = *(const f32x4*)(xsrc32 + off + 4); }
            else { const u32x4 xv = *(const u32x4*)(xsrc16 + off); x0 = (f32x4){bflo(xv.x), bfhi(xv.x), bflo(xv.y), bfhi(xv.y)}; x1 = (f32x4){bflo(xv.z), bfhi(xv.z), bflo(xv.w), bfhi(xv.w)}; }
            const f32x4 g0 = *(const f32x4*)(gain + c), g1 = *(const f32x4*)(gain + c + 4);
            x0[0] += bflo(mv.x) * rm * g0[0]; x0[1] += bfhi(mv.x) * rm * g0[1]; x0[2] += bflo(mv.y) * rm * g0[2]; x0[3] += bfhi(mv.y) * rm * g0[3];
            x1[0] += bflo(mv.z) * rm * g1[0]; x1[1] += bfhi(mv.z) * rm * g1[1]; x1[2] += bflo(mv.w) * rm * g1[2]; x1[3] += bfhi(mv.w) * rm * g1[3];
            u32x4 w; w.x = pk2(x0[0], x0[1]); w.y = pk2(x0[2], x0[3]); w.z = pk2(x1[0], x1[1]); w.w = pk2(x1[2], x1[3]);
            *(u32x4*)(XB + off) = w;
            ss += (x0[0] * x0[0] + x0[1] * x0[1]) + (x0[2] * x0[2] + x0[3] * x0[3]) + (x1[0] * x1[0] + x1[1] * x1[1]) + (x1[2] * x1[2] + x1[3] * x1[3]);
        }
        ss = wave_sum(ss, lane);
        if (lane == 0) ssqOut[row] = fx_enc(ss);
    }
}

__device__ __forceinline__ void attn_naive(bf16_t* QH, const bf16_t* Kb, const bf16_t* Vb, const float* sinks, u64* ssqA, int gtid, int nthr) {
    for (int item = gtid; item < T * 16; item += nthr) {
        const int head = item / T, row = item % T, b = row / SEQ, t = row % SEQ, hk = head >> 2;
        float q[64], acc[64];
        const u32x4* qp = (const u32x4*)(QH + (size_t)row * 2048 + head * 64);
#pragma unroll
        for (int c = 0; c < 8; ++c) { const u32x4 w = qp[c]; q[8 * c] = bflo(w.x); q[8 * c + 1] = bfhi(w.x); q[8 * c + 2] = bflo(w.y); q[8 * c + 3] = bfhi(w.y); q[8 * c + 4] = bflo(w.z); q[8 * c + 5] = bfhi(w.z); q[8 * c + 6] = bflo(w.w); q[8 * c + 7] = bfhi(w.w); }
#pragma unroll
        for (int d = 0; d < 64; ++d) acc[d] = 0.f;
        float mx = sinks[head] * LOG2E, l = 1.0f;
        const int j0 = t - 127 < 0 ? 0 : t - 127;
        for (int j = j0; j <= t; ++j) {
            const size_t kr = (size_t)(b * SEQ + j) * 256 + hk * 64;
            const u32x4* kp = (const u32x4*)(Kb + kr);
            float s = 0.f;
#pragma unroll
            for (int c = 0; c < 8; ++c) { const u32x4 w = kp[c]; s += q[8 * c] * bflo(w.x) + q[8 * c + 1] * bfhi(w.x) + q[8 * c + 2] * bflo(w.y) + q[8 * c + 3] * bfhi(w.y) + q[8 * c + 4] * bflo(w.z) + q[8 * c + 5] * bfhi(w.z) + q[8 * c + 6] * bflo(w.w) + q[8 * c + 7] * bfhi(w.w); }
            if (s > mx) { const float cf = exp2f(mx - s); l *= cf;
#pragma unroll
                for (int d = 0; d < 64; ++d) acc[d] *= cf;
                mx = s; }
            const float p = exp2f(s - mx); l += p;
            const u32x4* vp = (const u32x4*)(Vb + kr);
#pragma unroll
            for (int c = 0; c < 8; ++c) { const u32x4 w = vp[c]; acc[8 * c] += p * bflo(w.x); acc[8 * c + 1] += p * bfhi(w.x); acc[8 * c + 2] += p * bflo(w.y); acc[8 * c + 3] += p * bfhi(w.y); acc[8 * c + 4] += p * bflo(w.z); acc[8 * c + 5] += p * bfhi(w.z); acc[8 * c + 6] += p * bflo(w.w); acc[8 * c + 7] += p * bfhi(w.w); }
        }
        const float il = 1.0f / l; float ss = 0.f;
        u32x4* op = (u32x4*)(QH + (size_t)row * 2048 + head * 64);
#pragma unroll
        for (int c = 0; c < 8; ++c) {
            float o[8];
#pragma unroll
            for (int e = 0; e < 8; ++e) { o[e] = acc[8 * c + e] * il; ss += o[e] * o[e]; }
            u32x4 w; w.x = pk2(o[0], o[1]); w.y = pk2(o[2], o[3]); w.z = pk2(o[4], o[5]); w.w = pk2(o[6], o[7]); op[c] = w;
        }
        fx_add(ssqA + row, ss);
    }
}

__device__ __forceinline__ void hgrn_naive(const bf16_t* QH, const bf16_t* KIN, const float* G, const bf16_t* HI, float* tmpO, int item, int lane) {
    const int bh = item >> 1, b = bh >> 3, h = bh & 7, v = (item & 1) * 64 + lane;
    float S[128];
#pragma unroll
    for (int k = 0; k < 128; ++k) S[k] = 0.f;
    int z = 0; asm volatile("v_mov_b32 %0, 0" : "=v"(z));
    for (int t = 0; t < SEQ; ++t) {
        const size_t row = (size_t)b * SEQ + t;
        const float vv = bf2f(HI[row * 1024 + h * 128 + v]);
        const u32x4* qp = (const u32x4*)(QH + row * 2048 + 1024 + h * 128 + z);
        const u32x4* kp = (const u32x4*)(KIN + row * 1024 + h * 128 + z);
        const f32x4* gp = (const f32x4*)(G + row * 1024 + h * 128 + z);
        float o = 0.f;
#pragma unroll
        for (int c = 0; c < 16; ++c) {
            const u32x4 qw = qp[c], kw = kp[c]; const f32x4 g0 = gp[2 * c], g1 = gp[2 * c + 1];
            const float qq[8] = {bflo(qw.x), bfhi(qw.x), bflo(qw.y), bfhi(qw.y), bflo(qw.z), bfhi(qw.z), bflo(qw.w), bfhi(qw.w)};
            const float kk[8] = {bflo(kw.x), bfhi(kw.x), bflo(kw.y), bfhi(kw.y), bflo(kw.z), bfhi(kw.z), bflo(kw.w), bfhi(kw.w)};
            const float gg[8] = {g0[0], g0[1], g0[2], g0[3], g1[0], g1[1], g1[2], g1[3]};
#pragma unroll
            for (int e = 0; e < 8; ++e) { const float f = __expf(gg[e]); S[8 * c + e] = f * S[8 * c + e] + kk[e] * vv; o += S[8 * c + e] * qq[e]; }
        }
        tmpO[row * 1024 + h * 128 + v] = o;
    }
}
__device__ __forceinline__ void hgrn_norm_naive(const float* tmpO, const bf16_t* HG, bf16_t* QH, int gw, int ngw, int lane) {
    for (int row = gw; row < T; row += ngw) {
        const size_t off = (size_t)row * 1024 + lane * 16;
        f32x4 o[4]; float ss = 0.f;
#pragma unroll
        for (int j = 0; j < 4; ++j) { o[j] = *(const f32x4*)(tmpO + off + 4 * j); ss += (o[j][0] * o[j][0] + o[j][1] * o[j][1]) + (o[j][2] * o[j][2] + o[j][3] * o[j][3]); }
        ss += shx(ss, lane, 1); ss += shx(ss, lane, 2); ss += shx(ss, lane, 4);
        const float r = rsqrtf(ss * (1.0f / 128.0f) + EPS);
        const u32x4 g0 = *(const u32x4*)(HG + off), g1 = *(const u32x4*)(HG + off + 8);
        u32x4 w0, w1;
        w0.x = pk2(o[0][0] * r * bflo(g0.x), o[0][1] * r * bfhi(g0.x)); w0.y = pk2(o[0][2] * r * bflo(g0.y), o[0][3] * r * bfhi(g0.y));
        w0.z = pk2(o[1][0] * r * bflo(g0.z), o[1][1] * r * bfhi(g0.z)); w0.w = pk2(o[1][2] * r * bflo(g0.w), o[1][3] * r * bfhi(g0.w));
        w1.x = pk2(o[2][0] * r * bflo(g1.x), o[2][1] * r * bfhi(g1.x)); w1.y = pk2(o[2][2] * r * bflo(g1.y), o[2][3] * r * bfhi(g1.y));
        w1.z = pk2(o[3][0] * r * bflo(g1.z), o[3][1] * r * bfhi(g1.z)); w1.w = pk2(o[3][2] * r * bflo(g1.w), o[3][3] * r * bfhi(g1.w));
        bf16_t* dst = QH + (size_t)row * 2048 + 1024 + lane * 16;
        *(u32x4*)dst = w0; *(u32x4*)(dst + 8) = w1;
    }
}


typedef float f32x16 __attribute__((ext_vector_type(16)));
typedef short bf16x8 __attribute__((ext_vector_type(8)));
typedef unsigned u32x2 __attribute__((ext_vector_type(2)));
__device__ __forceinline__ int crow(int r, int hi) { return (r & 3) + 8 * (r >> 2) + 4 * hi; }
__device__ __forceinline__ bf16x8 pack8(float a0, float a1, float a2, float a3, float a4, float a5, float a6, float a7) {
    u32x4 w; w.x = cvt_pk_bf16(a0, a1); w.y = cvt_pk_bf16(a2, a3); w.z = cvt_pk_bf16(a4, a5); w.w = cvt_pk_bf16(a6, a7); return __builtin_bit_cast(bf16x8, w);
}
constexpr int AT_KSTR = 144, AT_VSTR = 528, AT_VOFF = 256 * AT_KSTR;

__device__ __forceinline__ void attn_unit(LAS unsigned char* lds, bf16_t* QH, const bf16_t* Kb, const bf16_t* Vb, const float* sinks, u64* ssqA, int unit, int tid, int lane, int wave) {
    const int hk = unit & 3, n = (unit >> 2) & 31, b = unit >> 7;
    const long rowbase = (long)b * SEQ + n * 128 - 128;
    LAS unsigned char* Ks = lds; LAS unsigned char* Vt = lds + AT_VOFF;
#pragma unroll
    for (int i = 0; i < 4; ++i) {
        const int row = (tid >> 3) + 64 * i; u32x4 v = (u32x4){0u, 0u, 0u, 0u};
        if (n > 0 || row >= 128) v = *(const u32x4*)(Kb + (rowbase + row) * 256 + hk * 64 + (tid & 7) * 8);
        *(LAS u32x4*)(Ks + row * AT_KSTR + (tid & 7) * 16) = v;
    }
#pragma unroll
    for (int i = 0; i < 4; ++i) {
        const int key = lane + 64 * i; u32x4 v = (u32x4){0u, 0u, 0u, 0u};
        if (n > 0 || key >= 128) v = *(const u32x4*)(Vb + (rowbase + key) * 256 + hk * 64 + wave * 8);
        LAS unsigned short* vp = (LAS unsigned short*)(Vt + (wave * 8) * AT_VSTR + key * 2);
        vp[0 * 264] = (unsigned short)(v.x & 0xffffu); vp[1 * 264] = (unsigned short)(v.x >> 16); vp[2 * 264] = (unsigned short)(v.y & 0xffffu); vp[3 * 264] = (unsigned short)(v.y >> 16);
        vp[4 * 264] = (unsigned short)(v.z & 0xffffu); vp[5 * 264] = (unsigned short)(v.z >> 16); vp[6 * 264] = (unsigned short)(v.w & 0xffffu); vp[7 * 264] = (unsigned short)(v.w >> 16);
    }
    __syncthreads();
    const int g = wave >> 1, qh = wave & 1, head = hk * 4 + g, r = lane & 31, h = lane >> 5;
    const float sink2 = sinks[head] * LOG2E;
    for (int qt = 0; qt < 2; ++qt) {
        const int t0 = 64 * qh + 32 * qt, t = t0 + r;
        const size_t qrow = (size_t)b * SEQ + n * 128 + t;
        bf16_t* qp = QH + qrow * 2048 + head * 64;
        bf16x8 qf[4];
#pragma unroll
        for (int s4 = 0; s4 < 4; ++s4) qf[s4] = *(const bf16x8*)(qp + 16 * s4 + 8 * h);
        f32x16 S[5];
#pragma unroll
        for (int jt = 0; jt < 5; ++jt) {
            const int kb = t0 + 32 * jt;
            f32x16 a = {};
#pragma unroll
            for (int s4 = 0; s4 < 4; ++s4) { const bf16x8 kf = *(const LAS bf16x8*)(Ks + (kb + r) * AT_KSTR + (16 * s4 + 8 * h) * 2); a = __builtin_amdgcn_mfma_f32_32x32x16_bf16(kf, qf[s4], a, 0, 0, 0); }
            S[jt] = a;
        }
        float mx = sink2;
#pragma unroll
        for (int jt = 0; jt < 5; ++jt)
#pragma unroll
            for (int rg = 0; rg < 16; ++rg) {
                const int ki = t0 + 32 * jt + crow(rg, h);
                const bool ok = (ki > t) && (ki <= t + 128) && (n > 0 || ki >= 128);
                const float v = ok ? S[jt][rg] : -1e30f; S[jt][rg] = v; mx = fmaxf(mx, v);
            }
        mx = fmaxf(mx, shx(mx, lane, 32));
        float l = 0.f;
#pragma unroll
        for (int jt = 0; jt < 5; ++jt)
#pragma unroll
            for (int rg = 0; rg < 16; ++rg) { const float p = __builtin_amdgcn_exp2f(S[jt][rg] - mx); S[jt][rg] = p; l += p; }
        l += shx(l, lane, 32);
        l += __builtin_amdgcn_exp2f(sink2 - mx);
        f32x16 O[2]; O[0] = (f32x16){}; O[1] = (f32x16){};
#pragma unroll
        for (int jt = 0; jt < 5; ++jt)
#pragma unroll
            for (int sp = 0; sp < 2; ++sp) {
                const bf16x8 pf = pack8(S[jt][8 * sp], S[jt][8 * sp + 1], S[jt][8 * sp + 2], S[jt][8 * sp + 3], S[jt][8 * sp + 4], S[jt][8 * sp + 5], S[jt][8 * sp + 6], S[jt][8 * sp + 7]);
                const int kk = t0 + 32 * jt + 16 * sp + 4 * h;
#pragma unroll
                for (int dt = 0; dt < 2; ++dt) {
                    const LAS unsigned char* vrow = Vt + (32 * dt + r) * AT_VSTR + kk * 2;
                    const u32x2 lo = *(const LAS u32x2*)vrow, hi2 = *(const LAS u32x2*)(vrow + 16);
                    u32x4 w; w.x = lo.x; w.y = lo.y; w.z = hi2.x; w.w = hi2.y;
                    O[dt] = __builtin_amdgcn_mfma_f32_32x32x16_bf16(__builtin_bit_cast(bf16x8, w), pf, O[dt], 0, 0, 0);
                }
            }
        const float il = 1.0f / l; float ss = 0.f;
#pragma unroll
        for (int dt = 0; dt < 2; ++dt)
#pragma unroll
            for (int gp = 0; gp < 4; ++gp) {
                const float o0 = O[dt][4 * gp] * il, o1 = O[dt][4 * gp + 1] * il, o2 = O[dt][4 * gp + 2] * il, o3 = O[dt][4 * gp + 3] * il;
                ss += (o0 * o0 + o1 * o1) + (o2 * o2 + o3 * o3);
                u32x2 w; w.x = cvt_pk_bf16(o0, o1); w.y = cvt_pk_bf16(o2, o3);
                *(u32x2*)(qp + 32 * dt + 8 * gp + 4 * h) = w;
            }
        ss += shx(ss, lane, 32);
        if (h == 0) fx_add(ssqA + qrow, ss);
    }
    __syncthreads();
}

#define LBAR() asm volatile("s_waitcnt lgkmcnt(0)\n\ts_barrier" ::: "memory")
constexpr int HG_STR = 144;
__device__ __forceinline__ void hgrn_h1_phase(LAS unsigned char* lds, const bf16_t* KIN, const float* G, const bf16_t* HI, bf16_t* SB, float* DEC, int bx, int Gd, int tid, int lane, int wave) {
    LAS unsigned char* Kt = lds;
    LAS unsigned char* Vt = lds + 128 * HG_STR;
    LAS float* tot = (LAS float*)(lds + 2 * 128 * HG_STR);
    const int k = tid & 127, sg = tid >> 7;
    float g[16]; unsigned kr[16], vr[16];
#define H1_LOAD(U) do { const int c_ = (U) & 63, bh_ = (U) >> 6; const size_t r0_ = (size_t)(bh_ >> 3) * SEQ + c_ * 64 + sg * 16; const int col_ = (bh_ & 7) * 128 + k; \
        _Pragma("unroll") for (int i = 0; i < 16; ++i) { g[i] = G[(r0_ + i) * 1024 + col_]; kr[i] = KIN[(r0_ + i) * 1024 + col_]; vr[i] = HI[(r0_ + i) * 1024 + col_]; } } while (0)
    int u = bx;
    if (u < 2048) H1_LOAD(u);
    for (; u < 2048; u += Gd) {
        float bl[16]; float run = 0.f;
#pragma unroll
        for (int i = 0; i < 16; ++i) { run += g[i]; bl[i] = run; }
        tot[sg * 128 + k] = run;
        LBAR();
        const float t0 = tot[k], t1 = tot[128 + k], t2 = tot[256 + k], t3 = tot[384 + k];
        const float blast = (t0 + t1) + (t2 + t3);
        const float off = (sg > 0 ? t0 : 0.f) + (sg > 1 ? t1 : 0.f) + (sg > 2 ? t2 : 0.f);
        if (sg == 0) DEC[(size_t)u * 128 + k] = __expf(blast);
        float kt[16];
#pragma unroll
        for (int i = 0; i < 16; ++i) kt[i] = bf2f(kr[i]) * __expf(blast - (bl[i] + off));
        {
            u32x4 w0, w1;
            w0.x = pk2(kt[0], kt[1]); w0.y = pk2(kt[2], kt[3]); w0.z = pk2(kt[4], kt[5]); w0.w = pk2(kt[6], kt[7]);
            w1.x = pk2(kt[8], kt[9]); w1.y = pk2(kt[10], kt[11]); w1.z = pk2(kt[12], kt[13]); w1.w = pk2(kt[14], kt[15]);
            *(LAS u32x4*)(Kt + k * HG_STR + sg * 32) = w0; *(LAS u32x4*)(Kt + k * HG_STR + sg * 32 + 16) = w1;
            w0.x = vr[0] | (vr[1] << 16); w0.y = vr[2] | (vr[3] << 16); w0.z = vr[4] | (vr[5] << 16); w0.w = vr[6] | (vr[7] << 16);
            w1.x = vr[8] | (vr[9] << 16); w1.y = vr[10] | (vr[11] << 16); w1.z = vr[12] | (vr[13] << 16); w1.w = vr[14] | (vr[15] << 16);
            *(LAS u32x4*)(Vt + k * HG_STR + sg * 32) = w0; *(LAS u32x4*)(Vt + k * HG_STR + sg * 32 + 16) = w1;
        }
        if (u + Gd < 2048) H1_LOAD(u + Gd);
        LBAR();
        const int vt = wave >> 1, kt0 = (wave & 1) * 2, r = lane & 31, hh = lane >> 5;
        f32x16 acc0 = {}, acc1 = {};
#pragma unroll
        for (int st = 0; st < 4; ++st) {
            const bf16x8 af = *(const LAS bf16x8*)(Vt + (32 * vt + r) * HG_STR + (16 * st + 8 * hh) * 2);
            const bf16x8 b0 = *(const LAS bf16x8*)(Kt + (32 * kt0 + r) * HG_STR + (16 * st + 8 * hh) * 2);
            const bf16x8 b1 = *(const LAS bf16x8*)(Kt + (32 * (kt0 + 1) + r) * HG_STR + (16 * st + 8 * hh) * 2);
            acc0 = __builtin_amdgcn_mfma_f32_32x32x16_bf16(af, b0, acc0, 0, 0, 0);
            acc1 = __builtin_amdgcn_mfma_f32_32x32x16_bf16(af, b1, acc1, 0, 0, 0);
        }
        bf16_t* sb = SB + (size_t)u * 16384;
#pragma unroll
        for (int rg = 0; rg < 16; ++rg) {
            const int v = 32 * vt + crow(rg, hh);
            sb[v * 128 + 32 * kt0 + r] = (bf16_t)f2bf(acc0[rg]);
            sb[v * 128 + 32 * (kt0 + 1) + r] = (bf16_t)f2bf(acc1[rg]);
        }
    }
    LBAR();
#undef H1_LOAD
}

__device__ __forceinline__ void hgrn_scan(bf16_t* SB, const float* DEC, int gtid, int nthr) {
    for (int item = gtid; item < 32 * 128 * 32; item += nthr) {
        const int kq = item & 31, v = (item >> 5) & 127, bh = item >> 12;
        f32x4 st = (f32x4){0.f, 0.f, 0.f, 0.f};
        u32x2* p = (u32x2*)(SB + ((size_t)bh * 64 * 128 + v) * 128 + kq * 4);
        const f32x4* dp = (const f32x4*)(DEC + (size_t)bh * 64 * 128 + kq * 4);
#pragma unroll 8
        for (int c = 0; c < 64; ++c) {
            const u32x2 d = p[(size_t)c * 16384 / 4]; const f32x4 dc = dp[c * 32];
            u32x2 o; o.x = cvt_pk_bf16(st[0], st[1]); o.y = cvt_pk_bf16(st[2], st[3]);
            p[(size_t)c * 16384 / 4] = o;
            st[0] = dc[0] * st[0] + bflo(d.x); st[1] = dc[1] * st[1] + bfhi(d.x); st[2] = dc[2] * st[2] + bflo(d.y); st[3] = dc[3] * st[3] + bfhi(d.y);
        }
    }
}

constexpr int H3_BSTR = 528, H3_QSTR = 272, H3_B_OFF = 0, H3_Q_OFF = 64 * H3_BSTR, H3_K_OFF = H3_Q_OFF + 64 * H3_QSTR, H3_V_OFF = H3_K_OFF + 64 * H3_QSTR, H3_T_OFF = H3_V_OFF + 128 * HG_STR, H3_O_OFF = H3_T_OFF + 2048;
__device__ __forceinline__ void hgrn_h3_phase(LAS unsigned char* lds, bf16_t* QH, const bf16_t* KIN, const float* G, const bf16_t* HI, const bf16_t* HG, const bf16_t* SB, int bx, int Gd, int tid, int lane, int wave) {
    LAS unsigned char* Bl = lds + H3_B_OFF;
    LAS unsigned char* Qs = lds + H3_Q_OFF;
    LAS unsigned char* Ks = lds + H3_K_OFF;
    LAS unsigned char* Vt = lds + H3_V_OFF;
    LAS float* tot = (LAS float*)(lds + H3_T_OFF);
    LAS float* osq = (LAS float*)(lds + H3_O_OFF);
    const int k = tid & 127, sg = tid >> 7;
    const int i4 = wave & 3, vh = wave >> 2, fr = lane & 15, hh = lane >> 4;
    const int tq = 16 * i4 + fr;
    float g[16]; unsigned vr[16]; u32x4 qv[2], kv[2];
#define H3_LOAD(U) do { const int c_ = (U) & 63, bh_ = (U) >> 6; const size_t rb_ = (size_t)(bh_ >> 3) * SEQ + c_ * 64; const int hc_ = (bh_ & 7) * 128; \
        _Pragma("unroll") for (int i = 0; i < 16; ++i) { g[i] = G[(rb_ + sg * 16 + i) * 1024 + hc_ + k]; vr[i] = HI[(rb_ + sg * 16 + i) * 1024 + hc_ + k]; } \
        _Pragma("unroll") for (int i = 0; i < 2; ++i) { const int idx_ = tid + 512 * i, rr_ = idx_ >> 4, ch_ = idx_ & 15; \
            qv[i] = *(const u32x4*)(QH + (rb_ + rr_) * 2048 + 1024 + hc_ + ch_ * 8); kv[i] = *(const u32x4*)(KIN + (rb_ + rr_) * 1024 + hc_ + ch_ * 8); } } while (0)
    int u = bx;
    if (u < 2048) H3_LOAD(u);
    for (; u < 2048; u += Gd) {
        const int c = u & 63, bh = u >> 6, b = bh >> 3, h = bh & 7;
        const size_t row0 = (size_t)b * SEQ + c * 64;
        float bl[16];
        {
            float run = 0.f;
#pragma unroll
            for (int i = 0; i < 16; ++i) { run += g[i]; bl[i] = run; }
            tot[sg * 128 + k] = run;
            u32x4 w0, w1;
            w0.x = vr[0] | (vr[1] << 16); w0.y = vr[2] | (vr[3] << 16); w0.z = vr[4] | (vr[5] << 16); w0.w = vr[6] | (vr[7] << 16);
            w1.x = vr[8] | (vr[9] << 16); w1.y = vr[10] | (vr[11] << 16); w1.z = vr[12] | (vr[13] << 16); w1.w = vr[14] | (vr[15] << 16);
            *(LAS u32x4*)(Vt + k * HG_STR + sg * 32) = w0; *(LAS u32x4*)(Vt + k * HG_STR + sg * 32 + 16) = w1;
#pragma unroll
            for (int i = 0; i < 2; ++i) { const int idx = tid + 512 * i, rr = idx >> 4, ch = idx & 15;
                *(LAS u32x4*)(Qs + rr * H3_QSTR + ch * 16) = qv[i]; *(LAS u32x4*)(Ks + rr * H3_QSTR + ch * 16) = kv[i]; }
        }
        LBAR();
        {
            const float t0 = tot[k], t1 = tot[128 + k], t2 = tot[256 + k];
            const float off = (sg > 0 ? t0 : 0.f) + (sg > 1 ? t1 : 0.f) + (sg > 2 ? t2 : 0.f);
#pragma unroll
            for (int i = 0; i < 16; ++i) *(LAS float*)(Bl + (sg * 16 + i) * H3_BSTR + k * 4) = bl[i] + off;
        }
        if (u + Gd < 2048) H3_LOAD(u + Gd);
        LBAR();
        bf16x8 sf[4][4];
        {
            const bf16_t* sb = SB + (size_t)u * 16384;
#pragma unroll
            for (int vt = 0; vt < 4; ++vt)
#pragma unroll
                for (int ks = 0; ks < 4; ++ks) sf[vt][ks] = *(const bf16x8*)(sb + (64 * vh + 16 * vt + fr) * 128 + 32 * ks + 8 * hh);
        }
        u32x2 gate[4];
#pragma unroll
        for (int vt = 0; vt < 4; ++vt) gate[vt] = *(const u32x2*)(HG + (row0 + tq) * 1024 + h * 128 + 64 * vh + 16 * vt + 4 * hh);
        bf16x8 qhat[4], qtil[4];
#pragma unroll
        for (int ks = 0; ks < 4; ++ks) {
            const int k0 = 32 * ks + 8 * hh;
            const u32x4 qw = *(const LAS u32x4*)(Qs + tq * H3_QSTR + k0 * 2);
            const f32x4 b0 = *(const LAS f32x4*)(Bl + tq * H3_BSTR + k0 * 4), b1 = *(const LAS f32x4*)(Bl + tq * H3_BSTR + k0 * 4 + 16);
            f32x4 r0 = (f32x4){0.f, 0.f, 0.f, 0.f}, r1 = r0;
            if (i4 > 0) { r0 = *(const LAS f32x4*)(Bl + (16 * i4 - 1) * H3_BSTR + k0 * 4); r1 = *(const LAS f32x4*)(Bl + (16 * i4 - 1) * H3_BSTR + k0 * 4 + 16); }
            const float q[8] = {bflo(qw.x), bfhi(qw.x), bflo(qw.y), bfhi(qw.y), bflo(qw.z), bfhi(qw.z), bflo(qw.w), bfhi(qw.w)};
            const float bb[8] = {b0[0], b0[1], b0[2], b0[3], b1[0], b1[1], b1[2], b1[3]};
            const float rf[8] = {r0[0], r0[1], r0[2], r0[3], r1[0], r1[1], r1[2], r1[3]};
            float a[8], t8[8];
#pragma unroll
            for (int e = 0; e < 8; ++e) { a[e] = q[e] * __expf(bb[e] - rf[e]); t8[e] = q[e] * __expf(bb[e]); }
            qhat[ks] = pack8(a[0], a[1], a[2], a[3], a[4], a[5], a[6], a[7]);
            qtil[ks] = pack8(t8[0], t8[1], t8[2], t8[3], t8[4], t8[5], t8[6], t8[7]);
        }
        f32x4 at[4];
#pragma unroll
        for (int j = 0; j < 4; ++j) {
            at[j] = (f32x4){0.f, 0.f, 0.f, 0.f};
            if (j <= i4) {
                const int sr = 16 * j + fr;
#pragma unroll
                for (int ks = 0; ks < 4; ++ks) {
                    const int k0 = 32 * ks + 8 * hh;
                    const u32x4 kw = *(const LAS u32x4*)(Ks + sr * H3_QSTR + k0 * 2);
                    const f32x4 b0 = *(const LAS f32x4*)(Bl + sr * H3_BSTR + k0 * 4), b1 = *(const LAS f32x4*)(Bl + sr * H3_BSTR + k0 * 4 + 16);
                    f32x4 r0 = (f32x4){0.f, 0.f, 0.f, 0.f}, r1 = r0;
                    if (i4 > 0) { r0 = *(const LAS f32x4*)(Bl + (16 * i4 - 1) * H3_BSTR + k0 * 4); r1 = *(const LAS f32x4*)(Bl + (16 * i4 - 1) * H3_BSTR + k0 * 4 + 16); }
                    const float kk[8] = {bflo(kw.x), bfhi(kw.x), bflo(kw.y), bfhi(kw.y), bflo(kw.z), bfhi(kw.z), bflo(kw.w), bfhi(kw.w)};
                    const float bb[8] = {b0[0], b0[1], b0[2], b0[3], b1[0], b1[1], b1[2], b1[3]};
                    const float rf[8] = {r0[0], r0[1], r0[2], r0[3], r1[0], r1[1], r1[2], r1[3]};
                    float a[8];
#pragma unroll
                    for (int e = 0; e < 8; ++e) a[e] = kk[e] * __expf(fminf(rf[e] - bb[e], 80.f));
                    const bf16x8 kf = pack8(a[0], a[1], a[2], a[3], a[4], a[5], a[6], a[7]);
                    at[j] = __builtin_amdgcn_mfma_f32_16x16x32_bf16(kf, qhat[ks], at[j], 0, 0, 0);
                }
                if (j == i4) {
#pragma unroll
                    for (int rg = 0; rg < 4; ++rg) if (4 * hh + rg > fr) at[j][rg] = 0.f;
                }
            }
        }
        f32x4 o[4];
#pragma unroll
        for (int vt = 0; vt < 4; ++vt) o[vt] = (f32x4){0.f, 0.f, 0.f, 0.f};
#pragma unroll
        for (int p = 0; p < 2; ++p) {
            if (2 * p <= i4) {
                const bf16x8 pf = pack8(at[2 * p][0], at[2 * p][1], at[2 * p][2], at[2 * p][3], at[2 * p + 1][0], at[2 * p + 1][1], at[2 * p + 1][2], at[2 * p + 1][3]);
#pragma unroll
                for (int vt = 0; vt < 4; ++vt) {
                    const LAS unsigned char* vrow = Vt + (64 * vh + 16 * vt + fr) * HG_STR;
                    const u32x2 lo = *(const LAS u32x2*)(vrow + (32 * p + 4 * hh) * 2), hi2 = *(const LAS u32x2*)(vrow + (32 * p + 16 + 4 * hh) * 2);
                    u32x4 w; w.x = lo.x; w.y = lo.y; w.z = hi2.x; w.w = hi2.y;
                    o[vt] = __builtin_amdgcn_mfma_f32_16x16x32_bf16(__builtin_bit_cast(bf16x8, w), pf, o[vt], 0, 0, 0);
                }
            }
        }
#pragma unroll
        for (int vt = 0; vt < 4; ++vt)
#pragma unroll
            for (int ks = 0; ks < 4; ++ks) o[vt] = __builtin_amdgcn_mfma_f32_16x16x32_bf16(sf[vt][ks], qtil[ks], o[vt], 0, 0, 0);
        float ss = 0.f;
#pragma unroll
        for (int vt = 0; vt < 4; ++vt) ss += (o[vt][0] * o[vt][0] + o[vt][1] * o[vt][1]) + (o[vt][2] * o[vt][2] + o[vt][3] * o[vt][3]);
        ss += shx(ss, lane, 16); ss += shx(ss, lane, 32);
        if (hh == 0) osq[vh * 64 + tq] = ss;
        LBAR();
        const float rn = rsqrtf((osq[tq] + osq[64 + tq]) * (1.0f / 128.0f) + EPS);
#pragma unroll
        for (int vt = 0; vt < 4; ++vt) {
            const int v = 64 * vh + 16 * vt + 4 * hh;
            const u32x2 gw = gate[vt];
            u32x2 w; w.x = cvt_pk_bf16(o[vt][0] * rn * bflo(gw.x), o[vt][1] * rn * bfhi(gw.x)); w.y = cvt_pk_bf16(o[vt][2] * rn * bflo(gw.y), o[vt][3] * rn * bfhi(gw.y));
            *(u32x2*)(QH + (row0 + tq) * 2048 + 1024 + h * 128 + v) = w;
        }
    }
    LBAR();
#undef H3_LOAD
}

#define XB_TMO      128
#define XB_XCNT(j)  (256  + 64 * (j))
#define XB_XSUB(j)  (1280 + 64 * (j))
#define XB_XGEN(j)  (2304 + 64 * (j))
#define XB_TOP      3328
#define XB_TOPGEN   3392
#define XCD_BAR_WORDS 3456
#define XB_SPIN_CAP (1u << 22)
__device__ __forceinline__ unsigned xb_ld(unsigned* p)              { return __hip_atomic_load(p, __ATOMIC_RELAXED, __HIP_MEMORY_SCOPE_AGENT); }
__device__ __forceinline__ unsigned xb_add(unsigned* p, unsigned v) { return __hip_atomic_fetch_add(p, v, __ATOMIC_RELAXED, __HIP_MEMORY_SCOPE_AGENT); }
__device__ __forceinline__ unsigned xb_xcc_id() { return (unsigned)__builtin_amdgcn_s_getreg((3 << 11) | 20) & 0xFu; }
#define XB_SPIN(cond, bar) do { unsigned _sp = 0; while (cond) { __builtin_amdgcn_s_sleep(1); \
    if ((++_sp & 255u) == 0u) { if (xb_ld(&(bar)[XB_TMO])) break; if (_sp > XB_SPIN_CAP) { atomicAdd(&(bar)[XB_TMO], 1u); break; } } } } while (0)
struct XcdBarrier { unsigned* bar; unsigned x; volatile LAS unsigned* st; };
__device__ __forceinline__ XcdBarrier xcd_barrier_post(unsigned* bar, volatile LAS unsigned* st) {
    XcdBarrier b; b.bar = bar; b.x = xb_xcc_id(); b.st = st;
    if (threadIdx.x == 0) (void)xb_add(&bar[XB_XCNT(b.x)], 1u);
    return b;
}
__device__ __forceinline__ void xcd_barrier_complete(unsigned* bar, unsigned x, unsigned& nloc, unsigned& nx) {
    const unsigned G = gridDim.x * gridDim.y * gridDim.z;
    unsigned sum, cnt, mine, sp = 0u;
    for (;;) {
        sum = 0u; cnt = 0u; mine = 0u;
#pragma unroll
        for (unsigned j = 0; j < 16; ++j) { const unsigned c = xb_ld(&bar[XB_XCNT(j)]); sum += c; cnt += (c > 0u) ? 1u : 0u; mine = (j == x) ? c : mine; }
        if (sum == G) break;
        __builtin_amdgcn_s_sleep(1);
        if ((++sp & 255u) == 0u) { if (xb_ld(&bar[XB_TMO])) break; if (sp > XB_SPIN_CAP) { atomicAdd(&bar[XB_TMO], 1u); break; } }
    }
    nloc = mine > 0u ? mine : 1u; nx = cnt > 0u ? cnt : 1u;
}
__device__ __forceinline__ void xcd_barrier(const XcdBarrier& b) {
    asm volatile("s_waitcnt vmcnt(0)" ::: "memory");
    __syncthreads();
    if (threadIdx.x == 0) {
        unsigned* bar = b.bar;
        __builtin_amdgcn_s_waitcnt(0);
        unsigned nloc = b.st[0], nx = b.st[1];
        if (nloc == 0u) { xcd_barrier_complete(bar, b.x, nloc, nx); b.st[0] = nloc; b.st[1] = nx; }
        const unsigned old = xb_add(&bar[XB_XSUB(b.x)], 1u);
        const unsigned gen = old / nloc;
        if (old + 1u == (gen + 1u) * nloc) {
            __builtin_amdgcn_fence(__ATOMIC_RELEASE, "agent");
            asm volatile("s_waitcnt vmcnt(0)" ::: "memory");
            const unsigned og = xb_add(&bar[XB_TOP], 1u);
            const unsigned tg = og / nx;
            if (og + 1u == (tg + 1u) * nx) xb_add(&bar[XB_TOPGEN], 1u);
            else XB_SPIN(xb_ld(&bar[XB_TOPGEN]) == tg, bar);
            __builtin_amdgcn_fence(__ATOMIC_ACQUIRE, "agent");
            xb_add(&bar[XB_XGEN(b.x)], 1u);
            asm volatile("s_waitcnt vmcnt(0)" ::: "memory");
        } else {
            XB_SPIN(xb_ld(&bar[XB_XGEN(b.x)]) == gen, bar);
            __builtin_amdgcn_fence(__ATOMIC_ACQUIRE, "agent");
            asm volatile("s_waitcnt vmcnt(0)" ::: "memory");
        }
    }
    __syncthreads();
}

__global__ void __launch_bounds__(NTHR, 2) fwd_megakernel(Args args) {
    extern __shared__ __attribute__((aligned(16))) unsigned char lds_raw[];
    LAS unsigned char* lds = (LAS unsigned char*)lds_raw;
    cg::grid_group grid = cg::this_grid();
    const int G = gridDim.x, bx = blockIdx.x, ngw = G * NWAVES, nthr = G * NTHR;
    const int wave = __builtin_amdgcn_readfirstlane((int)threadIdx.x >> 6);
#define PHASE_IDS() int lane_; asm volatile("v_mbcnt_lo_u32_b32 %0, -1, 0\n\tv_mbcnt_hi_u32_b32 %0, -1, %0" : "=v"(lane_)); const int lane = lane_, tid = wave * 64 + lane, gw = bx * NWAVES + wave, gtid = bx * NTHR + tid; (void)gw; (void)gtid
    unsigned char* ws = args.ws;
    const float* x_in = (const float*)args.in[0]; const float* p_in = (const float*)args.in[1]; const int* pos = (const int*)args.in[2];
    const float* w_in = (const float*)args.in[3]; const float* sinks = (const float*)args.in[4]; const float* lb_logits = (const float*)args.in[5];
    const float* attn_gain = (const float*)args.in[6]; const float* hgrn_gain = (const float*)args.in[7]; const float* w_out = (const float*)args.in[8];
    const float* pre_mix = (const float*)args.in[9]; const float* post_mix = (const float*)args.in[10]; const float* pre_ffn = (const float*)args.in[11]; const float* post_ffn = (const float*)args.in[12];
    const float* w_gate = (const float*)args.in[13]; const float* w_up = (const float*)args.in[14]; const float* w_down = (const float*)args.in[15];
    const float* ple_gain = (const float*)args.in[16]; const float* w_pg = (const float*)args.in[17]; const float* w_pp = (const float*)args.in[18];
    float* out = args.out;
    u64* stat = (u64*)(ws + WS_STAT); float* lbt = (float*)(ws + WS_LBT); float* cs = (float*)(ws + WS_CS);
    bf16_t* PBF = (bf16_t*)(ws + WS_PBF); bf16_t* HA = (bf16_t*)(ws + WS_HA); float* tmpO = (float*)(ws + WS_HA);
    bf16_t* QH = (bf16_t*)(ws + WS_QH); bf16_t* Kb = (bf16_t*)(ws + WS_K); bf16_t* Vb = (bf16_t*)(ws + WS_V); float* Gb = (float*)(ws + WS_G);
    bf16_t* KIN = (bf16_t*)(ws + WS_KIN); bf16_t* HI = (bf16_t*)(ws + WS_HI); bf16_t* HG = (bf16_t*)(ws + WS_HG);
    bf16_t* SBuf = (bf16_t*)(ws + WS_HA); float* DEC = (float*)(ws + WS_DEC);
    bf16_t* Mb = (bf16_t*)(ws + WS_M); bf16_t* ACT = (bf16_t*)(ws + WS_ACT); bf16_t* Fb = (bf16_t*)(ws + WS_F); bf16_t* PP = (bf16_t*)(ws + WS_PP);

    volatile LAS unsigned* xst = (volatile LAS unsigned*)(lds + 131072 + 64);
    unsigned* barw = (unsigned*)(ws + WS_BAR);
    if (threadIdx.x < 2) xst[threadIdx.x] = 0u;
    if (bx == 0) for (int i = threadIdx.x; i < 3456; i += NTHR) barw[i] = 0u;
    __syncthreads();
    {
        PHASE_IDS();
        LAS float* scr = (LAS float*)(lds + wave * 16384);
        constexpr int I_IN = 32 * 176, I_OUT = 32 * 64, I_G = 32 * 176, I_D = 88 * 64, I_PG = 32 * 64, I_PP = 4 * 64;
        constexpr int I_L = I_IN + I_OUT + 2 * I_G + I_D + I_PG + I_PP;
        for (int it = gw; it < DEPTH * I_L; it += ngw) {
            const int l = it / I_L; int r = it % I_L;
            unsigned char* wl = ws + WS_W + (size_t)l * WL_SIZE;
            if (r < I_IN) {
                const int kb = r / 176, nb = r % 176, n0 = nb * 32, pn = n0 >> 8; int prow0 = n0;
                if (pn <= 4) { const int lc = n0 & 255; prow0 = (pn << 8) + 128 * ((lc >> 5) & 1) + 32 * ((lc >> 6) & 3); }
                tr_item(w_in + (size_t)l * DM * DIN, DIN, DM, kb * 64, n0, (bf16_t*)(wl + WL_IN), prow0, pre_mix + l * DM, scr, lane); continue; }
            r -= I_IN;
            if (r < I_OUT) {
                const int kb = r / 64, nb = r % 64; const int k0 = kb * 64;
                const float* gp = (k0 < 1024) ? (attn_gain + l * 1024) : (hgrn_gain + l * 1024 - 1024);
                tr_item(w_out + (size_t)l * DM * DM, DM, DM, k0, nb * 32, (bf16_t*)(wl + WL_OUT), nb * 32, gp, scr, lane); continue; }
            r -= I_OUT;
            if (r < 2 * I_G) {
                const int up = r >= I_G; if (up) r -= I_G;
                const int kb = r / 176, nb = r % 176, n0 = nb * 32; const int prow0 = 256 * (n0 >> 7) + (n0 & 127) + (up ? 128 : 0);
                tr_item((up ? w_up : w_gate) + (size_t)l * DM * DFF, DFF, DM, kb * 64, n0, (bf16_t*)(wl + WL_GU), prow0, pre_ffn + l * DM, scr, lane); continue; }
            r -= 2 * I_G;
            if (r < I_D) { const int kb = r / 64, nb = r % 64;
                tr_item(w_down + (size_t)l * DFF * DM, DM, DFF, kb * 64, nb * 32, (bf16_t*)(wl + WL_DOWN), nb * 32, nullptr, scr, lane); continue; }
            r -= I_D;
            if (r < I_PG) { const int kb = r / 64, nb = r % 64;
                tr_item(w_pg + (size_t)l * DM * DM, DM, DM, kb * 64, nb * 32, (bf16_t*)(wl + WL_PG), nb * 32, ple_gain + l * DM, scr, lane); continue; }
            r -= I_PG;
            { const int kb = r / 64, nb = r % 64;
                tr_item(w_pp + (size_t)l * DPLE * DM, DM, DPLE, kb * 64, nb * 32, (bf16_t*)(wl + WL_PP), nb * 32, nullptr, scr, lane); }
        }
        for (int i = gtid; i < 11 * T; i += nthr) stat[T + i] = 0ull;
        for (int i = gtid; i < 1024; i += nthr) {
            const float l0 = lb_logits[i], l1 = lb_logits[1024 + i];
            lbt[i] = 0.f; lbt[1024 + i] = 1.0f / (1.0f + expf(l0 - l1));
        }
        for (int i = gtid; i < T * 32; i += nthr) {
            const int row = i >> 5, d = i & 31;
            const double rev = (double)pos[row] * c_invf[d] * 0.15915494309189535;
            const float fr = (float)(rev - rint(rev));
            cs[(size_t)row * 64 + d] = __builtin_amdgcn_cosf(fr); cs[(size_t)row * 64 + 32 + d] = __builtin_amdgcn_sinf(fr);
        }
        for (int i = gtid; i < DEPTH * T * DPLE / 8; i += nthr) {
            const f32x4 a = *(const f32x4*)(p_in + (size_t)i * 8), b = *(const f32x4*)(p_in + (size_t)i * 8 + 4);
            u32x4 w; w.x = pk2(a[0], a[1]); w.y = pk2(a[2], a[3]); w.z = pk2(b[0], b[1]); w.w = pk2(b[2], b[3]);
            *(u32x4*)(PBF + (size_t)i * 8) = w;
        }
    }
    { PHASE_IDS();
    for (int row = gw; row < T; row += ngw) {
        float ss = 0.f;
#pragma unroll
        for (int j = 0; j < 4; ++j) {
            const int c = j * 512 + lane * 8; const size_t off = (size_t)row * 2048 + c;
            const f32x4 x0 = *(const f32x4*)(x_in + off), x1 = *(const f32x4*)(x_in + off + 4);
            u32x4 w; w.x = pk2(x0[0], x0[1]); w.y = pk2(x0[2], x0[3]); w.z = pk2(x1[0], x1[1]); w.w = pk2(x1[2], x1[3]);
            *(u32x4*)(HA + off) = w;
            ss += (x0[0] * x0[0] + x0[1] * x0[1]) + (x0[2] * x0[2] + x0[3] * x0[3]) + (x1[0] * x1[0] + x1[1] * x1[1]) + (x1[2] * x1[2] + x1[3] * x1[3]);
        }
        ss = wave_sum(ss, lane);
        if (lane == 0) stat[(SQ_X + 0) * T + row] = fx_enc(ss);
    } }
    grid.sync();
    const XcdBarrier xbar = xcd_barrier_post(barw, xst);
#define GSYNC() xcd_barrier(xbar)

    for (int l = 0; l < DEPTH; ++l) {
        unsigned char* wl = ws + WS_W + (size_t)l * WL_SIZE;
        u64* ssqX = stat + (SQ_X + l) * T; u64* ssqA = stat + (SQ_A + l) * T; u64* ssqM = stat + (SQ_M + l) * T;
        u64* ssq2 = stat + (SQ_2 + l) * T; u64* ssqF = stat + (SQ_F + l) * T; u64* ssq3 = stat + (SQ_3 + l) * T;
        {
            PHASE_IDS(); pg8::Gemm g{l == 0 ? HA : (const bf16_t*)(ws + WS_W + (size_t)(l - 1) * WL_SIZE), (const bf16_t*)(wl + WL_IN), T, DIN, DM}; pg8::StaticOrder S; S.init(T, DIN, G, bx);
            EpiIn E{0, ssqX, cs, lbt + l * 1024, QH, Kb, Vb, Gb, KIN, HI, HG};
            if (PH & 1) pg8::gemm_phase<EpiIn, pg8::StaticOrder, true, true>(lds, g, S, E, tid);
        }
        GSYNC();
#if !NAIVE_MIX
        { PHASE_IDS();
          for (int u = bx; u < 512; u += G) attn_unit(lds, QH, Kb, Vb, sinks + l * 16, ssqA, u, tid, lane, wave);
          hgrn_h1_phase(lds, KIN, Gb, HI, SBuf, DEC, bx, G, tid, lane, wave); }
        GSYNC();
        { PHASE_IDS(); hgrn_scan(SBuf, DEC, gtid, nthr); }
        GSYNC();
        { PHASE_IDS();
          hgrn_h3_phase(lds, QH, KIN, Gb, HI, HG, SBuf, bx, G, tid, lane, wave); }
        GSYNC();
#else
        { PHASE_IDS();
        if (bx < 64 && wave == 0) hgrn_naive(QH, KIN, Gb, HI, tmpO, bx, lane);
        attn_naive(QH, Kb, Vb, sinks + l * 16, ssqA, gtid, nthr); }
        GSYNC();
        { PHASE_IDS(); hgrn_norm_naive(tmpO, HG, QH, gw, ngw, lane); }
        GSYNC();
#endif
        {
            PHASE_IDS(); pg8::Gemm g{QH, (const bf16_t*)(wl + WL_OUT), T, DM, DM}; pg8::StaticOrder S; S.init(T, DM, G, bx);
            EpiRowSsq<true> E{16, Mb, ssqM, ssqA};
            if (PH & 2) pg8::gemm_phase<EpiRowSsq<true>, pg8::StaticOrder, true, true>(lds, g, S, E, tid);
        }
        GSYNC();
        { PHASE_IDS();
          if (l == 0) row_phase<true>(x_in, nullptr, Mb, ssqM, post_mix + l * DM, HA, ssq2, gw, ngw, lane);
          else row_phase<false>(nullptr, (const bf16_t*)(ws + WS_W + (size_t)(l - 1) * WL_SIZE), Mb, ssqM, post_mix + l * DM, HA, ssq2, gw, ngw, lane); }
        GSYNC();
        {
            PHASE_IDS(); pg8::Gemm g{HA, (const bf16_t*)(wl + WL_GU), T, 2 * DFF, DM}; pg8::StaticOrder S; S.init(T, 2 * DFF, G, bx);
            EpiGU E{0, ssq2, ACT};
            if (PH & 4) pg8::gemm_phase<EpiGU, pg8::StaticOrder, true, true>(lds, g, S, E, tid);
        }
        GSYNC();
        {
            PHASE_IDS(); pg8::Gemm g{ACT, (const bf16_t*)(wl + WL_DOWN), T, DM, DFF}; pg8::StaticOrder S; S.init(T, DM, G, bx);
            EpiRowSsq<false> E{0, Fb, ssqF, nullptr};
            if (PH & 8) pg8::gemm_phase<EpiRowSsq<false>, pg8::StaticOrder, true, true>(lds, g, S, E, tid);
        }
        GSYNC();
        { PHASE_IDS(); row_phase<false>(nullptr, HA, Fb, ssqF, post_ffn + l * DM, HA, ssq3, gw, ngw, lane); }
        GSYNC();
        {
            PHASE_IDS(); int kpp = DPLE; asm volatile("" : "+s"(kpp)); pg8::Gemm g{PBF + (size_t)l * T * DPLE, (const bf16_t*)(wl + WL_PP), T, DM, kpp}; pg8::StaticOrder S; S.init(T, DM, G, bx);
            EpiPlain E{0, PP};
            if (PH & 16) pg8::gemm_phase<EpiPlain, pg8::StaticOrder, true, true>(lds, g, S, E, tid);
        }
        {
            PHASE_IDS(); pg8::Gemm g{HA, (const bf16_t*)(wl + WL_PG), T, DM, DM}; pg8::StaticOrder S; S.init(T, DM, G, bx);
            EpiPle E{0, ssq3, PP, HA, out, (bf16_t*)wl, stat + (SQ_X + (l + 1 < DEPTH ? l + 1 : 0)) * T, l + 1 < DEPTH ? 1 : 0};
            if (PH & 32) pg8::gemm_phase<EpiPle, pg8::StaticOrder, true, true>(lds, g, S, E, tid);
        }
        if (l + 1 < DEPTH) GSYNC();
    }
}

extern "C" void kernel_launch(void* const* d_in, const int* in_sizes, int n_in, void* d_out, int out_size, void* d_ws, size_t ws_size, hipStream_t stream) {
    static int grid = 0;
    if (grid == 0) {
        if (n_in != 19 || out_size != T * DM || ws_size < WS_END) { fprintf(stderr, "kernel_launch: unexpected shapes (n_in %d out %d ws %zu need %zu)\n", n_in, out_size, ws_size, (size_t)WS_END); grid = -1; return; }
        int dev = 0, cus = 0, per_cu = 0;
        hipGetDevice(&dev);
        hipDeviceGetAttribute(&cus, hipDeviceAttributeMultiprocessorCount, dev);
        if (hipFuncSetAttribute((const void*)fwd_megakernel, hipFuncAttributeMaxDynamicSharedMemorySize, LDS_BYTES) != hipSuccess) { fprintf(stderr, "kernel_launch: hipFuncSetAttribute failed\n"); grid = -1; return; }
        if (hipOccupancyMaxActiveBlocksPerMultiprocessor(&per_cu, (const void*)fwd_megakernel, NTHR, LDS_BYTES) != hipSuccess || per_cu < 1) { fprintf(stderr, "kernel_launch: occupancy query gave %d\n", per_cu); per_cu = 1; }
        (void)hipGetLastError();
        grid = cus * per_cu;
    }
    if (grid < 0) return;
    Args a{};
    for (int i = 0; i < 19; ++i) a.in[i] = d_in[i];
    a.out = (float*)d_out; a.ws = (unsigned char*)d_ws;
    void* kargs[] = {&a};
    hipError_t e = hipLaunchCooperativeKernel((const void*)fwd_megakernel, dim3(grid), dim3(NTHR), kargs, LDS_BYTES, stream);
    if (e != hipSuccess) fprintf(stderr, "cooperative launch failed: %s (grid %d)\n", hipGetErrorString(e), grid);
}
```

```cpp
#include <hip/hip_runtime.h>
#include <hip/hip_cooperative_groups.h>
#include <cstdio>
#include <cstdint>
namespace cg = cooperative_groups;

#ifndef PH
#define PH 63
#endif
#ifndef NAIVE_MIX
#define NAIVE_MIX 0
#endif

namespace pg8 {
#define PG8_LAS __attribute__((address_space(3)))
typedef unsigned short bf16_t;
typedef short bf16x8 __attribute__((ext_vector_type(8)));
typedef float f32x4 __attribute__((ext_vector_type(4)));
typedef unsigned u32x4 __attribute__((ext_vector_type(4)));
constexpr int BM = 256, BK = 64, HALF = 128, HTB = HALF * BK * 2, STAGE_BYTES = 8 * HTB, NXCD = 8, WGM = 8;

__host__ __device__ __forceinline__ int lds_byte(int r, int c) { const int st = (r >> 4) * 2 + (c >> 5), rr = r & 15, cc = c & 31, ob = rr * 64 + cc * 2; return st * 1024 + (ob ^ (((ob >> 9) & 1) << 5)); }
__host__ __device__ __forceinline__ void stage_rc(int b, int& R, int& C) { const int st = b / 1024, sb = b % 1024, swz = sb ^ (((sb >> 9) & 1) << 5); R = (st >> 1) * 16 + swz / 64; C = (st & 1) * 32 + (swz % 64) / 2; }
__host__ __device__ __forceinline__ int perm32(int rho) { const int n = rho >> 4, i = rho & 15; return 8 * (i >> 2) + 4 * n + (i & 3); }

struct Unit { int pm, pn; };
struct Gemm { const bf16_t* A; const bf16_t* Bt; int M, N, K; };

struct StaticOrder {
    int nM, nN, nwg, G, c;
    __host__ __device__ void init(int M, int N, int G_, int c_) { nM = M / BM; nN = N / BM; nwg = nM * nN; G = G_; c = c_; }
    __host__ __device__ bool next(int i, Unit& u) const {
        const long L = (long)i * G + c; if (L >= nwg) return false;
        int wgid = (int)L; { const int q = nwg / NXCD, r = nwg % NXCD, xcd = wgid % NXCD, off = wgid / NXCD; wgid = (xcd < r ? xcd * (q + 1) : r * (q + 1) + (xcd - r) * q) + off; }
        const int nig = WGM * nN, gid = wgid / nig, fm = gid * WGM, gsz = (nM - fm) < WGM ? (nM - fm) : WGM;
        u.pm = fm + ((wgid % nig) % gsz); u.pn = (wgid % nig) / gsz; return true;
    }
    __device__ __forceinline__ void a_ready(const Unit&) const {}
    __device__ __forceinline__ void done(const Unit&) const {}
};

__device__ __forceinline__ unsigned cvt_pk_bf16(float lo, float hi) { unsigned r; asm volatile("v_cvt_pk_bf16_f32 %0, %1, %2" : "=v"(r) : "v"(lo), "v"(hi)); return r; }

template <class Epi, class Sched, bool ALIGN_EPI = false, bool SP2 = false>
__device__ __forceinline__ void gemm_phase(PG8_LAS unsigned char* lds, const Gemm g, const Sched& S, const Epi& E, int tid_in) {
    int tid_ = tid_in; asm volatile("" : "+v"(tid_));
    const int tid = tid_, wid = __builtin_amdgcn_readfirstlane(tid >> 6), lane = tid & 63, wr = wid >> 2, wc = wid & 3, fr = lane & 15, fq = lane >> 4;
    const int K = g.K, nt = K / BK;
    unsigned voffA[2], voffB[2];
#pragma unroll
    for (int i = 0; i < 2; ++i) { int R, C; stage_rc(tid * 16 + i * 8192, R, C); const int Rb = Epi::PERM ? ((R & ~31) + perm32(R & 31)) : R;
        voffA[i] = (unsigned)(R * K + C) * 2u; voffB[i] = (unsigned)(Rb * K + C) * 2u; }
    const size_t kstep = (size_t)(BK * 2);
    const size_t hstep = (size_t)HALF * K * 2;
    const size_t tstep = 2 * hstep;
    const unsigned ldsw = (unsigned)wid * 1024u;
    const int aoff = lds_byte(wr * 64 + fr, fq * 8), boff = lds_byte(wc * 32 + fr, fq * 8);
#define PG8_SA(b, h) (((b) * 2 + (h)) * HTB)
#define PG8_SB(b, h) ((4 + (b) * 2 + (h)) * HTB)
#define PG8_STAGE(bufoff, gbase, voff) do { _Pragma("unroll") for (int _i = 0; _i < 2; ++_i) \
        __builtin_amdgcn_global_load_lds((const unsigned*)((const char*)(gbase) + (voff)[_i]), (PG8_LAS unsigned*)(lds + (bufoff) + ldsw + _i * 8192), 16, 0, 0); } while (0)
#define PG8_LDA(dst, b, h) do { _Pragma("unroll") for (int m = 0; m < 4; ++m) _Pragma("unroll") for (int k = 0; k < 2; ++k) dst[m][k] = *(const PG8_LAS bf16x8*)(lds + PG8_SA(b, h) + aoff + m * 2048 + k * 1024); } while (0)
#define PG8_LDB(dst, b, h) do { _Pragma("unroll") for (int n = 0; n < 2; ++n) _Pragma("unroll") for (int k = 0; k < 2; ++k) dst[n][k] = *(const PG8_LAS bf16x8*)(lds + PG8_SB(b, h) + boff + n * 2048 + k * 1024); } while (0)
#define PG8_MMA(ai, bj, At, Bt) do { __builtin_amdgcn_s_setprio(1); _Pragma("unroll") for (int m = 0; m < 4; ++m) _Pragma("unroll") for (int n = 0; n < 2; ++n) _Pragma("unroll") for (int k = 0; k < 2; ++k) \
        acc[ai][bj][m][n] = __builtin_amdgcn_mfma_f32_16x16x32_bf16(Bt[n][k], At[m][k], acc[ai][bj][m][n], 0, 0, 0); __builtin_amdgcn_s_setprio(0); } while (0)
#define PG8_WAIT_V(n) asm volatile("s_waitcnt vmcnt(" #n ")" ::: "memory")
#define PG8_WAIT_L(n) asm volatile("s_waitcnt lgkmcnt(" #n ")" ::: "memory")
#define PG8_BAR __builtin_amdgcn_s_barrier()
#define PG8_SCHED __builtin_amdgcn_sched_barrier(0)
    Unit cur, nxt; int ui = 0;
    if (!S.next(0, cur)) return;
    f32x4 acc[2][2][4][2];
#pragma unroll
    for (int a = 0; a < 2; ++a)
#pragma unroll
        for (int b = 0; b < 2; ++b)
#pragma unroll
            for (int m = 0; m < 4; ++m)
#pragma unroll
                for (int n = 0; n < 2; ++n) acc[a][b][m][n] = (f32x4){0.f, 0.f, 0.f, 0.f};
    bf16x8 At[4][2], B0[2][2], B1[2][2];
    const char* cA = (const char*)g.A + (size_t)cur.pm * tstep; const char* cB = (const char*)g.Bt + (size_t)cur.pn * tstep;
    S.a_ready(cur);
    if constexpr (SP2) {
        PG8_STAGE(PG8_SB(0, 0), cB, voffB); PG8_STAGE(PG8_SB(0, 1), cB + hstep, voffB); PG8_STAGE(PG8_SA(0, 0), cA, voffA); PG8_STAGE(PG8_SA(0, 1), cA + hstep, voffA);
        if (wr == 1) PG8_BAR;
        PG8_WAIT_V(2); PG8_BAR;
        PG8_STAGE(PG8_SB(1, 0), cB + kstep, voffB); PG8_STAGE(PG8_SA(1, 0), cA + kstep, voffA); PG8_STAGE(PG8_SB(1, 1), cB + hstep + kstep, voffB);
        PG8_WAIT_V(6); PG8_BAR;
    } else {
        PG8_STAGE(PG8_SB(0, 0), cB, voffB); PG8_STAGE(PG8_SA(0, 0), cA, voffA); PG8_STAGE(PG8_SB(0, 1), cB + hstep, voffB); PG8_STAGE(PG8_SA(0, 1), cA + hstep, voffA);
        if (wr == 1) PG8_BAR;
        PG8_WAIT_V(4); PG8_BAR;
        PG8_STAGE(PG8_SB(1, 0), cB + kstep, voffB); PG8_STAGE(PG8_SA(1, 0), cA + kstep, voffA); PG8_STAGE(PG8_SB(1, 1), cB + hstep + kstep, voffB);
        PG8_WAIT_V(6); PG8_BAR;
    }
    for (;;) {
        const bool has_next = S.next(ui + 1, nxt);
        const char* nA = has_next ? (const char*)g.A + (size_t)nxt.pm * tstep : cA; const char* nB = has_next ? (const char*)g.Bt + (size_t)nxt.pn * tstep : cB;
        for (int t = 0; t < nt; t += 2) {
            const bool last = (t == nt - 2);
            const char* a1 = cA + (size_t)(t + 1) * kstep;
            const char* a2 = last ? nA : cA + (size_t)(t + 2) * kstep; const char* b2 = last ? nB : cB + (size_t)(t + 2) * kstep;
            const char* a3 = a2 + kstep; const char* b3 = b2 + kstep;
            if (last && has_next) S.a_ready(nxt);
            if constexpr (Epi::MID) { if (t == E.kmid) { int l2 = lane; asm volatile("" : "+v"(l2)); E.mid(acc, cur, wr, wc, l2 & 15, l2 >> 4); } }
            if constexpr (SP2) {
            PG8_LDB(B0, 0, 0); PG8_LDB(B1, 0, 1); PG8_SCHED; PG8_LDA(At, 0, 0); PG8_STAGE(PG8_SA(1, 1), a1 + hstep, voffA);
            PG8_WAIT_V(8); PG8_WAIT_L(0); PG8_BAR; PG8_MMA(0, 0, At, B0); PG8_MMA(0, 1, At, B1); PG8_BAR; PG8_SCHED;
            PG8_LDA(At, 0, 1); PG8_STAGE(PG8_SB(0, 0), b2, voffB); PG8_STAGE(PG8_SB(0, 1), b2 + hstep, voffB); PG8_STAGE(PG8_SA(0, 0), a2, voffA);
            PG8_WAIT_V(8); PG8_WAIT_L(0); PG8_BAR; PG8_MMA(1, 0, At, B0); PG8_MMA(1, 1, At, B1); PG8_BAR; PG8_SCHED;
            PG8_LDB(B0, 1, 0); PG8_LDB(B1, 1, 1); PG8_SCHED; PG8_LDA(At, 1, 0); PG8_STAGE(PG8_SA(0, 1), a2 + hstep, voffA);
            PG8_WAIT_V(8); PG8_WAIT_L(0); PG8_BAR; PG8_MMA(0, 0, At, B0); PG8_MMA(0, 1, At, B1); PG8_BAR; PG8_SCHED;
            PG8_LDA(At, 1, 1); PG8_STAGE(PG8_SB(1, 0), b3, voffB); PG8_STAGE(PG8_SB(1, 1), b3 + hstep, voffB); PG8_STAGE(PG8_SA(1, 0), a3, voffA);
            PG8_WAIT_V(8); PG8_WAIT_L(0); PG8_BAR; PG8_MMA(1, 0, At, B0); PG8_MMA(1, 1, At, B1); PG8_BAR; PG8_SCHED;
            } else {
            PG8_LDB(B0, 0, 0); PG8_SCHED; PG8_LDA(At, 0, 0); PG8_STAGE(PG8_SA(1, 1), a1 + hstep, voffA);
            PG8_WAIT_L(8); PG8_BAR; PG8_WAIT_L(0); PG8_MMA(0, 0, At, B0); PG8_BAR; PG8_SCHED;
            PG8_LDB(B1, 0, 1); PG8_STAGE(PG8_SB(0, 0), b2, voffB);
            PG8_BAR; PG8_WAIT_L(0); PG8_MMA(0, 1, At, B1); PG8_BAR;
            PG8_LDA(At, 0, 1); PG8_STAGE(PG8_SA(0, 0), a2, voffA);
            PG8_BAR; PG8_WAIT_L(0); PG8_MMA(1, 0, At, B0); PG8_BAR; PG8_SCHED;
            PG8_STAGE(PG8_SB(0, 1), b2 + hstep, voffB);
            PG8_WAIT_V(6); PG8_BAR; PG8_MMA(1, 1, At, B1); PG8_BAR;
            PG8_LDB(B0, 1, 0); PG8_SCHED; PG8_LDA(At, 1, 0); PG8_STAGE(PG8_SA(0, 1), a2 + hstep, voffA);
            PG8_WAIT_L(8); PG8_BAR; PG8_WAIT_L(0); PG8_MMA(0, 0, At, B0); PG8_BAR; PG8_SCHED;
            PG8_LDB(B1, 1, 1); PG8_STAGE(PG8_SB(1, 0), b3, voffB);
            PG8_BAR; PG8_WAIT_L(0); PG8_MMA(0, 1, At, B1); PG8_BAR;
            PG8_LDA(At, 1, 1); PG8_STAGE(PG8_SA(1, 0), a3, voffA);
            PG8_BAR; PG8_WAIT_L(0); PG8_MMA(1, 0, At, B0); PG8_BAR; PG8_SCHED;
            PG8_STAGE(PG8_SB(1, 1), b3 + hstep, voffB);
            PG8_WAIT_V(6); PG8_BAR; PG8_MMA(1, 1, At, B1); PG8_BAR;
            }
        }
        if constexpr (ALIGN_EPI) { if (wr == 0) PG8_BAR; }
        { int l2 = lane; asm volatile("" : "+v"(l2)); E(acc, cur, wr, wc, l2 & 15, l2 >> 4); }
        if (!has_next) break;
#pragma unroll
        for (int a = 0; a < 2; ++a)
#pragma unroll
            for (int b = 0; b < 2; ++b)
#pragma unroll
                for (int m = 0; m < 4; ++m)
#pragma unroll
                    for (int n = 0; n < 2; ++n) acc[a][b][m][n] = (f32x4){0.f, 0.f, 0.f, 0.f};
        cur = nxt; cA = nA; cB = nB; ++ui;
        if constexpr (ALIGN_EPI) { if (wr == 1) PG8_BAR; }
    }
    PG8_WAIT_V(0);
    if constexpr (!ALIGN_EPI) { if (wr == 0) PG8_BAR; }
    PG8_BAR;
#undef PG8_SA
#undef PG8_SB
#undef PG8_STAGE
#undef PG8_LDA
#undef PG8_LDB
#undef PG8_MMA
#undef PG8_WAIT_V
#undef PG8_WAIT_L
#undef PG8_BAR
#undef PG8_SCHED
}
}

using pg8::bf16_t; using pg8::f32x4; using pg8::u32x4; using pg8::Unit; using pg8::cvt_pk_bf16;
#define LAS __attribute__((address_space(3)))
constexpr int NB = 4, SEQ = 4096, T = NB * SEQ, DM = 2048, DIN = 5632, DFF = 5632, DPLE = 256, DEPTH = 2;
constexpr float EPS = 1e-6f;
constexpr float LOG2E = 1.4426950408889634f;
constexpr float QSCALE = 0.125f * LOG2E;
constexpr int NWAVES = 8, NTHR = 512;
constexpr int LDS_BYTES = 147456;

constexpr size_t MiB = 1u << 20;
constexpr size_t WS_STAT = 0;
constexpr size_t WS_LBT = 1536 * 1024;
constexpr size_t WS_BAR = 1600 * 1024;
constexpr size_t WS_CS = 2 * MiB;
constexpr size_t WS_W = 6 * MiB;
constexpr size_t WL_IN = 0, WL_OUT = 22 * MiB, WL_GU = 30 * MiB, WL_DOWN = 74 * MiB, WL_PG = 96 * MiB, WL_PP = 104 * MiB, WL_SIZE = 105 * MiB;
constexpr size_t WS_PBF = 216 * MiB;
constexpr size_t WS_HA = 232 * MiB;
constexpr size_t WS_R = 296 * MiB;
constexpr size_t WS_QH = WS_R, WS_K = WS_R + 64 * MiB, WS_V = WS_R + 72 * MiB, WS_G = WS_R + 80 * MiB, WS_KIN = WS_R + 144 * MiB, WS_HI = WS_R + 176 * MiB, WS_HG = WS_R + 208 * MiB;
constexpr size_t WS_M = WS_G, WS_ACT = WS_R, WS_F = WS_R + 176 * MiB, WS_PP = WS_R;
constexpr size_t WS_DEC = WS_R + 240 * MiB;
constexpr size_t WS_END = WS_DEC + 1 * MiB;
enum { SQ_X = 0, SQ_A = 2, SQ_M = 4, SQ_2 = 6, SQ_F = 8, SQ_3 = 10 };

__constant__ double c_invf[32] = {1.0, 0.7498942093324559, 0.5623413251903491, 0.4216965034285822, 0.31622776601683794, 0.23713737056616552, 0.1778279410038923, 0.1333521432163324, 0.09999999999999999, 0.07498942093324558, 0.056234132519034905, 0.042169650342858224, 0.03162277660168379, 0.023713737056616554, 0.01778279410038923, 0.013335214321633239, 0.01, 0.007498942093324559, 0.005623413251903491, 0.004216965034285822, 0.0031622776601683794, 0.002371373705661655, 0.0017782794100389228, 0.0013335214321633238, 0.001, 0.0007498942093324559, 0.000562341325190349, 0.00042169650342858224, 0.00031622776601683794, 0.00023713737056616554, 0.0001778279410038923, 0.0001333521432163324};

__device__ __forceinline__ float bf2f(unsigned h) { return __uint_as_float(h << 16); }
__device__ __forceinline__ float bflo(unsigned w) { return __uint_as_float(w << 16); }
__device__ __forceinline__ float bfhi(unsigned w) { return __uint_as_float(w & 0xffff0000u); }
__device__ __forceinline__ unsigned f2bf(float f) { unsigned u = __float_as_uint(f); return (u + 0x7fffu + ((u >> 16) & 1u)) >> 16; }
__device__ __forceinline__ unsigned pk2(float lo, float hi) { return f2bf(lo) | (f2bf(hi) << 16); }
__device__ __forceinline__ float shx(float v, int lane, int m) { return __int_as_float(__builtin_amdgcn_ds_bpermute((lane ^ m) << 2, __float_as_int(v))); }
__device__ __forceinline__ float wave_sum(float v, int lane) {
#pragma unroll
    for (int o = 1; o < 64; o <<= 1) v += shx(v, lane, o);
    return v;
}
typedef unsigned long long u64;
__device__ __forceinline__ u64 fx_enc(float q) { return (u64)__float2ll_rn(q * 16777216.0f); }
__device__ __forceinline__ float fx_dec(u64 v) { return __ll2float_rn((long long)v) * (1.0f / 16777216.0f); }
__device__ __forceinline__ void fx_add(u64* p, float q) { atomicAdd(p, fx_enc(q)); }
__device__ __forceinline__ float sigmoidf_(float z) { return __builtin_amdgcn_rcpf(1.0f + __builtin_amdgcn_exp2f(-LOG2E * z)); }
__device__ __forceinline__ float siluf_(float z) { return z * __builtin_amdgcn_rcpf(1.0f + __builtin_amdgcn_exp2f(-LOG2E * z)); }

struct EpiIn {
    static constexpr bool PERM = true, MID = false;
    int kmid;
    const u64* ssqX; const float* cs; const float* lb;
    bf16_t* QH; bf16_t* Kb; bf16_t* Vb; float* G; bf16_t* KIN; bf16_t* HI; bf16_t* HG;
    __device__ __forceinline__ void mid(f32x4 (&acc)[2][2][4][2], const Unit& u, int wr, int wc, int fr, int fq) const {}
    __device__ __forceinline__ void operator()(const f32x4 (&acc)[2][2][4][2], const Unit& u, int wr, int wc, int fr, int fq) const {
        const int pn = u.pn;
#pragma unroll
        for (int ai = 0; ai < 2; ++ai)
#pragma unroll
            for (int m = 0; m < 4; ++m) {
                const int row = u.pm * 256 + ai * 128 + wr * 64 + m * 16 + fr;
                const float rs = rsqrtf(fx_dec(ssqX[row]) * (1.0f / DM) + EPS);
                if (pn <= 4) {
                    const int d0 = 8 * fq;
                    const f32x4 c0 = *(const f32x4*)(cs + (size_t)row * 64 + d0), c1 = *(const f32x4*)(cs + (size_t)row * 64 + d0 + 4);
                    const f32x4 s0 = *(const f32x4*)(cs + (size_t)row * 64 + 32 + d0), s1 = *(const f32x4*)(cs + (size_t)row * 64 + 32 + d0 + 4);
                    const float sc = (pn < 4) ? rs * QSCALE : rs;
                    const f32x4 a0 = acc[ai][0][m][0] * sc, a1 = acc[ai][0][m][1] * sc, b0 = acc[ai][1][m][0] * sc, b1 = acc[ai][1][m][1] * sc;
                    const f32x4 o10 = a0 * c0 - b0 * s0, o11 = a1 * c1 - b1 * s1, o20 = b0 * c0 + a0 * s0, o21 = b1 * c1 + a1 * s1;
                    u32x4 w1, w2;
                    w1.x = cvt_pk_bf16(o10[0], o10[1]); w1.y = cvt_pk_bf16(o10[2], o10[3]); w1.z = cvt_pk_bf16(o11[0], o11[1]); w1.w = cvt_pk_bf16(o11[2], o11[3]);
                    w2.x = cvt_pk_bf16(o20[0], o20[1]); w2.y = cvt_pk_bf16(o20[2], o20[3]); w2.z = cvt_pk_bf16(o21[0], o21[1]); w2.w = cvt_pk_bf16(o21[2], o21[3]);
                    bf16_t* dst = (pn < 4) ? (QH + (size_t)row * 2048 + (pn * 4 + wc) * 64 + d0) : (Kb + (size_t)row * 256 + wc * 64 + d0);
                    *(u32x4*)dst = w1; *(u32x4*)(dst + 32) = w2;
                } else {
#pragma unroll
                    for (int bj = 0; bj < 2; ++bj) {
                        const int cl = bj * 128 + wc * 32 + 8 * fq;
                        f32x4 v0 = acc[ai][bj][m][0] * rs, v1 = acc[ai][bj][m][1] * rs;
                        if (pn == 5) {
                            u32x4 w; w.x = cvt_pk_bf16(v0[0], v0[1]); w.y = cvt_pk_bf16(v0[2], v0[3]); w.z = cvt_pk_bf16(v1[0], v1[1]); w.w = cvt_pk_bf16(v1[2], v1[3]);
                            *(u32x4*)(Vb + (size_t)row * 256 + cl) = w;
                        } else if (pn < 10) {
                            const int c = (pn - 6) * 256 + cl;
#pragma unroll
                            for (int j = 0; j < 4; ++j) { v0[j] = siluf_(v0[j]); v1[j] = siluf_(v1[j]); }
                            u32x4 w; w.x = cvt_pk_bf16(v0[0], v0[1]); w.y = cvt_pk_bf16(v0[2], v0[3]); w.z = cvt_pk_bf16(v1[0], v1[1]); w.w = cvt_pk_bf16(v1[2], v1[3]);
                            *(u32x4*)(QH + (size_t)row * 2048 + 1024 + c) = w;
                        } else if (pn < 14) {
                            const int c = (pn - 10) * 256 + cl;
                            const f32x4 l0 = *(const f32x4*)(lb + c), l1 = *(const f32x4*)(lb + c + 4);
                            f32x4 g0, g1, k0, k1;
#pragma unroll
                            for (int j = 0; j < 4; ++j) {
                                { const float z = fminf(fmaxf(v0[j], -30.f), 30.f), e = __builtin_amdgcn_exp2f(-LOG2E * z), sg = __builtin_amdgcn_rcpf(1.0f + e), om = 1.0f - l0[j]; g0[j] = __logf(l0[j] + om * sg); k0[j] = om * e * sg; }
                                { const float z = fminf(fmaxf(v1[j], -30.f), 30.f), e = __builtin_amdgcn_exp2f(-LOG2E * z), sg = __builtin_amdgcn_rcpf(1.0f + e), om = 1.0f - l1[j]; g1[j] = __logf(l1[j] + om * sg); k1[j] = om * e * sg; }
                            }
                            *(f32x4*)(G + (size_t)row * 1024 + c) = g0; *(f32x4*)(G + (size_t)row * 1024 + c + 4) = g1;
                            u32x4 w; w.x = cvt_pk_bf16(k0[0], k0[1]); w.y = cvt_pk_bf16(k0[2], k0[3]); w.z = cvt_pk_bf16(k1[0], k1[1]); w.w = cvt_pk_bf16(k1[2], k1[3]);
                            *(u32x4*)(KIN + (size_t)row * 1024 + c) = w;
                        } else if (pn < 18) {
                            const int c = (pn - 14) * 256 + cl;
                            u32x4 w; w.x = cvt_pk_bf16(v0[0], v0[1]); w.y = cvt_pk_bf16(v0[2], v0[3]); w.z = cvt_pk_bf16(v1[0], v1[1]); w.w = cvt_pk_bf16(v1[2], v1[3]);
                            *(u32x4*)(HI + (size_t)row * 1024 + c) = w;
                        } else {
                            const int c = (pn - 18) * 256 + cl;
#pragma unroll
                            for (int j = 0; j < 4; ++j) { v0[j] = siluf_(v0[j]); v1[j] = siluf_(v1[j]); }
                            u32x4 w; w.x = cvt_pk_bf16(v0[0], v0[1]); w.y = cvt_pk_bf16(v0[2], v0[3]); w.z = cvt_pk_bf16(v1[0], v1[1]); w.w = cvt_pk_bf16(v1[2], v1[3]);
                            *(u32x4*)(HG + (size_t)row * 1024 + c) = w;
                        }
                    }
                }
                asm volatile("" ::: "memory");
            }
    }
};

template <bool MIDS> struct EpiRowSsq {
    static constexpr bool PERM = true, MID = MIDS;
    int kmid;
    bf16_t* O; u64* ssq; const u64* ssqA;
    __device__ __forceinline__ void mid(f32x4 (&acc)[2][2][4][2], const Unit& u, int wr, int wc, int fr, int fq) const {
#pragma unroll
        for (int ai = 0; ai < 2; ++ai)
#pragma unroll
            for (int m = 0; m < 4; ++m) {
                const int row = u.pm * 256 + ai * 128 + wr * 64 + m * 16 + fr;
                const float s = rsqrtf(fx_dec(ssqA[row]) * (1.0f / 1024.0f) + EPS);
#pragma unroll
                for (int bj = 0; bj < 2; ++bj)
#pragma unroll
                    for (int n = 0; n < 2; ++n) acc[ai][bj][m][n] = acc[ai][bj][m][n] * s;
            }
    }
    __device__ __forceinline__ void operator()(const f32x4 (&acc)[2][2][4][2], const Unit& u, int wr, int wc, int fr, int fq) const {
#pragma unroll
        for (int ai = 0; ai < 2; ++ai)
#pragma unroll
            for (int m = 0; m < 4; ++m) {
                const int row = u.pm * 256 + ai * 128 + wr * 64 + m * 16 + fr;
                float q = 0.f;
#pragma unroll
                for (int bj = 0; bj < 2; ++bj) {
                    const f32x4 v0 = acc[ai][bj][m][0], v1 = acc[ai][bj][m][1];
                    q += (v0[0] * v0[0] + v0[1] * v0[1]) + (v0[2] * v0[2] + v0[3] * v0[3]) + (v1[0] * v1[0] + v1[1] * v1[1]) + (v1[2] * v1[2] + v1[3] * v1[3]);
                    u32x4 w; w.x = cvt_pk_bf16(v0[0], v0[1]); w.y = cvt_pk_bf16(v0[2], v0[3]); w.z = cvt_pk_bf16(v1[0], v1[1]); w.w = cvt_pk_bf16(v1[2], v1[3]);
                    *(u32x4*)(O + (size_t)row * 2048 + u.pn * 256 + bj * 128 + wc * 32 + 8 * fq) = w;
                }
                q += shx(q, fq * 16 + fr, 16); q += shx(q, fq * 16 + fr, 32);
                if (fq == 0) fx_add(ssq + row, q);
                asm volatile("" ::: "memory");
            }
    }
};

struct EpiGU {
    static constexpr bool PERM = true, MID = false;
    int kmid;
    const u64* ssq2; bf16_t* ACT;
    __device__ __forceinline__ void mid(f32x4 (&acc)[2][2][4][2], const Unit& u, int wr, int wc, int fr, int fq) const {}
    __device__ __forceinline__ void operator()(const f32x4 (&acc)[2][2][4][2], const Unit& u, int wr, int wc, int fr, int fq) const {
#pragma unroll
        for (int ai = 0; ai < 2; ++ai)
#pragma unroll
            for (int m = 0; m < 4; ++m) {
                const int row = u.pm * 256 + ai * 128 + wr * 64 + m * 16 + fr;
                const float rs = rsqrtf(fx_dec(ssq2[row]) * (1.0f / DM) + EPS);
                f32x4 o0, o1;
#pragma unroll
                for (int j = 0; j < 4; ++j) {
                    const float g0 = acc[ai][0][m][0][j] * rs, u0 = acc[ai][1][m][0][j] * rs, g1 = acc[ai][0][m][1][j] * rs, u1 = acc[ai][1][m][1][j] * rs;
                    o0[j] = siluf_(g0) * u0; o1[j] = siluf_(g1) * u1;
                }
                u32x4 w; w.x = cvt_pk_bf16(o0[0], o0[1]); w.y = cvt_pk_bf16(o0[2], o0[3]); w.z = cvt_pk_bf16(o1[0], o1[1]); w.w = cvt_pk_bf16(o1[2], o1[3]);
                *(u32x4*)(ACT + (size_t)row * DFF + u.pn * 128 + wc * 32 + 8 * fq) = w;
                asm volatile("" ::: "memory");
            }
    }
};

struct EpiPlain {
    static constexpr bool PERM = true, MID = false;
    int kmid;
    bf16_t* O;
    __device__ __forceinline__ void mid(f32x4 (&acc)[2][2][4][2], const Unit& u, int wr, int wc, int fr, int fq) const {}
    __device__ __forceinline__ void operator()(const f32x4 (&acc)[2][2][4][2], const Unit& u, int wr, int wc, int fr, int fq) const {
#pragma unroll
        for (int ai = 0; ai < 2; ++ai)
#pragma unroll
            for (int m = 0; m < 4; ++m) {
                const int row = u.pm * 256 + ai * 128 + wr * 64 + m * 16 + fr;
#pragma unroll
                for (int bj = 0; bj < 2; ++bj) {
                    const f32x4 v0 = acc[ai][bj][m][0], v1 = acc[ai][bj][m][1];
                    u32x4 w; w.x = cvt_pk_bf16(v0[0], v0[1]); w.y = cvt_pk_bf16(v0[2], v0[3]); w.z = cvt_pk_bf16(v1[0], v1[1]); w.w = cvt_pk_bf16(v1[2], v1[3]);
                    *(u32x4*)(O + (size_t)row * 2048 + u.pn * 256 + bj * 128 + wc * 32 + 8 * fq) = w;
                }
                asm volatile("" ::: "memory");
            }
    }
};

struct EpiPle {
    static constexpr bool PERM = true, MID = false;
    int kmid;
    const u64* ssq3; const bf16_t* PP; const bf16_t* XB; float* OUT; bf16_t* HAn; u64* ssqN; int has_next;
    __device__ __forceinline__ void mid(f32x4 (&acc)[2][2][4][2], const Unit& u, int wr, int wc, int fr, int fq) const {}
    __device__ __forceinline__ void operator()(const f32x4 (&acc)[2][2][4][2], const Unit& u, int wr, int wc, int fr, int fq) const {
#pragma unroll
        for (int ai = 0; ai < 2; ++ai)
#pragma unroll
            for (int m = 0; m < 4; ++m) {
                const int row = u.pm * 256 + ai * 128 + wr * 64 + m * 16 + fr;
                const float rs = rsqrtf(fx_dec(ssq3[row]) * (1.0f / DM) + EPS);
                float q = 0.f;
#pragma unroll
                for (int bj = 0; bj < 2; ++bj) {
                    const size_t off = (size_t)row * 2048 + u.pn * 256 + bj * 128 + wc * 32 + 8 * fq;
                    const u32x4 pw = *(const u32x4*)(PP + off); const u32x4 xv = *(const u32x4*)(XB + off);
                    f32x4 x0 = (f32x4){bflo(xv.x), bfhi(xv.x), bflo(xv.y), bfhi(xv.y)}, x1 = (f32x4){bflo(xv.z), bfhi(xv.z), bflo(xv.w), bfhi(xv.w)};
                    const f32x4 v0 = acc[ai][bj][m][0] * rs, v1 = acc[ai][bj][m][1] * rs;
                    x0[0] += bflo(pw.x) * sigmoidf_(v0[0]); x0[1] += bfhi(pw.x) * sigmoidf_(v0[1]); x0[2] += bflo(pw.y) * sigmoidf_(v0[2]); x0[3] += bfhi(pw.y) * sigmoidf_(v0[3]);
                    x1[0] += bflo(pw.z) * sigmoidf_(v1[0]); x1[1] += bfhi(pw.z) * sigmoidf_(v1[1]); x1[2] += bflo(pw.w) * sigmoidf_(v1[2]); x1[3] += bfhi(pw.w) * sigmoidf_(v1[3]);
                    if (has_next) {
                        q += (x0[0] * x0[0] + x0[1] * x0[1]) + (x0[2] * x0[2] + x0[3] * x0[3]) + (x1[0] * x1[0] + x1[1] * x1[1]) + (x1[2] * x1[2] + x1[3] * x1[3]);
                        u32x4 w; w.x = cvt_pk_bf16(x0[0], x0[1]); w.y = cvt_pk_bf16(x0[2], x0[3]); w.z = cvt_pk_bf16(x1[0], x1[1]); w.w = cvt_pk_bf16(x1[2], x1[3]);
                        *(u32x4*)(HAn + off) = w;
                    } else { *(f32x4*)(OUT + off) = x0; *(f32x4*)(OUT + off + 4) = x1; }
                }
                if (has_next) { q += shx(q, fq * 16 + fr, 16); q += shx(q, fq * 16 + fr, 32); if (fq == 0) fx_add(ssqN + row, q); }
                asm volatile("" ::: "memory");
            }
    }
};

__device__ __forceinline__ void tr_item(const float* W, int ldw, int K, int k0, int n0, bf16_t* WT, int prow0, const float* gain, LAS float* scr, int lane) {
    f32x4 v[8];
#pragma unroll
    for (int i = 0; i < 8; ++i) { const int kk = 8 * i + (lane >> 3); v[i] = *(const f32x4*)(W + (size_t)(k0 + kk) * ldw + n0 + 4 * (lane & 7)); }
#pragma unroll
    for (int i = 0; i < 8; ++i) { const int kk = 8 * i + (lane >> 3); const float gsc = gain ? gain[k0 + kk] : 1.0f; LAS float* d = scr + kk * 33 + 4 * (lane & 7);
        d[0] = v[i][0] * gsc; d[1] = v[i][1] * gsc; d[2] = v[i][2] * gsc; d[3] = v[i][3] * gsc; }
    asm volatile("s_waitcnt lgkmcnt(0)" ::: "memory");
    const int c = lane & 7;
#pragma unroll
    for (int j = 0; j < 4; ++j) { const int n = (lane >> 3) + 8 * j; const LAS float* s = scr + (8 * c) * 33 + n;
        u32x4 o; o.x = pk2(s[0 * 33], s[1 * 33]); o.y = pk2(s[2 * 33], s[3 * 33]); o.z = pk2(s[4 * 33], s[5 * 33]); o.w = pk2(s[6 * 33], s[7 * 33]);
        *(u32x4*)(WT + (size_t)(prow0 + n) * K + k0 + 8 * c) = o; }
    asm volatile("s_waitcnt lgkmcnt(0)" ::: "memory");
}

struct Args { const void* in[19]; float* out; unsigned char* ws; };

template <bool SRC_F32>
__device__ __forceinline__ void row_phase(const float* xsrc32, const bf16_t* xsrc16, const bf16_t* Mb, const u64* ssqIn, const float* gain, bf16_t* XB, u64* ssqOut, int gw, int ngw, int lane) {
    for (int row = gw; row < T; row += ngw) {
        const float rm = rsqrtf(fx_dec(ssqIn[row]) * (1.0f / DM) + EPS);
        float ss = 0.f;
#pragma unroll
        for (int j = 0; j < 4; ++j) {
            const int c = j * 512 + lane * 8; const size_t off = (size_t)row * 2048 + c;
            const u32x4 mv = *(const u32x4*)(Mb + off);
            f32x4 x0, x1;
            if (SRC_F32) { x0 = *(const f32x4*)(xsrc32 + off); x1 = *(const f32x4*)(xsrc32 + off + 4); }
            else { const u32x4 xv = *(const u32x4*)(xsrc16 + off); x0 = (f32x4){bflo(xv.x), bfhi(xv.x), bflo(xv.y), bfhi(xv.y)}; x1 = (f32x4){bflo(xv.z), bfhi(xv.z), bflo(xv.w), bfhi(xv.w)}; }
            const f32x4 g0 = *(const f32x4*)(gain + c), g1 = *(const f32x4*)(gain + c + 4);
            x0[0] += bflo(mv.x) * rm * g0[0]; x0[1] += bfhi(mv.x) * rm * g0[1]; x0[2] += bflo(mv.y) * rm * g0[2]; x0[3] += bfhi(mv.y) * rm * g0[3];
            x1[0] += bflo(mv.z) * rm * g1[0]; x1[1] += bfhi(mv.z) * rm * g1[1]; x1[2] += bflo(mv.w) * rm * g1[2]; x1[3] += bfhi(mv.w) * rm * g1[3];
            u32x4 w; w.x = pk2(x0[0], x0[1]); w.y = pk2(x0[2], x0[3]); w.z = pk2(x1[0], x1[1]); w.w = pk2(x1[2], x1[3]);
            *(u32x4*)(XB + off) = w;
            ss += (x0[0] * x0[0] + x0[1] * x0[1]) + (x0[2] * x0[2] + x0[3] * x0[3]) + (x1[0] * x1[0] + x1[1] * x1[1]) + (x1[2] * x1[2] + x1[3] * x1[3]);
        }
        ss = wave_sum(ss, lane);
        if (lane == 0) ssqOut[row] = fx_enc(ss);
    }
}

__device__ __forceinline__ void attn_naive(bf16_t* QH, const bf16_t* Kb, const bf16_t* Vb, const float* sinks, u64* ssqA, int gtid, int nthr) {
    for (int item = gtid; item < T * 16; item += nthr) {
        const int head = item / T, row = item % T, b = row / SEQ, t = row % SEQ, hk = head >> 2;
        float q[64], acc[64];
        const u32x4* qp = (const u32x4*)(QH + (size_t)row * 2048 + head * 64);
#pragma unroll
        for (int c = 0; c < 8; ++c) { const u32x4 w = qp[c]; q[8 * c] = bflo(w.x); q[8 * c + 1] = bfhi(w.x); q[8 * c + 2] = bflo(w.y); q[8 * c + 3] = bfhi(w.y); q[8 * c + 4] = bflo(w.z); q[8 * c + 5] = bfhi(w.z); q[8 * c + 6] = bflo(w.w); q[8 * c + 7] = bfhi(w.w); }
#pragma unroll
        for (int d = 0; d < 64; ++d) acc[d] = 0.f;
        float mx = sinks[head] * LOG2E, l = 1.0f;
        const int j0 = t - 127 < 0 ? 0 : t - 127;
        for (int j = j0; j <= t; ++j) {
            const size_t kr = (size_t)(b * SEQ + j) * 256 + hk * 64;
            const u32x4* kp = (const u32x4*)(Kb + kr);
            float s = 0.f;
#pragma unroll
            for (int c = 0; c < 8; ++c) { const u32x4 w = kp[c]; s += q[8 * c] * bflo(w.x) + q[8 * c + 1] * bfhi(w.x) + q[8 * c + 2] * bflo(w.y) + q[8 * c + 3] * bfhi(w.y) + q[8 * c + 4] * bflo(w.z) + q[8 * c + 5] * bfhi(w.z) + q[8 * c + 6] * bflo(w.w) + q[8 * c + 7] * bfhi(w.w); }
            if (s > mx) { const float cf = exp2f(mx - s); l *= cf;
#pragma unroll
                for (int d = 0; d < 64; ++d) acc[d] *= cf;
                mx = s; }
            const float p = exp2f(s - mx); l += p;
            const u32x4* vp = (const u32x4*)(Vb + kr);
#pragma unroll
            for (int c = 0; c < 8; ++c) { const u32x4 w = vp[c]; acc[8 * c] += p * bflo(w.x); acc[8 * c + 1] += p * bfhi(w.x); acc[8 * c + 2] += p * bflo(w.y); acc[8 * c + 3] += p * bfhi(w.y); acc[8 * c + 4] += p * bflo(w.z); acc[8 * c + 5] += p * bfhi(w.z); acc[8 * c + 6] += p * bflo(w.w); acc[8 * c + 7] += p * bfhi(w.w); }
        }
        const float il = 1.0f / l; float ss = 0.f;
        u32x4* op = (u32x4*)(QH + (size_t)row * 2048 + head * 64);
#pragma unroll
        for (int c = 0; c < 8; ++c) {
            float o[8];
#pragma unroll
            for (int e = 0; e < 8; ++e) { o[e] = acc[8 * c + e] * il; ss += o[e] * o[e]; }
            u32x4 w; w.x = pk2(o[0], o[1]); w.y = pk2(o[2], o[3]); w.z = pk2(o[4], o[5]); w.w = pk2(o[6], o[7]); op[c] = w;
        }
        fx_add(ssqA + row, ss);
    }
}

__device__ __forceinline__ void hgrn_naive(const bf16_t* QH, const bf16_t* KIN, const float* G, const bf16_t* HI, float* tmpO, int item, int lane) {
    const int bh = item >> 1, b = bh >> 3, h = bh & 7, v = (item & 1) * 64 + lane;
    float S[128];
#pragma unroll
    for (int k = 0; k < 128; ++k) S[k] = 0.f;
    int z = 0; asm volatile("v_mov_b32 %0, 0" : "=v"(z));
    for (int t = 0; t < SEQ; ++t) {
        const size_t row = (size_t)b * SEQ + t;
        const float vv = bf2f(HI[row * 1024 + h * 128 + v]);
        const u32x4* qp = (const u32x4*)(QH + row * 2048 + 1024 + h * 128 + z);
        const u32x4* kp = (const u32x4*)(KIN + row * 1024 + h * 128 + z);
        const f32x4* gp = (const f32x4*)(G + row * 1024 + h * 128 + z);
        float o = 0.f;
#pragma unroll
        for (int c = 0; c < 16; ++c) {
            const u32x4 qw = qp[c], kw = kp[c]; const f32x4 g0 = gp[2 * c], g1 = gp[2 * c + 1];
            const float qq[8] = {bflo(qw.x), bfhi(qw.x), bflo(qw.y), bfhi(qw.y), bflo(qw.z), bfhi(qw.z), bflo(qw.w), bfhi(qw.w)};
            const float kk[8] = {bflo(kw.x), bfhi(kw.x), bflo(kw.y), bfhi(kw.y), bflo(kw.z), bfhi(kw.z), bflo(kw.w), bfhi(kw.w)};
            const float gg[8] = {g0[0], g0[1], g0[2], g0[3], g1[0], g1[1], g1[2], g1[3]};
#pragma unroll
            for (int e = 0; e < 8; ++e) { const float f = __expf(gg[e]); S[8 * c + e] = f * S[8 * c + e] + kk[e] * vv; o += S[8 * c + e] * qq[e]; }
        }
        tmpO[row * 1024 + h * 128 + v] = o;
    }
}
__device__ __forceinline__ void hgrn_norm_naive(const float* tmpO, const bf16_t* HG, bf16_t* QH, int gw, int ngw, int lane) {
    for (int row = gw; row < T; row += ngw) {
        const size_t off = (size_t)row * 1024 + lane * 16;
        f32x4 o[4]; float ss = 0.f;
#pragma unroll
        for (int j = 0; j < 4; ++j) { o[j] = *(const f32x4*)(tmpO + off + 4 * j); ss += (o[j][0] * o[j][0] + o[j][1] * o[j][1]) + (o[j][2] * o[j][2] + o[j][3] * o[j][3]); }
        ss += shx(ss, lane, 1); ss += shx(ss, lane, 2); ss += shx(ss, lane, 4);
        const float r = rsqrtf(ss * (1.0f / 128.0f) + EPS);
        const u32x4 g0 = *(const u32x4*)(HG + off), g1 = *(const u32x4*)(HG + off + 8);
        u32x4 w0, w1;
        w0.x = pk2(o[0][0] * r * bflo(g0.x), o[0][1] * r * bfhi(g0.x)); w0.y = pk2(o[0][2] * r * bflo(g0.y), o[0][3] * r * bfhi(g0.y));
        w0.z = pk2(o[1][0] * r * bflo(g0.z), o[1][1] * r * bfhi(g0.z)); w0.w = pk2(o[1][2] * r * bflo(g0.w), o[1][3] * r * bfhi(g0.w));
        w1.x = pk2(o[2][0] * r * bflo(g1.x), o[2][1] * r * bfhi(g1.x)); w1.y = pk2(o[2][2] * r * bflo(g1.y), o[2][3] * r * bfhi(g1.y));
        w1.z = pk2(o[3][0] * r * bflo(g1.z), o[3][1] * r * bfhi(g1.z)); w1.w = pk2(o[3][2] * r * bflo(g1.w), o[3][3] * r * bfhi(g1.w));
        bf16_t* dst = QH + (size_t)row * 2048 + 1024 + lane * 16;
        *(u32x4*)dst = w0; *(u32x4*)(dst + 8) = w1;
    }
}


typedef float f32x16 __attribute__((ext_vector_type(16)));
typedef short bf16x8 __attribute__((ext_vector_type(8)));
typedef unsigned u32x2 __attribute__((ext_vector_type(2)));
__device__ __forceinline__ int crow(int r, int hi) { return (r & 3) + 8 * (r >> 2) + 4 * hi; }
__device__ __forceinline__ bf16x8 pack8(float a0, float a1, float a2, float a3, float a4, float a5, float a6, float a7) {
    u32x4 w; w.x = cvt_pk_bf16(a0, a1); w.y = cvt_pk_bf16(a2, a3); w.z = cvt_pk_bf16(a4, a5); w.w = cvt_pk_bf16(a6, a7); return __builtin_bit_cast(bf16x8, w);
}
constexpr int AT_KSTR = 144, AT_VSTR = 528, AT_VOFF = 256 * AT_KSTR;

__device__ __forceinline__ void attn_unit(LAS unsigned char* lds, bf16_t* QH, const bf16_t* Kb, const bf16_t* Vb, const float* sinks, u64* ssqA, int unit, int tid, int lane, int wave) {
    const int hk = unit & 3, n = (unit >> 2) & 31, b = unit >> 7;
    const long rowbase = (long)b * SEQ + n * 128 - 128;
    LAS unsigned char* Ks = lds; LAS unsigned char* Vt = lds + AT_VOFF;
#pragma unroll
    for (int i = 0; i < 4; ++i) {
        const int row = (tid >> 3) + 64 * i; u32x4 v = (u32x4){0u, 0u, 0u, 0u};
        if (n > 0 || row >= 128) v = *(const u32x4*)(Kb + (rowbase + row) * 256 + hk * 64 + (tid & 7) * 8);
        *(LAS u32x4*)(Ks + row * AT_KSTR + (tid & 7) * 16) = v;
    }
#pragma unroll
    for (int i = 0; i < 4; ++i) {
        const int key = lane + 64 * i; u32x4 v = (u32x4){0u, 0u, 0u, 0u};
        if (n > 0 || key >= 128) v = *(const u32x4*)(Vb + (rowbase + key) * 256 + hk * 64 + wave * 8);
        LAS unsigned short* vp = (LAS unsigned short*)(Vt + (wave * 8) * AT_VSTR + key * 2);
        vp[0 * 264] = (unsigned short)(v.x & 0xffffu); vp[1 * 264] = (unsigned short)(v.x >> 16); vp[2 * 264] = (unsigned short)(v.y & 0xffffu); vp[3 * 264] = (unsigned short)(v.y >> 16);
        vp[4 * 264] = (unsigned short)(v.z & 0xffffu); vp[5 * 264] = (unsigned short)(v.z >> 16); vp[6 * 264] = (unsigned short)(v.w & 0xffffu); vp[7 * 264] = (unsigned short)(v.w >> 16);
    }
    __syncthreads();
    const int g = wave >> 1, qh = wave & 1, head = hk * 4 + g, r = lane & 31, h = lane >> 5;
    const float sink2 = sinks[head] * LOG2E;
    for (int qt = 0; qt < 2; ++qt) {
        const int t0 = 64 * qh + 32 * qt, t = t0 + r;
        const size_t qrow = (size_t)b * SEQ + n * 128 + t;
        bf16_t* qp = QH + qrow * 2048 + head * 64;
        bf16x8 qf[4];
#pragma unroll
        for (int s4 = 0; s4 < 4; ++s4) qf[s4] = *(const bf16x8*)(qp + 16 * s4 + 8 * h);
        f32x16 S[5];
#pragma unroll
        for (int jt = 0; jt < 5; ++jt) {
            const int kb = t0 + 32 * jt;
            f32x16 a = {};
#pragma unroll
            for (int s4 = 0; s4 < 4; ++s4) { const bf16x8 kf = *(const LAS bf16x8*)(Ks + (kb + r) * AT_KSTR + (16 * s4 + 8 * h) * 2); a = __builtin_amdgcn_mfma_f32_32x32x16_bf16(kf, qf[s4], a, 0, 0, 0); }
            S[jt] = a;
        }
        float mx = sink2;
#pragma unroll
        for (int jt = 0; jt < 5; ++jt)
#pragma unroll
            for (int rg = 0; rg < 16; ++rg) {
                const int ki = t0 + 32 * jt + crow(rg, h);
                const bool ok = (ki > t) && (ki <= t + 128) && (n > 0 || ki >= 128);
                const float v = ok ? S[jt][rg] : -1e30f; S[jt][rg] = v; mx = fmaxf(mx, v);
            }
        mx = fmaxf(mx, shx(mx, lane, 32));
        float l = 0.f;
#pragma unroll
        for (int jt = 0; jt < 5; ++jt)
#pragma unroll
            for (int rg = 0; rg < 16; ++rg) { const float p = __builtin_amdgcn_exp2f(S[jt][rg] - mx); S[jt][rg] = p; l += p; }
        l += shx(l, lane, 32);
        l += __builtin_amdgcn_exp2f(sink2 - mx);
        f32x16 O[2]; O[0] = (f32x16){}; O[1] = (f32x16){};
#pragma unroll
        for (int jt = 0; jt < 5; ++jt)
#pragma unroll
            for (int sp = 0; sp < 2; ++sp) {
                const bf16x8 pf = pack8(S[jt][8 * sp], S[jt][8 * sp + 1], S[jt][8 * sp + 2], S[jt][8 * sp + 3], S[jt][8 * sp + 4], S[jt][8 * sp + 5], S[jt][8 * sp + 6], S[jt][8 * sp + 7]);
                const int kk = t0 + 32 * jt + 16 * sp + 4 * h;
#pragma unroll
                for (int dt = 0; dt < 2; ++dt) {
                    const LAS unsigned char* vrow = Vt + (32 * dt + r) * AT_VSTR + kk * 2;
                    const u32x2 lo = *(const LAS u32x2*)vrow, hi2 = *(const LAS u32x2*)(vrow + 16);
                    u32x4 w; w.x = lo.x; w.y = lo.y; w.z = hi2.x; w.w = hi2.y;
                    O[dt] = __builtin_amdgcn_mfma_f32_32x32x16_bf16(__builtin_bit_cast(bf16x8, w), pf, O[dt], 0, 0, 0);
                }
            }
        const float il = 1.0f / l; float ss = 0.f;
#pragma unroll
        for (int dt = 0; dt < 2; ++dt)
#pragma unroll
            for (int gp = 0; gp < 4; ++gp) {
                const float o0 = O[dt][4 * gp] * il, o1 = O[dt][4 * gp + 1] * il, o2 = O[dt][4 * gp + 2] * il, o3 = O[dt][4 * gp + 3] * il;
                ss += (o0 * o0 + o1 * o1) + (o2 * o2 + o3 * o3);
                u32x2 w; w.x = cvt_pk_bf16(o0, o1); w.y = cvt_pk_bf16(o2, o3);
                *(u32x2*)(qp + 32 * dt + 8 * gp + 4 * h) = w;
            }
        ss += shx(ss, lane, 32);
        if (h == 0) fx_add(ssqA + qrow, ss);
    }
    __syncthreads();
}

#define LBAR() asm volatile("s_waitcnt lgkmcnt(0)\n\ts_barrier" ::: "memory")
constexpr int HG_STR = 144;
__device__ __forceinline__ void hgrn_h1_phase(LAS unsigned char* lds, const bf16_t* KIN, const float* G, const bf16_t* HI, bf16_t* SB, float* DEC, int bx, int Gd, int tid, int lane, int wave) {
    LAS unsigned char* Kt = lds;
    LAS unsigned char* Vt = lds + 128 * HG_STR;
    LAS float* tot = (LAS float*)(lds + 2 * 128 * HG_STR);
    const int k = tid & 127, sg = tid >> 7;
    float g[16]; unsigned kr[16], vr[16];
#define H1_LOAD(U) do { const int c_ = (U) & 63, bh_ = (U) >> 6; const size_t r0_ = (size_t)(bh_ >> 3) * SEQ + c_ * 64 + sg * 16; const int col_ = (bh_ & 7) * 128 + k; \
        _Pragma("unroll") for (int i = 0; i < 16; ++i) { g[i] = G[(r0_ + i) * 1024 + col_]; kr[i] = KIN[(r0_ + i) * 1024 + col_]; vr[i] = HI[(r0_ + i) * 1024 + col_]; } } while (0)
    int u = bx;
    if (u < 2048) H1_LOAD(u);
    for (; u < 2048; u += Gd) {
        float bl[16]; float run = 0.f;
#pragma unroll
        for (int i = 0; i < 16; ++i) { run += g[i]; bl[i] = run; }
        tot[sg * 128 + k] = run;
        LBAR();
        const float t0 = tot[k], t1 = tot[128 + k], t2 = tot[256 + k], t3 = tot[384 + k];
        const float blast = (t0 + t1) + (t2 + t3);
        const float off = (sg > 0 ? t0 : 0.f) + (sg > 1 ? t1 : 0.f) + (sg > 2 ? t2 : 0.f);
        if (sg == 0) DEC[(size_t)u * 128 + k] = __expf(blast);
        float kt[16];
#pragma unroll
        for (int i = 0; i < 16; ++i) kt[i] = bf2f(kr[i]) * __expf(blast - (bl[i] + off));
        {
            u32x4 w0, w1;
            w0.x = pk2(kt[0], kt[1]); w0.y = pk2(kt[2], kt[3]); w0.z = pk2(kt[4], kt[5]); w0.w = pk2(kt[6], kt[7]);
            w1.x = pk2(kt[8], kt[9]); w1.y = pk2(kt[10], kt[11]); w1.z = pk2(kt[12], kt[13]); w1.w = pk2(kt[14], kt[15]);
            *(LAS u32x4*)(Kt + k * HG_STR + sg * 32) = w0; *(LAS u32x4*)(Kt + k * HG_STR + sg * 32 + 16) = w1;
            w0.x = vr[0] | (vr[1] << 16); w0.y = vr[2] | (vr[3] << 16); w0.z = vr[4] | (vr[5] << 16); w0.w = vr[6] | (vr[7] << 16);
            w1.x = vr[8] | (vr[9] << 16); w1.y = vr[10] | (vr[11] << 16); w1.z = vr[12] | (vr[13] << 16); w1.w = vr[14] | (vr[15] << 16);
            *(LAS u32x4*)(Vt + k * HG_STR + sg * 32) = w0; *(LAS u32x4*)(Vt + k * HG_STR + sg * 32 + 16) = w1;
        }
        if (u + Gd < 2048) H1_LOAD(u + Gd);
        LBAR();
        const int vt = wave >> 1, kt0 = (wave & 1) * 2, r = lane & 31, hh = lane >> 5;
        f32x16 acc0 = {}, acc1 = {};
#pragma unroll
        for (int st = 0; st < 4; ++st) {
            const bf16x8 af = *(const LAS bf16x8*)(Vt + (32 * vt + r) * HG_STR + (16 * st + 8 * hh) * 2);
            const bf16x8 b0 = *(const LAS bf16x8*)(Kt + (32 * kt0 + r) * HG_STR + (16 * st + 8 * hh) * 2);
            const bf16x8 b1 = *(const LAS bf16x8*)(Kt + (32 * (kt0 + 1) + r) * HG_STR + (16 * st + 8 * hh) * 2);
            acc0 = __builtin_amdgcn_mfma_f32_32x32x16_bf16(af, b0, acc0, 0, 0, 0);
            acc1 = __builtin_amdgcn_mfma_f32_32x32x16_bf16(af, b1, acc1, 0, 0, 0);
        }
        bf16_t* sb = SB + (size_t)u * 16384;
#pragma unroll
        for (int rg = 0; rg < 16; ++rg) {
            const int v = 32 * vt + crow(rg, hh);
            sb[v * 128 + 32 * kt0 + r] = (bf16_t)f2bf(acc0[rg]);
            sb[v * 128 + 32 * (kt0 + 1) + r] = (bf16_t)f2bf(acc1[rg]);
        }
    }
    LBAR();
#undef H1_LOAD
}

__device__ __forceinline__ void hgrn_scan(bf16_t* SB, const float* DEC, int gtid, int nthr) {
    for (int item = gtid; item < 32 * 128 * 32; item += nthr) {
        const int kq = item & 31, v = (item >> 5) & 127, bh = item >> 12;
        f32x4 st = (f32x4){0.f, 0.f, 0.f, 0.f};
        u32x2* p = (u32x2*)(SB + ((size_t)bh * 64 * 128 + v) * 128 + kq * 4);
        const f32x4* dp = (const f32x4*)(DEC + (size_t)bh * 64 * 128 + kq * 4);
#pragma unroll 8
        for (int c = 0; c < 64; ++c) {
            const u32x2 d = p[(size_t)c * 16384 / 4]; const f32x4 dc = dp[c * 32];
            u32x2 o; o.x = cvt_pk_bf16(st[0], st[1]); o.y = cvt_pk_bf16(st[2], st[3]);
            p[(size_t)c * 16384 / 4] = o;
            st[0] = dc[0] * st[0] + bflo(d.x); st[1] = dc[1] * st[1] + bfhi(d.x); st[2] = dc[2] * st[2] + bflo(d.y); st[3] = dc[3] * st[3] + bfhi(d.y);
        }
    }
}

constexpr int H3_BSTR = 528, H3_QSTR = 272, H3_B_OFF = 0, H3_Q_OFF = 64 * H3_BSTR, H3_K_OFF = H3_Q_OFF + 64 * H3_QSTR, H3_V_OFF = H3_K_OFF + 64 * H3_QSTR, H3_T_OFF = H3_V_OFF + 128 * HG_STR, H3_O_OFF = H3_T_OFF + 2048;
__device__ __forceinline__ void hgrn_h3_phase(LAS unsigned char* lds, bf16_t* QH, const bf16_t* KIN, const float* G, const bf16_t* HI, const bf16_t* HG, const bf16_t* SB, int bx, int Gd, int tid, int lane, int wave) {
    LAS unsigned char* Bl = lds + H3_B_OFF;
    LAS unsigned char* Qs = lds + H3_Q_OFF;
    LAS unsigned char* Ks = lds + H3_K_OFF;
    LAS unsigned char* Vt = lds + H3_V_OFF;
    LAS float* tot = (LAS float*)(lds + H3_T_OFF);
    LAS float* osq = (LAS float*)(lds + H3_O_OFF);
    const int k = tid & 127, sg = tid >> 7;
    const int i4 = wave & 3, vh = wave >> 2, fr = lane & 15, hh = lane >> 4;
    const int tq = 16 * i4 + fr;
    float g[16]; unsigned vr[16]; u32x4 qv[2], kv[2];
#define H3_LOAD(U) do { const int c_ = (U) & 63, bh_ = (U) >> 6; const size_t rb_ = (size_t)(bh_ >> 3) * SEQ + c_ * 64; const int hc_ = (bh_ & 7) * 128; \
        _Pragma("unroll") for (int i = 0; i < 16; ++i) { g[i] = G[(rb_ + sg * 16 + i) * 1024 + hc_ + k]; vr[i] = HI[(rb_ + sg * 16 + i) * 1024 + hc_ + k]; } \
        _Pragma("unroll") for (int i = 0; i < 2; ++i) { const int idx_ = tid + 512 * i, rr_ = idx_ >> 4, ch_ = idx_ & 15; \
            qv[i] = *(const u32x4*)(QH + (rb_ + rr_) * 2048 + 1024 + hc_ + ch_ * 8); kv[i] = *(const u32x4*)(KIN + (rb_ + rr_) * 1024 + hc_ + ch_ * 8); } } while (0)
    int u = bx;
    if (u < 2048) H3_LOAD(u);
    for (; u < 2048; u += Gd) {
        const int c = u & 63, bh = u >> 6, b = bh >> 3, h = bh & 7;
        const size_t row0 = (size_t)b * SEQ + c * 64;
        float bl[16];
        {
            float run = 0.f;
#pragma unroll
            for (int i = 0; i < 16; ++i) { run += g[i]; bl[i] = run; }
            tot[sg * 128 + k] = run;
            u32x4 w0, w1;
            w0.x = vr[0] | (vr[1] << 16); w0.y = vr[2] | (vr[3] << 16); w0.z = vr[4] | (vr[5] << 16); w0.w = vr[6] | (vr[7] << 16);
            w1.x = vr[8] | (vr[9] << 16); w1.y = vr[10] | (vr[11] << 16); w1.z = vr[12] | (vr[13] << 16); w1.w = vr[14] | (vr[15] << 16);
            *(LAS u32x4*)(Vt + k * HG_STR + sg * 32) = w0; *(LAS u32x4*)(Vt + k * HG_STR + sg * 32 + 16) = w1;
#pragma unroll
            for (int i = 0; i < 2; ++i) { const int idx = tid + 512 * i, rr = idx >> 4, ch = idx & 15;
                *(LAS u32x4*)(Qs + rr * H3_QSTR + ch * 16) = qv[i]; *(LAS u32x4*)(Ks + rr * H3_QSTR + ch * 16) = kv[i]; }
        }
        LBAR();
        {
            const float t0 = tot[k], t1 = tot[128 + k], t2 = tot[256 + k];
            const float off = (sg > 0 ? t0 : 0.f) + (sg > 1 ? t1 : 0.f) + (sg > 2 ? t2 : 0.f);
#pragma unroll
            for (int i = 0; i < 16; ++i) *(LAS float*)(Bl + (sg * 16 + i) * H3_BSTR + k * 4) = bl[i] + off;
        }
        if (u + Gd < 2048) H3_LOAD(u + Gd);
        LBAR();
        bf16x8 sf[4][4];
        {
            const bf16_t* sb = SB + (size_t)u * 16384;
#pragma unroll
            for (int vt = 0; vt < 4; ++vt)
#pragma unroll
                for (int ks = 0; ks < 4; ++ks) sf[vt][ks] = *(const bf16x8*)(sb + (64 * vh + 16 * vt + fr) * 128 + 32 * ks + 8 * hh);
        }
        u32x2 gate[4];
#pragma unroll
        for (int vt = 0; vt < 4; ++vt) gate[vt] = *(const u32x2*)(HG + (row0 + tq) * 1024 + h * 128 + 64 * vh + 16 * vt + 4 * hh);
        bf16x8 qhat[4], qtil[4];
#pragma unroll
        for (int ks = 0; ks < 4; ++ks) {
            const int k0 = 32 * ks + 8 * hh;
            const u32x4 qw = *(const LAS u32x4*)(Qs + tq * H3_QSTR + k0 * 2);
            const f32x4 b0 = *(const LAS f32x4*)(Bl + tq * H3_BSTR + k0 * 4), b1 = *(const LAS f32x4*)(Bl + tq * H3_BSTR + k0 * 4 + 16);
            f32x4 r0 = (f32x4){0.f, 0.f, 0.f, 0.f}, r1 = r0;
            if (i4 > 0) { r0 = *(const LAS f32x4*)(Bl + (16 * i4 - 1) * H3_BSTR + k0 * 4); r1 = *(const LAS f32x4*)(Bl + (16 * i4 - 1) * H3_BSTR + k0 * 4 + 16); }
            const float q[8] = {bflo(qw.x), bfhi(qw.x), bflo(qw.y), bfhi(qw.y), bflo(qw.z), bfhi(qw.z), bflo(qw.w), bfhi(qw.w)};
            const float bb[8] = {b0[0], b0[1], b0[2], b0[3], b1[0], b1[1], b1[2], b1[3]};
            const float rf[8] = {r0[0], r0[1], r0[2], r0[3], r1[0], r1[1], r1[2], r1[3]};
            float a[8], t8[8];
#pragma unroll
            for (int e = 0; e < 8; ++e) { a[e] = q[e] * __expf(bb[e] - rf[e]); t8[e] = q[e] * __expf(bb[e]); }
            qhat[ks] = pack8(a[0], a[1], a[2], a[3], a[4], a[5], a[6], a[7]);
            qtil[ks] = pack8(t8[0], t8[1], t8[2], t8[3], t8[4], t8[5], t8[6], t8[7]);
        }
        f32x4 at[4];
#pragma unroll
        for (int j = 0; j < 4; ++j) {
            at[j] = (f32x4){0.f, 0.f, 0.f, 0.f};
            if (j <= i4) {
                const int sr = 16 * j + fr;
#pragma unroll
                for (int ks = 0; ks < 4; ++ks) {
                    const int k0 = 32 * ks + 8 * hh;
                    const u32x4 kw = *(const LAS u32x4*)(Ks + sr * H3_QSTR + k0 * 2);
                    const f32x4 b0 = *(const LAS f32x4*)(Bl + sr * H3_BSTR + k0 * 4), b1 = *(const LAS f32x4*)(Bl + sr * H3_BSTR + k0 * 4 + 16);
                    f32x4 r0 = (f32x4){0.f, 0.f, 0.f, 0.f}, r1 = r0;
                    if (i4 > 0) { r0 = *(const LAS f32x4*)(Bl + (16 * i4 - 1) * H3_BSTR + k0 * 4); r1 = *(const LAS f32x4*)(Bl + (16 * i4 - 1) * H3_BSTR + k0 * 4 + 16); }
                    const float kk[8] = {bflo(kw.x), bfhi(kw.x), bflo(kw.y), bfhi(kw.y), bflo(kw.z), bfhi(kw.z), bflo(kw.w), bfhi(kw.w)};
                    const float bb[8] = {b0[0], b0[1], b0[2], b0[3], b1[0], b1[1], b1[2], b1[3]};
                    const float rf[8] = {r0[0], r0[1], r0[2], r0[3], r1[0], r1[1], r1[2], r1[3]};
                    float a[8];
#pragma unroll
                    for (int e = 0; e < 8; ++e) a[e] = kk[e] * __expf(fminf(rf[e] - bb[e], 80.f));
                    const bf16x8 kf = pack8(a[0], a[1], a[2], a[3], a[4], a[5], a[6], a[7]);
                    at[j] = __builtin_amdgcn_mfma_f32_16x16x32_bf16(kf, qhat[ks], at[j], 0, 0, 0);
                }
                if (j == i4) {
#pragma unroll
                    for (int rg = 0; rg < 4; ++rg) if (4 * hh + rg > fr) at[j][rg] = 0.f;
                }
            }
        }
        f32x4 o[4];
#pragma unroll
        for (int vt = 0; vt < 4; ++vt) o[vt] = (f32x4){0.f, 0.f, 0.f, 0.f};
#pragma unroll
        for (int p = 0; p < 2; ++p) {
            if (2 * p <= i4) {
                const bf16x8 pf = pack8(at[2 * p][0], at[2 * p][1], at[2 * p][2], at[2 * p][3], at[2 * p + 1][0], at[2 * p + 1][1], at[2 * p + 1][2], at[2 * p + 1][3]);
#pragma unroll
                for (int vt = 0; vt < 4; ++vt) {
                    const LAS unsigned char* vrow = Vt + (64 * vh + 16 * vt + fr) * HG_STR;
                    const u32x2 lo = *(const LAS u32x2*)(vrow + (32 * p + 4 * hh) * 2), hi2 = *(const LAS u32x2*)(vrow + (32 * p + 16 + 4 * hh) * 2);
                    u32x4 w; w.x = lo.x; w.y = lo.y; w.z = hi2.x; w.w = hi2.y;
                    o[vt] = __builtin_amdgcn_mfma_f32_16x16x32_bf16(__builtin_bit_cast(bf16x8, w), pf, o[vt], 0, 0, 0);
                }
            }
        }
#pragma unroll
        for (int vt = 0; vt < 4; ++vt)
#pragma unroll
            for (int ks = 0; ks < 4; ++ks) o[vt] = __builtin_amdgcn_mfma_f32_16x16x32_bf16(sf[vt][ks], qtil[ks], o[vt], 0, 0, 0);
        float ss = 0.f;
#pragma unroll
        for (int vt = 0; vt < 4; ++vt) ss += (o[vt][0] * o[vt][0] + o[vt][1] * o[vt][1]) + (o[vt][2] * o[vt][2] + o[vt][3] * o[vt][3]);
        ss += shx(ss, lane, 16); ss += shx(ss, lane, 32);
        if (hh == 0) osq[vh * 64 + tq] = ss;
        LBAR();
        const float rn = rsqrtf((osq[tq] + osq[64 + tq]) * (1.0f / 128.0f) + EPS);
#pragma unroll
        for (int vt = 0; vt < 4; ++vt) {
            const int v = 64 * vh + 16 * vt + 4 * hh;
            const u32x2 gw = gate[vt];
            u32x2 w; w.x = cvt_pk_bf16(o[vt][0] * rn * bflo(gw.x), o[vt][1] * rn * bfhi(gw.x)); w.y = cvt_pk_bf16(o[vt][2] * rn * bflo(gw.y), o[vt][3] * rn * bfhi(gw.y));
            *(u32x2*)(QH + (row0 + tq) * 2048 + 1024 + h * 128 + v) = w;
        }
    }
    LBAR();
#undef H3_LOAD
}

#define XB_TMO      128
#define XB_XCNT(j)  (256  + 64 * (j))
#define XB_XSUB(j)  (1280 + 64 * (j))
#define XB_XGEN(j)  (2304 + 64 * (j))
#define XB_TOP      3328
#define XB_TOPGEN   3392
#define XCD_BAR_WORDS 3456
#define XB_SPIN_CAP (1u << 22)
__device__ __forceinline__ unsigned xb_ld(unsigned* p)              { return __hip_atomic_load(p, __ATOMIC_RELAXED, __HIP_MEMORY_SCOPE_AGENT); }
__device__ __forceinline__ unsigned xb_add(unsigned* p, unsigned v) { return __hip_atomic_fetch_add(p, v, __ATOMIC_RELAXED, __HIP_MEMORY_SCOPE_AGENT); }
__device__ __forceinline__ unsigned xb_xcc_id() { return (unsigned)__builtin_amdgcn_s_getreg((3 << 11) | 20) & 0xFu; }
#define XB_SPIN(cond, bar) do { unsigned _sp = 0; while (cond) { __builtin_amdgcn_s_sleep(1); \
    if ((++_sp & 255u) == 0u) { if (xb_ld(&(bar)[XB_TMO])) break; if (_sp > XB_SPIN_CAP) { atomicAdd(&(bar)[XB_TMO], 1u); break; } } } } while (0)
struct XcdBarrier { unsigned* bar; unsigned x; volatile LAS unsigned* st; };
__device__ __forceinline__ XcdBarrier xcd_barrier_post(unsigned* bar, volatile LAS unsigned* st) {
    XcdBarrier b; b.bar = bar; b.x = xb_xcc_id(); b.st = st;
    if (threadIdx.x == 0) (void)xb_add(&bar[XB_XCNT(b.x)], 1u);
    return b;
}
__device__ __forceinline__ void xcd_barrier_complete(unsigned* bar, unsigned x, unsigned& nloc, unsigned& nx) {
    const unsigned G = gridDim.x * gridDim.y * gridDim.z;
    unsigned sum, cnt, mine, sp = 0u;
    for (;;) {
        sum = 0u; cnt = 0u; mine = 0u;
#pragma unroll
        for (unsigned j = 0; j < 16; ++j) { const unsigned c = xb_ld(&bar[XB_XCNT(j)]); sum += c; cnt += (c > 0u) ? 1u : 0u; mine = (j == x) ? c : mine; }
        if (sum == G) break;
        __builtin_amdgcn_s_sleep(1);
        if ((++sp & 255u) == 0u) { if (xb_ld(&bar[XB_TMO])) break; if (sp > XB_SPIN_CAP) { atomicAdd(&bar[XB_TMO], 1u); break; } }
    }
    nloc = mine > 0u ? mine : 1u; nx = cnt > 0u ? cnt : 1u;
}
__device__ __forceinline__ void xcd_barrier(const XcdBarrier& b) {
    asm volatile("s_waitcnt vmcnt(0)" ::: "memory");
    __syncthreads();
    if (threadIdx.x == 0) {
        unsigned* bar = b.bar;
        __builtin_amdgcn_s_waitcnt(0);
        unsigned nloc = b.st[0], nx = b.st[1];
        if (nloc == 0u) { xcd_barrier_complete(bar, b.x, nloc, nx); b.st[0] = nloc; b.st[1] = nx; }
        const unsigned old = xb_add(&bar[XB_XSUB(b.x)], 1u);
        const unsigned gen = old / nloc;
        if (old + 1u == (gen + 1u) * nloc) {
            __builtin_amdgcn_fence(__ATOMIC_RELEASE, "agent");
            asm volatile("s_waitcnt vmcnt(0)" ::: "memory");
            const unsigned og = xb_add(&bar[XB_TOP], 1u);
            const unsigned tg = og / nx;
            if (og + 1u == (tg + 1u) * nx) xb_add(&bar[XB_TOPGEN], 1u);
            else XB_SPIN(xb_ld(&bar[XB_TOPGEN]) == tg, bar);
            __builtin_amdgcn_fence(__ATOMIC_ACQUIRE, "agent");
            xb_add(&bar[XB_XGEN(b.x)], 1u);
            asm volatile("s_waitcnt vmcnt(0)" ::: "memory");
        } else {
            XB_SPIN(xb_ld(&bar[XB_XGEN(b.x)]) == gen, bar);
            __builtin_amdgcn_fence(__ATOMIC_ACQUIRE, "agent");
            asm volatile("s_waitcnt vmcnt(0)" ::: "memory");
        }
    }
    __syncthreads();
}

__global__ void __launch_bounds__(NTHR, 2) fwd_megakernel(Args args) {
    extern __shared__ __attribute__((aligned(16))) unsigned char lds_raw[];
    LAS unsigned char* lds = (LAS unsigned char*)lds_raw;
    cg::grid_group grid = cg::this_grid();
    const int G = gridDim.x, bx = blockIdx.x, ngw = G * NWAVES, nthr = G * NTHR;
    const int wave = __builtin_amdgcn_readfirstlane((int)threadIdx.x >> 6);
#define PHASE_IDS() int lane_; asm volatile("v_mbcnt_lo_u32_b32 %0, -1, 0\n\tv_mbcnt_hi_u32_b32 %0, -1, %0" : "=v"(lane_)); const int lane = lane_, tid = wave * 64 + lane, gw = bx * NWAVES + wave, gtid = bx * NTHR + tid; (void)gw; (void)gtid
    unsigned char* ws = args.ws;
    const float* x_in = (const float*)args.in[0]; const float* p_in = (const float*)args.in[1]; const int* pos = (const int*)args.in[2];
    const float* w_in = (const float*)args.in[3]; const float* sinks = (const float*)args.in[4]; const float* lb_logits = (const float*)args.in[5];
    const float* attn_gain = (const float*)args.in[6]; const float* hgrn_gain = (const float*)args.in[7]; const float* w_out = (const float*)args.in[8];
    const float* pre_mix = (const float*)args.in[9]; const float* post_mix = (const float*)args.in[10]; const float* pre_ffn = (const float*)args.in[11]; const float* post_ffn = (const float*)args.in[12];
    const float* w_gate = (const float*)args.in[13]; const float* w_up = (const float*)args.in[14]; const float* w_down = (const float*)args.in[15];
    const float* ple_gain = (const float*)args.in[16]; const float* w_pg = (const float*)args.in[17]; const float* w_pp = (const float*)args.in[18];
    float* out = args.out;
    u64* stat = (u64*)(ws + WS_STAT); float* lbt = (float*)(ws + WS_LBT); float* cs = (float*)(ws + WS_CS);
    bf16_t* PBF = (bf16_t*)(ws + WS_PBF); bf16_t* HA = (bf16_t*)(ws + WS_HA); float* tmpO = (float*)(ws + WS_HA);
    bf16_t* QH = (bf16_t*)(ws + WS_QH); bf16_t* Kb = (bf16_t*)(ws + WS_K); bf16_t* Vb = (bf16_t*)(ws + WS_V); float* Gb = (float*)(ws + WS_G);
    bf16_t* KIN = (bf16_t*)(ws + WS_KIN); bf16_t* HI = (bf16_t*)(ws + WS_HI); bf16_t* HG = (bf16_t*)(ws + WS_HG);
    bf16_t* SBuf = (bf16_t*)(ws + WS_HA); float* DEC = (float*)(ws + WS_DEC);
    bf16_t* Mb = (bf16_t*)(ws + WS_M); bf16_t* ACT = (bf16_t*)(ws + WS_ACT); bf16_t* Fb = (bf16_t*)(ws + WS_F); bf16_t* PP = (bf16_t*)(ws + WS_PP);

    volatile LAS unsigned* xst = (volatile LAS unsigned*)(lds + 131072 + 64);
    unsigned* barw = (unsigned*)(ws + WS_BAR);
    if (threadIdx.x < 2) xst[threadIdx.x] = 0u;
    if (bx == 0) for (int i = threadIdx.x; i < 3456; i += NTHR) barw[i] = 0u;
    __syncthreads();
    {
        PHASE_IDS();
        LAS float* scr = (LAS float*)(lds + wave * 16384);
        constexpr int I_IN = 32 * 176, I_OUT = 32 * 64, I_G = 32 * 176, I_D = 88 * 64, I_PG = 32 * 64, I_PP = 4 * 64;
        constexpr int I_L = I_IN + I_OUT + 2 * I_G + I_D + I_PG + I_PP;
        for (int it = gw; it < DEPTH * I_L; it += ngw) {
            const int l = it / I_L; int r = it % I_L;
            unsigned char* wl = ws + WS_W + (size_t)l * WL_SIZE;
            if (r < I_IN) {
                const int kb = r / 176, nb = r % 176, n0 = nb * 32, pn = n0 >> 8; int prow0 = n0;
                if (pn <= 4) { const int lc = n0 & 255; prow0 = (pn << 8) + 128 * ((lc >> 5) & 1) + 32 * ((lc >> 6) & 3); }
                tr_item(w_in + (size_t)l * DM * DIN, DIN, DM, kb * 64, n0, (bf16_t*)(wl + WL_IN), prow0, pre_mix + l * DM, scr, lane); continue; }
            r -= I_IN;
            if (r < I_OUT) {
                const int kb = r / 64, nb = r % 64; const int k0 = kb * 64;
                const float* gp = (k0 < 1024) ? (attn_gain + l * 1024) : (hgrn_gain + l * 1024 - 1024);
                tr_item(w_out + (size_t)l * DM * DM, DM, DM, k0, nb * 32, (bf16_t*)(wl + WL_OUT), nb * 32, gp, scr, lane); continue; }
            r -= I_OUT;
            if (r < 2 * I_G) {
                const int up = r >= I_G; if (up) r -= I_G;
                const int kb = r / 176, nb = r % 176, n0 = nb * 32; const int prow0 = 256 * (n0 >> 7) + (n0 & 127) + (up ? 128 : 0);
                tr_item((up ? w_up : w_gate) + (size_t)l * DM * DFF, DFF, DM, kb * 64, n0, (bf16_t*)(wl + WL_GU), prow0, pre_ffn + l * DM, scr, lane); continue; }
            r -= 2 * I_G;
            if (r < I_D) { const int kb = r / 64, nb = r % 64;
                tr_item(w_down + (size_t)l * DFF * DM, DM, DFF, kb * 64, nb * 32, (bf16_t*)(wl + WL_DOWN), nb * 32, nullptr, scr, lane); continue; }
            r -= I_D;
            if (r < I_PG) { const int kb = r / 64, nb = r % 64;
                tr_item(w_pg + (size_t)l * DM * DM, DM, DM, kb * 64, nb * 32, (bf16_t*)(wl + WL_PG), nb * 32, ple_gain + l * DM, scr, lane); continue; }
            r -= I_PG;
            { const int kb = r / 64, nb = r % 64;
                tr_item(w_pp + (size_t)l * DPLE * DM, DM, DPLE, kb * 64, nb * 32, (bf16_t*)(wl + WL_PP), nb * 32, nullptr, scr, lane); }
        }
        for (int i = gtid; i < 11 * T; i += nthr) stat[T + i] = 0ull;
        for (int i = gtid; i < 1024; i += nthr) {
            const float l0 = lb_logits[i], l1 = lb_logits[1024 + i];
            lbt[i] = 0.f; lbt[1024 + i] = 1.0f / (1.0f + expf(l0 - l1));
        }
        for (int i = gtid; i < T * 32; i += nthr) {
            const int row = i >> 5, d = i & 31;
            const double rev = (double)pos[row] * c_invf[d] * 0.15915494309189535;
            const float fr = (float)(rev - rint(rev));
            cs[(size_t)row * 64 + d] = __builtin_amdgcn_cosf(fr); cs[(size_t)row * 64 + 32 + d] = __builtin_amdgcn_sinf(fr);
        }
        for (int i = gtid; i < DEPTH * T * DPLE / 8; i += nthr) {
            const f32x4 a = *(const f32x4*)(p_in + (size_t)i * 8), b = *(const f32x4*)(p_in + (size_t)i * 8 + 4);
            u32x4 w; w.x = pk2(a[0], a[1]); w.y = pk2(a[2], a[3]); w.z = pk2(b[0], b[1]); w.w = pk2(b[2], b[3]);
            *(u32x4*)(PBF + (size_t)i * 8) = w;
        }
    }
    { PHASE_IDS();
    for (int row = gw; row < T; row += ngw) {
        float ss = 0.f;
#pragma unroll
        for (int j = 0; j < 4; ++j) {
            const int c = j * 512 + lane * 8; const size_t off = (size_t)row * 2048 + c;
            const f32x4 x0 = *(const f32x4*)(x_in + off), x1 = *(const f32x4*)(x_in + off + 4);
            u32x4 w; w.x = pk2(x0[0], x0[1]); w.y = pk2(x0[2], x0[3]); w.z = pk2(x1[0], x1[1]); w.w = pk2(x1[2], x1[3]);
            *(u32x4*)(HA + off) = w;
            ss += (x0[0] * x0[0] + x0[1] * x0[1]) + (x0[2] * x0[2] + x0[3] * x0[3]) + (x1[0] * x1[0] + x1[1] * x1[1]) + (x1[2] * x1[2] + x1[3] * x1[3]);
        }
        ss = wave_sum(ss, lane);
        if (lane == 0) stat[(SQ_X + 0) * T + row] = fx_enc(ss);
    } }
    grid.sync();
    const XcdBarrier xbar = xcd_barrier_post(barw, xst);
#define GSYNC() xcd_barrier(xbar)

    for (int l = 0; l < DEPTH; ++l) {
        unsigned char* wl = ws + WS_W + (size_t)l * WL_SIZE;
        u64* ssqX = stat + (SQ_X + l) * T; u64* ssqA = stat + (SQ_A + l) * T; u64* ssqM = stat + (SQ_M + l) * T;
        u64* ssq2 = stat + (SQ_2 + l) * T; u64* ssqF = stat + (SQ_F + l) * T; u64* ssq3 = stat + (SQ_3 + l) * T;
        {
            PHASE_IDS(); pg8::Gemm g{l == 0 ? HA : (const bf16_t*)(ws + WS_W + (size_t)(l - 1) * WL_SIZE), (const bf16_t*)(wl + WL_IN), T, DIN, DM}; pg8::StaticOrder S; S.init(T, DIN, G, bx);
            EpiIn E{0, ssqX, cs, lbt + l * 1024, QH, Kb, Vb, Gb, KIN, HI, HG};
            if (PH & 1) pg8::gemm_phase<EpiIn, pg8::StaticOrder, true, true>(lds, g, S, E, tid);
        }
        GSYNC();
#if !NAIVE_MIX
        { PHASE_IDS();
          for (int u = bx; u < 512; u += G) attn_unit(lds, QH, Kb, Vb, sinks + l * 16, ssqA, u, tid, lane, wave);
          hgrn_h1_phase(lds, KIN, Gb, HI, SBuf, DEC, bx, G, tid, lane, wave); }
        GSYNC();
        { PHASE_IDS(); hgrn_scan(SBuf, DEC, gtid, nthr); }
        GSYNC();
        { PHASE_IDS();
          hgrn_h3_phase(lds, QH, KIN, Gb, HI, HG, SBuf, bx, G, tid, lane, wave); }
        GSYNC();
#else
        { PHASE_IDS();
        if (bx < 64 && wave == 0) hgrn_naive(QH, KIN, Gb, HI, tmpO, bx, lane);
        attn_naive(QH, Kb, Vb, sinks + l * 16, ssqA, gtid, nthr); }
        GSYNC();
        { PHASE_IDS(); hgrn_norm_naive(tmpO, HG, QH, gw, ngw, lane); }
        GSYNC();
#endif
        {
            PHASE_IDS(); pg8::Gemm g{QH, (const bf16_t*)(wl + WL_OUT), T, DM, DM}; pg8::StaticOrder S; S.init(T, DM, G, bx);
            EpiRowSsq<true> E{16, Mb, ssqM, ssqA};
            if (PH & 2) pg8::gemm_phase<EpiRowSsq<true>, pg8::StaticOrder, true, true>(lds, g, S, E, tid);
        }
        GSYNC();
        { PHASE_IDS();
          if (l == 0) row_phase<true>(x_in, nullptr, Mb, ssqM, post_mix + l * DM, HA, ssq2, gw, ngw, lane);
          else row_phase<false>(nullptr, (const bf16_t*)(ws + WS_W + (size_t)(l - 1) * WL_SIZE), Mb, ssqM, post_mix + l * DM, HA, ssq2, gw, ngw, lane); }
        GSYNC();
        {
            PHASE_IDS(); pg8::Gemm g{HA, (const bf16_t*)(wl + WL_GU), T, 2 * DFF, DM}; pg8::StaticOrder S; S.init(T, 2 * DFF, G, bx);
            EpiGU E{0, ssq2, ACT};
            if (PH & 4) pg8::gemm_phase<EpiGU, pg8::StaticOrder, true, true>(lds, g, S, E, tid);
        }
        GSYNC();
        {
            PHASE_IDS(); pg8::Gemm g{ACT, (const bf16_t*)(wl + WL_DOWN), T, DM, DFF}; pg8::StaticOrder S; S.init(T, DM, G, bx);
            EpiRowSsq<false> E{0, Fb, ssqF, nullptr};
            if (PH & 8) pg8::gemm_phase<EpiRowSsq<false>, pg8::StaticOrder, true, true>(lds, g, S, E, tid);
        }
        GSYNC();
        { PHASE_IDS(); row_phase<false>(nullptr, HA, Fb, ssqF, post_ffn + l * DM, HA, ssq3, gw, ngw, lane); }
        GSYNC();
        {
            PHASE_IDS(); int kpp = DPLE; asm volatile("" : "+s"(kpp)); pg8::Gemm g{PBF + (size_t)l * T * DPLE, (const bf16_t*)(wl + WL_PP), T, DM, kpp}; pg8::StaticOrder S; S.init(T, DM, G, bx);
            EpiPlain E{0, PP};
            if (PH & 16) pg8::gemm_phase<EpiPlain, pg8::StaticOrder, true, true>(lds, g, S, E, tid);
        }
        {
            PHASE_IDS(); pg8::Gemm g{HA, (const bf16_t*)(wl + WL_PG), T, DM, DM}; pg8::StaticOrder S; S.init(T, DM, G, bx);
            EpiPle E{0, ssq3, PP, HA, out, (bf16_t*)wl, stat + (SQ_X + (l + 1 < DEPTH ? l + 1 : 0)) * T, l + 1 < DEPTH ? 1 : 0};
            if (PH & 32) pg8::gemm_phase<EpiPle, pg8::StaticOrder, true, true>(lds, g, S, E, tid);
        }
        if (l + 1 < DEPTH) GSYNC();
    }
}

extern "C" void kernel_launch(void* const* d_in, const int* in_sizes, int n_in, void* d_out, int out_size, void* d_ws, size_t ws_size, hipStream_t stream) {
    static int grid = 0;
    if (grid == 0) {
        if (n_in != 19 || out_size != T * DM || ws_size < WS_END) { fprintf(stderr, "kernel_launch: unexpected shapes (n_in %d out %d ws %zu need %zu)\n", n_in, out_size, ws_size, (size_t)WS_END); grid = -1; return; }
        int dev = 0, cus = 0, per_cu = 0;
        hipGetDevice(&dev);
        hipDeviceGetAttribute(&cus, hipDeviceAttributeMultiprocessorCount, dev);
        if (hipFuncSetAttribute((const void*)fwd_megakernel, hipFuncAttributeMaxDynamicSharedMemorySize, LDS_BYTES) != hipSuccess) { fprintf(stderr, "kernel_launch: hipFuncSetAttribute failed\n"); grid = -1; return; }
        if (hipOccupancyMaxActiveBlocksPerMultiprocessor(&per_cu, (const void*)fwd_megakernel, NTHR, LDS_BYTES) != hipSuccess || per_cu < 1) { fprintf(stderr, "kernel_launch: occupancy query gave %d\n", per_cu); per_cu = 1; }
        (void)hipGetLastError();
        grid = cus * per_cu;
    }
    if (grid < 0) return;
    Args a{};
    for (int i = 0; i < 19; ++i) a.in[i] = d_in[i];
    a.out = (float*)d_out; a.ws = (unsigned char*)d_ws;
    void* kargs[] = {&a};
    hipError_t e = hipLaunchCooperativeKernel((const void*)fwd_megakernel, dim3(grid), dim3(NTHR), kargs, LDS_BYTES, stream);
    if (e != hipSuccess) fprintf(stderr, "cooperative launch failed: %s (grid %d)\n", hipGetErrorString(e), grid);
}
```
